# Optimizing an MI355X kernel written in HIP

```python
import math
import jax, jax.numpy as jnp
from jax import lax
import numpy as np

D_MODEL = 1024
BATCH = 8
SEQ = 2048
DEPTH = 1
DEC_BATCH = 128
DEC_SEQ = 4
PAST_LEN = 2048
PAGE_SIZE = 128

N_META = 16
ATTN_WIDTH = D_MODEL // 2
SSM_WIDTH = D_MODEL - ATTN_WIDTH
N_HEADS = 4
QK_DIM = 64
HEAD_DIM = 2 * QK_DIM
SSM_GROUP = 16
N_SSM_GROUPS = SSM_WIDTH // SSM_GROUP
SSM_STATE = 64
D_FF = 2816
CONV_WIDTH = 3
Q_BLOCK = 128
EPS = 1e-6
NEG = -1e30
PROJ_WIDTH = 3 * N_HEADS * HEAD_DIM + SSM_WIDTH

kernel_name = "hymba_s5_diffattn_convffn_step"


def _rmsnorm(x, g):
    xf = x.astype(jnp.float32)
    r = lax.rsqrt(jnp.mean(xf * xf, axis=-1, keepdims=True) + EPS)
    return (xf * r).astype(x.dtype) * g


def _project(xn, w_in, q_norm, k_norm):
    b, t, _ = xn.shape
    a = N_HEADS * HEAD_DIM
    proj = xn @ w_in
    q, k, v, u = jnp.split(proj, [a, 2 * a, 3 * a], axis=-1)
    q = _rmsnorm(q.reshape(b, t, N_HEADS, 2, QK_DIM), q_norm)
    k = _rmsnorm(k.reshape(b, t, N_HEADS, 2, QK_DIM), k_norm)
    v = v.reshape(b, t, N_HEADS, HEAD_DIM)
    return q, k, v, u


def _scores(q, k):
    return jnp.einsum('bthcd,bshcd->bhcts', q, k).astype(jnp.float32) * (QK_DIM ** -0.5)


def _diff_weights(s, lam):
    p = jax.nn.softmax(s, axis=-1)
    return p[:, :, 0] - lam * p[:, :, 1]


def _attn_prompt(q, k, v, lam):
    L = q.shape[1]
    bounds = [(0, N_META)] + [(N_META + i * Q_BLOCK, N_META + (i + 1) * Q_BLOCK)
                              for i in range((L - N_META) // Q_BLOCK)]
    outs = []
    for s0, e0 in bounds:
        s = _scores(q[:, s0:e0], k[:, :e0])
        mask = jnp.arange(e0)[None, :] <= jnp.arange(s0, e0)[:, None]
        w = _diff_weights(jnp.where(mask, s, NEG), lam)
        outs.append(jnp.einsum('bhts,bshe->bthe', w.astype(v.dtype), v[:, :e0]))
    return jnp.concatenate(outs, axis=1)


def _attn_sample(q, k_new, v_new, k_past, v_past, lam):
    T = q.shape[1]
    P = k_past.shape[1]
    s_past = _scores(q, k_past)
    s_new = jnp.where(jnp.tril(jnp.ones((T, T), dtype=bool)), _scores(q, k_new), NEG)
    w = _diff_weights(jnp.concatenate([s_past, s_new], axis=-1), lam).astype(v_new.dtype)
    return (jnp.einsum('bhts,bshe->bthe', w[..., :P], v_past)
            + jnp.einsum('bhts,bshe->bthe', w[..., P:], v_new))


def _head_norm(o, sub_g, lam_init):
    b, t = o.shape[:2]
    return (_rmsnorm(o, sub_g) * (1.0 - lam_init)).reshape(b, t, N_HEADS * HEAD_DIM)


def _cplx_combine(e1, e2):
    a1r, a1i, b1r, b1i = e1
    a2r, a2i, b2r, b2i = e2
    return (a2r * a1r - a2i * a1i, a2r * a1i + a2i * a1r,
            a2r * b1r - a2i * b1i + b2r, a2r * b1i + a2i * b1r + b2i)


def _ssm(u, h0r, h0i, a_re, a_im, log_dt, b_re, b_im, c_re, c_im, d_skip, w_glu, b_glu):
    f32 = jnp.float32
    b, t, _ = u.shape
    ug = u.astype(f32).reshape(b, t, N_SSM_GROUPS, SSM_GROUP)
    ar, ai = a_re.astype(f32), a_im.astype(f32)
    dt = jnp.exp(log_dt.astype(f32))[:, None]
    mag = jnp.exp(ar * dt)
    abr, abi = mag * jnp.cos(ai * dt), mag * jnp.sin(ai * dt)
    den = ar * ar + ai * ai
    nr, ni = abr - 1.0, abi
    gr, gi = (nr * ar + ni * ai) / den, (ni * ar - nr * ai) / den
    br, bi = b_re.astype(f32), b_im.astype(f32)
    bbr = gr[..., None] * br - gi[..., None] * bi
    bbi = gr[..., None] * bi + gi[..., None] * br
    xr = jnp.einsum('btgc,gpc->btgp', ug, bbr)
    xi = jnp.einsum('btgc,gpc->btgp', ug, bbi)
    if h0r is not None:
        h0r, h0i = h0r.astype(f32), h0i.astype(f32)
        xr = xr.at[:, 0].add(abr * h0r - abi * h0i)
        xi = xi.at[:, 0].add(abr * h0i + abi * h0r)
    A_r = jnp.broadcast_to(abr, xr.shape)
    A_i = jnp.broadcast_to(abi, xr.shape)
    _, _, hr, hi = lax.associative_scan(_cplx_combine, (A_r, A_i, xr, xi), axis=1)
    y = (jnp.einsum('btgp,gcp->btgc', hr, c_re.astype(f32))
         - jnp.einsum('btgp,gcp->btgc', hi, c_im.astype(f32))
         + d_skip.astype(f32) * ug).reshape(b, t, SSM_WIDTH)
    g = jax.nn.gelu(y)
    out = g * jax.nn.sigmoid(g @ w_glu.astype(f32) + b_glu.astype(f32))
    return out.astype(u.dtype), hr[:, -1], hi[:, -1]


def _conv_ffn(xn, conv_state, w_gate, w_up, conv_w, conv_b, w_down):
    a = xn @ w_gate
    c = xn @ w_up
    b, T, _ = a.shape
    hist = jnp.zeros((b, CONV_WIDTH - 1, D_FF), a.dtype) if conv_state is None else conv_state.astype(a.dtype)
    ap = jnp.concatenate([hist, a], axis=1)
    conv = conv_b + sum(conv_w[j] * ap[:, j:j + T] for j in range(CONV_WIDTH))
    y = (jax.nn.gelu(conv) * c) @ w_down
    return y, ap[:, -(CONV_WIDTH - 1):]


def setup_inputs(seed: int = 0) -> dict:
    key = jax.random.key(seed)
    ks = jax.random.split(key, 40)
    f32 = jnp.float32
    nrm = lambda k, shape, s: jax.random.normal(k, shape, f32) * s
    n_pages = PAST_LEN // PAGE_SIZE
    n_pool = (DEC_BATCH * n_pages * 5 + 3) // 4
    G, P, C = N_SSM_GROUPS, SSM_STATE, SSM_GROUP
    page_table = jax.random.permutation(ks[0], n_pool)[:DEC_BATCH * n_pages].reshape(DEC_BATCH, n_pages).astype(jnp.int32)
    a_im = jnp.broadcast_to(math.pi * jnp.arange(P, dtype=f32), (DEPTH, G, P)) + nrm(ks[1], (DEPTH, G, P), 0.01)
    return {
        "x_prompt": nrm(ks[2], (BATCH, SEQ, D_MODEL), 1.0),
        "x_sample": nrm(ks[3], (DEC_BATCH, DEC_SEQ, D_MODEL), 1.0),
        "cache_k": nrm(ks[4], (DEPTH, n_pool, PAGE_SIZE, N_HEADS, HEAD_DIM), 1.0),
        "cache_v": nrm(ks[5], (DEPTH, n_pool, PAGE_SIZE, N_HEADS, HEAD_DIM), 1.0),
        "state_ssm_re": nrm(ks[6], (DEPTH, DEC_BATCH, G, P), 1.0),
        "state_ssm_im": nrm(ks[7], (DEPTH, DEC_BATCH, G, P), 1.0),
        "state_ffn_conv": nrm(ks[8], (DEPTH, DEC_BATCH, CONV_WIDTH - 1, D_FF), 1.0),
        "page_table": page_table,
        "meta_tokens": nrm(ks[9], (N_META, D_MODEL), 1.0),
        "norm1": 1.0 + nrm(ks[10], (DEPTH, D_MODEL), 0.01),
        "w_in": nrm(ks[11], (DEPTH, D_MODEL, PROJ_WIDTH), D_MODEL ** -0.5),
        "q_norm": 1.0 + nrm(ks[12], (DEPTH, 2, QK_DIM), 0.01),
        "k_norm": 1.0 + nrm(ks[13], (DEPTH, 2, QK_DIM), 0.01),
        "lam_q": nrm(ks[14], (DEPTH, 2, QK_DIM), 0.1),
        "lam_k": nrm(ks[15], (DEPTH, 2, QK_DIM), 0.1),
        "sub_norm": 1.0 + nrm(ks[16], (DEPTH, HEAD_DIM), 0.01),
        "ssm_a_re": -0.5 + nrm(ks[17], (DEPTH, G, P), 0.01),
        "ssm_a_im": a_im,
        "ssm_log_dt": jax.random.uniform(ks[18], (DEPTH, G), f32, math.log(1e-3), math.log(1e-1)),
        "ssm_b_re": nrm(ks[19], (DEPTH, G, P, C), (2 * C) ** -0.5),
        "ssm_b_im": nrm(ks[20], (DEPTH, G, P, C), (2 * C) ** -0.5),
        "ssm_c_re": nrm(ks[21], (DEPTH, G, C, P), P ** -0.5),
        "ssm_c_im": nrm(ks[22], (DEPTH, G, C, P), P ** -0.5),
        "ssm_d": nrm(ks[23], (DEPTH, G, C), 1.0),
        "w_glu": nrm(ks[24], (DEPTH, SSM_WIDTH, SSM_WIDTH), SSM_WIDTH ** -0.5),
        "b_glu": nrm(ks[25], (DEPTH, SSM_WIDTH), 0.01),
        "w_out": nrm(ks[26], (DEPTH, D_MODEL, D_MODEL), D_MODEL ** -0.5),
        "norm2": 1.0 + nrm(ks[27], (DEPTH, D_MODEL), 0.01),
        "w_gate": nrm(ks[28], (DEPTH, D_MODEL, D_FF), D_MODEL ** -0.5),
        "w_up": nrm(ks[29], (DEPTH, D_MODEL, D_FF), D_MODEL ** -0.5),
        "ffn_conv_w": nrm(ks[30], (DEPTH, CONV_WIDTH, D_FF), 0.5),
        "ffn_conv_b": nrm(ks[31], (DEPTH, D_FF), 0.01),
        "w_down": nrm(ks[32], (DEPTH, D_FF, D_MODEL), D_FF ** -0.5),
    }


def reference(x_prompt, x_sample, cache_k, cache_v, state_ssm_re, state_ssm_im, state_ffn_conv,
              page_table, meta_tokens, norm1, w_in, q_norm, k_norm, lam_q, lam_k, sub_norm,
              ssm_a_re, ssm_a_im, ssm_log_dt, ssm_b_re, ssm_b_im, ssm_c_re, ssm_c_im, ssm_d,
              w_glu, b_glu, w_out, norm2, w_gate, w_up, ffn_conv_w, ffn_conv_b, w_down):
    f32 = jnp.float32
    b = x_prompt.shape[0]
    db, T = x_sample.shape[:2]
    meta = jnp.broadcast_to(meta_tokens.astype(x_prompt.dtype), (b, N_META, D_MODEL))
    xp = jnp.concatenate([meta, x_prompt], axis=1)
    xs = x_sample
    kp_l, vp_l, ks_l, vs_l, srp_l, sip_l, srs_l, sis_l, cp_l, cs_l = ([] for _ in range(10))
    for l in range(DEPTH):
        lam_init = 0.8 - 0.6 * math.exp(-0.3 * l)
        lq, lk = lam_q[l].astype(f32), lam_k[l].astype(f32)
        lam = jnp.exp(jnp.sum(lq[0] * lk[0])) - jnp.exp(jnp.sum(lq[1] * lk[1])) + lam_init
        ssm_p = (ssm_a_re[l], ssm_a_im[l], ssm_log_dt[l], ssm_b_re[l], ssm_b_im[l],
                 ssm_c_re[l], ssm_c_im[l], ssm_d[l], w_glu[l], b_glu[l])
        ffn_p = (w_gate[l], w_up[l], ffn_conv_w[l], ffn_conv_b[l], w_down[l])

        q, k, v, u = _project(_rmsnorm(xp, norm1[l]), w_in[l], q_norm[l], k_norm[l])
        att = _head_norm(_attn_prompt(q, k, v, lam), sub_norm[l], lam_init)
        ssm_out, hr, hi = _ssm(u, None, None, *ssm_p)
        xp = xp + jnp.concatenate([att, ssm_out.astype(att.dtype)], axis=-1) @ w_out[l]
        f, cst = _conv_ffn(_rmsnorm(xp, norm2[l]), None, *ffn_p)
        xp = xp + f
        L = xp.shape[1]
        kp_l.append(k.reshape(b, L, N_HEADS, HEAD_DIM)); vp_l.append(v)
        srp_l.append(hr); sip_l.append(hi); cp_l.append(cst)

        q, k, v, u = _project(_rmsnorm(xs, norm1[l]), w_in[l], q_norm[l], k_norm[l])
        k_past = cache_k[l, page_table].reshape(db, -1, N_HEADS, 2, QK_DIM)
        v_past = cache_v[l, page_table].reshape(db, -1, N_HEADS, HEAD_DIM)
        att = _head_norm(_attn_sample(q, k, v, k_past.astype(q.dtype), v_past.astype(v.dtype), lam),
                         sub_norm[l], lam_init)
        ssm_out, hr, hi = _ssm(u, state_ssm_re[l], state_ssm_im[l], *ssm_p)
        xs = xs + jnp.concatenate([att, ssm_out.astype(att.dtype)], axis=-1) @ w_out[l]
        f, cst = _conv_ffn(_rmsnorm(xs, norm2[l]), state_ffn_conv[l], *ffn_p)
        xs = xs + f
        ks_l.append(k.reshape(db, T, N_HEADS, HEAD_DIM)); vs_l.append(v)
        srs_l.append(hr); sis_l.append(hi); cs_l.append(cst)

    y_prompt = xp[:, N_META:]
    y_sample = xs
    return (y_prompt, y_sample,
            jnp.stack(kp_l), jnp.stack(vp_l), jnp.stack(ks_l), jnp.stack(vs_l),
            jnp.stack(srp_l), jnp.stack(sip_l), jnp.stack(srs_l), jnp.stack(sis_l),
            jnp.stack(cp_l), jnp.stack(cs_l))
```

```cpp
#include <hip/hip_runtime.h>
#include <hip/hip_bf16.h>
#include <cstdio>
#include <cstdint>
#include <cmath>
namespace pg8 {
#define PG8_LAS __attribute__((address_space(3)))
typedef unsigned short bf16_t;
typedef short bf16x8 __attribute__((ext_vector_type(8)));
typedef float f32x4 __attribute__((ext_vector_type(4)));
typedef unsigned u32x4 __attribute__((ext_vector_type(4)));
constexpr int BM = 256, BK = 64, HALF = 128, HTB = HALF * BK * 2  , STAGE_BYTES = 8 * HTB, NXCD = 8, WGM = 8;

__host__ __device__ __forceinline__ int lds_byte(int r, int c) { const int st = (r >> 4) * 2 + (c >> 5), rr = r & 15, cc = c & 31, ob = rr * 64 + cc * 2; return st * 1024 + (ob ^ (((ob >> 9) & 1) << 5)); }
__host__ __device__ __forceinline__ void stage_rc(int b, int& R, int& C) { const int st = b / 1024, sb = b % 1024, swz = sb ^ (((sb >> 9) & 1) << 5); R = (st >> 1) * 16 + swz / 64; C = (st & 1) * 32 + (swz % 64) / 2; }
__host__ __device__ __forceinline__ int perm32(int rho) { const int n = rho >> 4, i = rho & 15; return 8 * (i >> 2) + 4 * n + (i & 3); }

struct Unit { int pm, pn; };
struct Gemm { const bf16_t* A; const bf16_t* Bt; int M, N, K, ld; };

struct StaticOrder {
    int nM, nN, nwg, G, c;
    __host__ __device__ void init(int M, int N, int G_, int c_) { nM = M / BM; nN = N / BM; nwg = nM * nN; G = G_; c = c_; }
    __host__ __device__ bool next(int i, Unit& u) const {
        const long L = (long)i * G + c; if (L >= nwg) return false;
        int wgid = (int)L; { const int q = nwg / NXCD, r = nwg % NXCD, xcd = wgid % NXCD, off = wgid / NXCD; wgid = (xcd < r ? xcd * (q + 1) : r * (q + 1) + (xcd - r) * q) + off; }
        const int nig = WGM * nN, gid = wgid / nig, fm = gid * WGM, gsz = (nM - fm) < WGM ? (nM - fm) : WGM;
        u.pm = fm + ((wgid % nig) % gsz); u.pn = (wgid % nig) / gsz; return true;
    }
    __device__ __forceinline__ void a_ready(const Unit&) const {}
    __device__ __forceinline__ void done(const Unit&) const {}
};

__device__ __forceinline__ unsigned cvt_pk_bf16(float lo, float hi) { unsigned r; asm volatile("v_cvt_pk_bf16_f32 %0, %1, %2" : "=v"(r) : "v"(lo), "v"(hi)); return r; }
typedef float f32x2 __attribute__((ext_vector_type(2)));
__device__ __forceinline__ f32x2 gelu_pk(f32x2 v) {
    const f32x2 av = __builtin_elementwise_abs(v), d = av * 0.2316418882f + 1.0f;
    f32x2 t; t.x = __builtin_amdgcn_rcpf(d.x); t.y = __builtin_amdgcn_rcpf(d.y);
    f32x2 q = t * 0.5307027145f + (-0.7265760135f); q = q * t + 0.7107068705f; q = q * t + (-0.142248368f); q = q * t + 0.127414796f; q = q * t;
    const f32x2 s = (v * v) * (-0.72134752044f);
    f32x2 e; e.x = __builtin_amdgcn_exp2f(s.x); e.y = __builtin_amdgcn_exp2f(s.y);
    const f32x2 m = v * (q * e), r = v - m;
    f32x2 o; o.x = v.x < 0.f ? m.x : r.x; o.y = v.y < 0.f ? m.y : r.y; return o;
}

template <int ACT  > struct EpiBf16 {
    static constexpr bool PERM = true, AFTER_DRAIN = false; static_assert(ACT == 0 || ACT == 1, "EpiBf16: ACT is 0 (none) or 1 (gelu_pk)");
    bf16_t* O; int ldc; const float* bias; int split_cols; size_t split_stride; float scale0;
    __device__ __forceinline__ void operator()(const f32x4 (&acc)[2][2][4][2], const Unit& u, int wr, int wc, int fr, int fq) const {
        const int row0 = u.pm * BM + wr * 64 + fr; int colt = u.pn * BM; bf16_t* base = O;
        float sc = 1.f; if (split_cols) { const int t = colt / split_cols; base += (size_t)t * split_stride; colt -= t * split_cols; if (t == 0) sc = scale0; }
        const int col0 = colt + wc * 32 + 8 * fq, bcol0 = u.pn * BM + wc * 32 + 8 * fq;
        f32x4 bv[2][2];
#pragma unroll
        for (int bj = 0; bj < 2; ++bj)
#pragma unroll
            for (int n = 0; n < 2; ++n) bv[bj][n] = bias ? *(const f32x4*)(bias + bcol0 + bj * HALF + 4 * n) : (f32x4){0.f, 0.f, 0.f, 0.f};
#pragma unroll
        for (int ai = 0; ai < 2; ++ai)
#pragma unroll
            for (int m = 0; m < 4; ++m) { bf16_t* rowp = base + (size_t)(row0 + ai * HALF + m * 16) * ldc + col0;
#pragma unroll
                for (int bj = 0; bj < 2; ++bj) { f32x4 v0 = acc[ai][bj][m][0] + bv[bj][0], v1 = acc[ai][bj][m][1] + bv[bj][1];
                    if (ACT == 1) { f32x2 a = gelu_pk((f32x2){v0[0], v0[1]}), b = gelu_pk((f32x2){v0[2], v0[3]}), c = gelu_pk((f32x2){v1[0], v1[1]}), d = gelu_pk((f32x2){v1[2], v1[3]});
                        v0 = (f32x4){a.x, a.y, b.x, b.y}; v1 = (f32x4){c.x, c.y, d.x, d.y}; }
                    v0 = v0 * sc; v1 = v1 * sc; u32x4 w; w.x = cvt_pk_bf16(v0[0], v0[1]); w.y = cvt_pk_bf16(v0[2], v0[3]); w.z = cvt_pk_bf16(v1[0], v1[1]); w.w = cvt_pk_bf16(v1[2], v1[3]);
                    *(u32x4*)(rowp + bj * HALF) = w; } }
    }
};

template <class Epi, class Sched, bool ALIGN_EPI = false, bool SP2 = false>
__device__ __forceinline__ void gemm_phase(PG8_LAS unsigned char* lds, const Gemm g, const Sched& S, const Epi& E) {
    int tid_ = threadIdx.x; asm volatile("" : "+v"(tid_));
    const int tid = tid_, wid = __builtin_amdgcn_readfirstlane(tid >> 6), lane = tid & 63, wr = wid >> 2, wc = wid & 3, fr = lane & 15, fq = lane >> 4;
    const int K = g.ld, nt = g.K / BK;
    unsigned voffA[2], voffB[2];
#pragma unroll
    for (int i = 0; i < 2; ++i) { int R, C; stage_rc(tid * 16 + i * 8192, R, C); const int Rb = Epi::PERM ? ((R & ~31) + perm32(R & 31)) : R;
        voffA[i] = (unsigned)(R * K + C) * 2u; voffB[i] = (unsigned)(Rb * K + C) * 2u; }
    const size_t kstep = (size_t)(BK * 2);
    const size_t hstep = (size_t)HALF * K * 2;
    const size_t tstep = 2 * hstep;
    const unsigned ldsw = (unsigned)wid * 1024u;
    const int aoff = lds_byte(wr * 64 + fr, fq * 8), boff = lds_byte(wc * 32 + fr, fq * 8);
#define PG8_SA(b, h) (((b) * 2 + (h)) * HTB)
#define PG8_SB(b, h) ((4 + (b) * 2 + (h)) * HTB)
#define PG8_STAGE(bufoff, gbase, voff) do { _Pragma("unroll") for (int _i = 0; _i < 2; ++_i) \
        __builtin_amdgcn_global_load_lds((const unsigned*)((const char*)(gbase) + (voff)[_i]), (PG8_LAS unsigned*)(lds + (bufoff) + ldsw + _i * 8192), 16, 0, 0); } while (0)
#define PG8_LDA(dst, b, h) do { _Pragma("unroll") for (int m = 0; m < 4; ++m) _Pragma("unroll") for (int k = 0; k < 2; ++k) dst[m][k] = *(const PG8_LAS bf16x8*)(lds + PG8_SA(b, h) + aoff + m * 2048 + k * 1024); } while (0)
#define PG8_LDB(dst, b, h) do { _Pragma("unroll") for (int n = 0; n < 2; ++n) _Pragma("unroll") for (int k = 0; k < 2; ++k) dst[n][k] = *(const PG8_LAS bf16x8*)(lds + PG8_SB(b, h) + boff + n * 2048 + k * 1024); } while (0)
#define PG8_MMA(ai, bj, At, Bt) do { __builtin_amdgcn_s_setprio(1); _Pragma("unroll") for (int m = 0; m < 4; ++m) _Pragma("unroll") for (int n = 0; n < 2; ++n) _Pragma("unroll") for (int k = 0; k < 2; ++k) \
        acc[ai][bj][m][n] = __builtin_amdgcn_mfma_f32_16x16x32_bf16(Bt[n][k], At[m][k], acc[ai][bj][m][n], 0, 0, 0); __builtin_amdgcn_s_setprio(0); } while (0)
#define PG8_WAIT_V(n) asm volatile("s_waitcnt vmcnt(" #n ")" ::: "memory")
#define PG8_WAIT_L(n) asm volatile("s_waitcnt lgkmcnt(" #n ")" ::: "memory")
#define PG8_BAR __builtin_amdgcn_s_barrier()
#define PG8_SCHED __builtin_amdgcn_sched_barrier(0)
    Unit cur, nxt; int ui = 0;
    if (!S.next(0, cur)) return;
    f32x4 acc[2][2][4][2];
#pragma unroll
    for (int a = 0; a < 2; ++a)
#pragma unroll
        for (int b = 0; b < 2; ++b)
#pragma unroll
            for (int m = 0; m < 4; ++m)
#pragma unroll
                for (int n = 0; n < 2; ++n) acc[a][b][m][n] = (f32x4){0.f, 0.f, 0.f, 0.f};
    bf16x8 At[4][2], B0[2][2], B1[2][2];
    const char* cA = (const char*)g.A + (size_t)cur.pm * tstep; const char* cB = (const char*)g.Bt + (size_t)cur.pn * tstep;
    S.a_ready(cur);
    if constexpr (SP2) {
        PG8_STAGE(PG8_SB(0, 0), cB, voffB); PG8_STAGE(PG8_SB(0, 1), cB + hstep, voffB); PG8_STAGE(PG8_SA(0, 0), cA, voffA); PG8_STAGE(PG8_SA(0, 1), cA + hstep, voffA);
        if (wr == 1) PG8_BAR;
        PG8_WAIT_V(2); PG8_BAR;
        PG8_STAGE(PG8_SB(1, 0), cB + kstep, voffB); PG8_STAGE(PG8_SA(1, 0), cA + kstep, voffA); PG8_STAGE(PG8_SB(1, 1), cB + hstep + kstep, voffB);
        PG8_WAIT_V(6); PG8_BAR;
    } else {
        PG8_STAGE(PG8_SB(0, 0), cB, voffB); PG8_STAGE(PG8_SA(0, 0), cA, voffA); PG8_STAGE(PG8_SB(0, 1), cB + hstep, voffB); PG8_STAGE(PG8_SA(0, 1), cA + hstep, voffA);
        if (wr == 1) PG8_BAR;
        PG8_WAIT_V(4); PG8_BAR;
        PG8_STAGE(PG8_SB(1, 0), cB + kstep, voffB); PG8_STAGE(PG8_SA(1, 0), cA + kstep, voffA); PG8_STAGE(PG8_SB(1, 1), cB + hstep + kstep, voffB);
        PG8_WAIT_V(6); PG8_BAR;
    }
    for (;;) {
        const bool has_next = S.next(ui + 1, nxt);
        const char* nA = has_next ? (const char*)g.A + (size_t)nxt.pm * tstep : cA; const char* nB = has_next ? (const char*)g.Bt + (size_t)nxt.pn * tstep : cB;
        for (int t = 0; t < nt; t += 2) {
            const bool last = (t == nt - 2);
            const char* a1 = cA + (size_t)(t + 1) * kstep;
            const char* a2 = last ? nA : cA + (size_t)(t + 2) * kstep; const char* b2 = last ? nB : cB + (size_t)(t + 2) * kstep;
            const char* a3 = a2 + kstep; const char* b3 = b2 + kstep;
            if (last && has_next) S.a_ready(nxt);
            if constexpr (SP2) {
            PG8_LDB(B0, 0, 0); PG8_LDB(B1, 0, 1); PG8_SCHED; PG8_LDA(At, 0, 0); PG8_STAGE(PG8_SA(1, 1), a1 + hstep, voffA);
            PG8_WAIT_V(8); PG8_WAIT_L(0); PG8_BAR; PG8_MMA(0, 0, At, B0); PG8_MMA(0, 1, At, B1); PG8_BAR; PG8_SCHED;
            PG8_LDA(At, 0, 1); PG8_STAGE(PG8_SB(0, 0), b2, voffB); PG8_STAGE(PG8_SB(0, 1), b2 + hstep, voffB); PG8_STAGE(PG8_SA(0, 0), a2, voffA);
            PG8_WAIT_V(8); PG8_WAIT_L(0); PG8_BAR; PG8_MMA(1, 0, At, B0); PG8_MMA(1, 1, At, B1); PG8_BAR; PG8_SCHED;
            PG8_LDB(B0, 1, 0); PG8_LDB(B1, 1, 1); PG8_SCHED; PG8_LDA(At, 1, 0); PG8_STAGE(PG8_SA(0, 1), a2 + hstep, voffA);
            PG8_WAIT_V(8); PG8_WAIT_L(0); PG8_BAR; PG8_MMA(0, 0, At, B0); PG8_MMA(0, 1, At, B1); PG8_BAR; PG8_SCHED;
            PG8_LDA(At, 1, 1); PG8_STAGE(PG8_SB(1, 0), b3, voffB); PG8_STAGE(PG8_SB(1, 1), b3 + hstep, voffB); PG8_STAGE(PG8_SA(1, 0), a3, voffA);
            PG8_WAIT_V(8); PG8_WAIT_L(0); PG8_BAR; PG8_MMA(1, 0, At, B0); PG8_MMA(1, 1, At, B1); PG8_BAR; PG8_SCHED;
            } else {
            PG8_LDB(B0, 0, 0); PG8_SCHED; PG8_LDA(At, 0, 0); PG8_STAGE(PG8_SA(1, 1), a1 + hstep, voffA);
            PG8_WAIT_L(8); PG8_BAR; PG8_WAIT_L(0); PG8_MMA(0, 0, At, B0); PG8_BAR; PG8_SCHED;
            PG8_LDB(B1, 0, 1); PG8_STAGE(PG8_SB(0, 0), b2, voffB);
            PG8_BAR; PG8_WAIT_L(0); PG8_MMA(0, 1, At, B1); PG8_BAR;
            PG8_LDA(At, 0, 1); PG8_STAGE(PG8_SA(0, 0), a2, voffA);
            PG8_BAR; PG8_WAIT_L(0); PG8_MMA(1, 0, At, B0); PG8_BAR; PG8_SCHED;
            PG8_STAGE(PG8_SB(0, 1), b2 + hstep, voffB);
            PG8_WAIT_V(6); PG8_BAR; PG8_MMA(1, 1, At, B1); PG8_BAR;
            PG8_LDB(B0, 1, 0); PG8_SCHED; PG8_LDA(At, 1, 0); PG8_STAGE(PG8_SA(0, 1), a2 + hstep, voffA);
            PG8_WAIT_L(8); PG8_BAR; PG8_WAIT_L(0); PG8_MMA(0, 0, At, B0); PG8_BAR; PG8_SCHED;
            PG8_LDB(B1, 1, 1); PG8_STAGE(PG8_SB(1, 0), b3, voffB);
            PG8_BAR; PG8_WAIT_L(0); PG8_MMA(0, 1, At, B1); PG8_BAR;
            PG8_LDA(At, 1, 1); PG8_STAGE(PG8_SA(1, 0), a3, voffA);
            PG8_BAR; PG8_WAIT_L(0); PG8_MMA(1, 0, At, B0); PG8_BAR; PG8_SCHED;
            PG8_STAGE(PG8_SB(1, 1), b3 + hstep, voffB);
            PG8_WAIT_V(6); PG8_BAR; PG8_MMA(1, 1, At, B1); PG8_BAR;
            }
        }
        if constexpr (ALIGN_EPI) { if (wr == 0) PG8_BAR; }
        if constexpr (!Epi::AFTER_DRAIN) { E(acc, cur, wr, wc, fr, fq); S.done(cur); }
        if (!has_next) break;
#pragma unroll
        for (int a = 0; a < 2; ++a)
#pragma unroll
            for (int b = 0; b < 2; ++b)
#pragma unroll
                for (int m = 0; m < 4; ++m)
#pragma unroll
                    for (int n = 0; n < 2; ++n) acc[a][b][m][n] = (f32x4){0.f, 0.f, 0.f, 0.f};
        cur = nxt; cA = nA; cB = nB; ++ui;
        if constexpr (ALIGN_EPI) { if (wr == 1) PG8_BAR; }
    }
    PG8_WAIT_V(0);
    if constexpr (!ALIGN_EPI) { if (wr == 0) PG8_BAR; }
    PG8_BAR;
    if constexpr (Epi::AFTER_DRAIN) { E.fused(acc, cur, wr, wc, fr, fq, lds, wid, lane); S.done(cur); }
#undef PG8_SA
#undef PG8_SB
#undef PG8_STAGE
#undef PG8_LDA
#undef PG8_LDB
#undef PG8_MMA
#undef PG8_WAIT_V
#undef PG8_WAIT_L
#undef PG8_BAR
#undef PG8_SCHED
}
}

constexpr int DM = 1024, NB = 8, SEQ = 2048, NMETA = 16, LP = SEQ + NMETA, DB = 128, TS = 4;
constexpr int MP = NB * LP, MS = DB * TS, MV = MP + MS, MPAD = 17152;
constexpr int NH = 4, HD = 128, QKD = 64, AW = 512, SW = 512, NG = 32, SG = 16, NST = 64, FF = 2816, PWID = 2048;
constexpr int NPG = 16, PAGE = 128;
constexpr float EPS = 1e-6f;
constexpr float QSCALE = 0.125f * 1.4426950408889634f;
constexpr float LAM_INIT = 0.2f;
constexpr size_t O_YP = 0, O_YS = O_YP + (size_t)NB * SEQ * DM, O_KP = O_YS + (size_t)MS * DM, O_VP = O_KP + (size_t)MP * 512,
                 O_KS = O_VP + (size_t)MP * 512, O_VS = O_KS + (size_t)MS * 512, O_SRP = O_VS + (size_t)MS * 512, O_SIP = O_SRP + NB * NG * NST,
                 O_SRS = O_SIP + NB * NG * NST, O_SIS = O_SRS + DB * NG * NST, O_CP = O_SIS + DB * NG * NST, O_CS = O_CP + (size_t)NB * 2 * FF,
                 O_END = O_CS + (size_t)DB * 2 * FF;
enum { I_XP = 0, I_XS, I_CK, I_CV, I_SRE, I_SIM, I_SCONV, I_PT, I_META, I_N1, I_WIN, I_QN, I_KN, I_LQ, I_LK, I_SUBN, I_ARE, I_AIM, I_LDT, I_BRE, I_BIM,
       I_CRE, I_CIM, I_DSK, I_WGLU, I_BGLU, I_WOUT, I_N2, I_WGATE, I_WUP, I_CW, I_CB, I_WDOWN, N_IN };

constexpr size_t MiB = 1u << 20;
constexpr size_t WS_CTL = 0, CTL_ZERO_BYTES = 1 * MiB;
constexpr size_t WS_PAR = 1 * MiB;
constexpr size_t WS_WIN = 2 * MiB, WS_WGLU = 6 * MiB, WS_WOUT = 7 * MiB, WS_WGATE = 9 * MiB, WS_WUP = 15 * MiB, WS_WDOWN = 21 * MiB;
constexpr size_t WS_XN = 32 * MiB;
constexpr size_t WS_QB = 66 * MiB, WS_KB = 83 * MiB, WS_VB = 100 * MiB, WS_UB = 117 * MiB;
constexpr size_t WS_MIX = 134 * MiB;
constexpr size_t WS_G = 168 * MiB;
constexpr size_t WS_X1 = 185 * MiB;
constexpr size_t WS_A = 252 * MiB;
constexpr size_t WS_H = 345 * MiB;
constexpr size_t WS_SLO = 438 * MiB, WS_SLL = 447 * MiB, WS_END = 448 * MiB;
constexpr int CW_BAR = 4096;
constexpr int CW_QUEUE = 8192;
constexpr int CW_ROWSS = 16384;
static_assert((CW_ROWSS + MPAD) * 4 <= (int)CTL_ZERO_BYTES, "ctl");
constexpr int PA_ABR = 0, PA_ABI = 2048, PA_BBR = 4096, PA_BBI = 4096 + 32768, PA_LAM = 4096 + 65536;

constexpr int RING_BYTES = 131072;
constexpr int LDS_BYTES = 147456;
constexpr int MISC_OFF = LDS_BYTES - 512;

#define GAS __attribute__((address_space(1)))
#define LAS __attribute__((address_space(3)))
typedef unsigned short bf16;
typedef unsigned v4u __attribute__((ext_vector_type(4)));
typedef unsigned v2u __attribute__((ext_vector_type(2)));
typedef float f32x4 __attribute__((ext_vector_type(4)));
typedef float f32x2 __attribute__((ext_vector_type(2)));
typedef float f32x16 __attribute__((ext_vector_type(16)));
typedef short bf16x8 __attribute__((ext_vector_type(8)));
typedef short s16x4 __attribute__((ext_vector_type(4)));
typedef GAS unsigned gu32;
#define RLX_AGENT __ATOMIC_RELAXED, __HIP_MEMORY_SCOPE_AGENT
#define LDS_WAIT() asm volatile("s_waitcnt lgkmcnt(0)" ::: "memory")
#define VM_WAIT() asm volatile("s_waitcnt vmcnt(0)" ::: "memory")
__device__ __forceinline__ unsigned f2bf(float f) { unsigned u = __builtin_bit_cast(unsigned, f); return (u + 0x7fffu + ((u >> 16) & 1u)) >> 16; }
__device__ __forceinline__ unsigned pk2(float lo, float hi) { return f2bf(lo) | (f2bf(hi) << 16); }
__device__ __forceinline__ float bf2f(unsigned short b) { return __builtin_bit_cast(float, (unsigned)b << 16); }
__device__ __forceinline__ unsigned cvtpk(float lo, float hi) { unsigned r; asm volatile("v_cvt_pk_bf16_f32 %0, %1, %2" : "=v"(r) : "v"(lo), "v"(hi)); return r; }
__device__ __forceinline__ float gelu_tanh(float x) {
    const float z = x * (1.0f + 0.044715f * x * x);
    const float e = __builtin_amdgcn_exp2f(z * (-2.0f * 0.7978845608028654f * 1.4426950408889634f));
    return x * __builtin_amdgcn_rcpf(1.0f + e);
}
__device__ __forceinline__ float wave_sum(float v) {
#pragma unroll
    for (int o = 1; o < 64; o <<= 1) v += __shfl_xor(v, o);
    return v;
}

#define XB_TMO      128
#define XB_XCNT(j)  (256  + 64 * (j))
#define XB_XSUB(j)  (1280 + 64 * (j))
#define XB_XGEN(j)  (2304 + 64 * (j))
#define XB_TOP      3328
#define XB_TOPGEN   3392
#define XCD_BAR_WORDS 3456
#define XB_SPIN_CAP (1u << 18)
__device__ __forceinline__ unsigned xb_ld(unsigned* p)              { return __hip_atomic_load(p, __ATOMIC_RELAXED, __HIP_MEMORY_SCOPE_AGENT); }
__device__ __forceinline__ unsigned xb_add(unsigned* p, unsigned v) { return __hip_atomic_fetch_add(p, v, __ATOMIC_RELAXED, __HIP_MEMORY_SCOPE_AGENT); }
__device__ __forceinline__ unsigned xb_xcc_id() { return (unsigned)__builtin_amdgcn_s_getreg((3 << 11) | 20) & 0xFu; }
#define XB_SPIN(cond, bar) do { unsigned _sp = 0; while (cond) { __builtin_amdgcn_s_sleep(1); \
    if ((++_sp & 255u) == 0u) { if (xb_ld(&(bar)[XB_TMO])) break; if (_sp > XB_SPIN_CAP) { atomicAdd(&(bar)[XB_TMO], 1u); break; } } } } while (0)
struct XcdBarrier { unsigned* bar; unsigned x; volatile LAS unsigned* st; };
__device__ __forceinline__ XcdBarrier xcd_barrier_post(unsigned* bar, volatile LAS unsigned* st) {
    XcdBarrier b; b.bar = bar; b.x = xb_xcc_id(); b.st = st;
    if (threadIdx.x == 0) (void)xb_add(&bar[XB_XCNT(b.x)], 1u);
    return b;
}
__device__ __forceinline__ void xcd_barrier_complete(unsigned* bar, unsigned x, unsigned& nloc, unsigned& nx) {
    const unsigned G = gridDim.x * gridDim.y * gridDim.z;
    unsigned sum, cnt, mine, sp = 0u;
    for (;;) {
        sum = 0u; cnt = 0u; mine = 0u;
#pragma unroll
        for (unsigned j = 0; j < 16; ++j) { const unsigned c = xb_ld(&bar[XB_XCNT(j)]); sum += c; cnt += (c > 0u) ? 1u : 0u; mine = (j == x) ? c : mine; }
        if (sum == G) break;
        __builtin_amdgcn_s_sleep(1);
        if ((++sp & 255u) == 0u) { if (xb_ld(&bar[XB_TMO])) break; if (sp > XB_SPIN_CAP) { atomicAdd(&bar[XB_TMO], 1u); break; } }
    }
    nloc = mine > 0u ? mine : 1u; nx = cnt > 0u ? cnt : 1u;
}
__device__ __forceinline__ void xcd_barrier(const XcdBarrier& b) {
    asm volatile("s_waitcnt vmcnt(0)" ::: "memory");
    __syncthreads();
    if (threadIdx.x == 0) {
        unsigned* bar = b.bar;
        __builtin_amdgcn_s_waitcnt(0);
        unsigned nloc = b.st[0], nx = b.st[1];
        if (nloc == 0u) { xcd_barrier_complete(bar, b.x, nloc, nx); b.st[0] = nloc; b.st[1] = nx; }
        const unsigned old = xb_add(&bar[XB_XSUB(b.x)], 1u);
        const unsigned gen = old / nloc;
        if (old + 1u == (gen + 1u) * nloc) {
            __builtin_amdgcn_fence(__ATOMIC_RELEASE, "agent");
            asm volatile("s_waitcnt vmcnt(0)" ::: "memory");
            const unsigned og = xb_add(&bar[XB_TOP], 1u);
            const unsigned tg = og / nx;
            if (og + 1u == (tg + 1u) * nx) xb_add(&bar[XB_TOPGEN], 1u);
            else XB_SPIN(xb_ld(&bar[XB_TOPGEN]) == tg, bar);
            __builtin_amdgcn_fence(__ATOMIC_ACQUIRE, "agent");
            xb_add(&bar[XB_XGEN(b.x)], 1u);
            asm volatile("s_waitcnt vmcnt(0)" ::: "memory");
        } else {
            XB_SPIN(xb_ld(&bar[XB_XGEN(b.x)]) == gen, bar);
            __builtin_amdgcn_fence(__ATOMIC_ACQUIRE, "agent");
            asm volatile("s_waitcnt vmcnt(0)" ::: "memory");
        }
    }
    __syncthreads();
}

struct Frame {
    LAS unsigned char* lds;
    volatile LAS unsigned* MISC;
    gu32* ctl;
    int tid, lane, wave, vcu, G;
    const float* in[N_IN];
    float* out;
    unsigned char* ws;
    bf16 *WIN_t, *WGLU_t, *WOUT_t, *WGATE_t, *WUP_t, *WDOWN_t;
    bf16 *XN, *QB, *KB, *VB, *UB, *MIX, *GB, *AB, *HB;
    float *X1, *PAR, *ROWSS, *SLO, *SLL;
};

__device__ __forceinline__ const float* xin_row(const Frame& F, int m) {
    if (m < MP) { const int b = m / LP, t = m - b * LP; return t < NMETA ? F.in[I_META] + (size_t)t * DM : F.in[I_XP] + ((size_t)b * SEQ + (t - NMETA)) * DM; }
    if (m < MV) return F.in[I_XS] + (size_t)(m - MP) * DM;
    return nullptr;
}

__device__ __forceinline__ void p0_tr_item(const float* W, int K, int N, bf16* WT, LAS float* scr, int item, int lane, const float* kscale, bool permqk) {
    const int nblk = N / 32, kb = item / nblk, nb = item % nblk, k0 = 64 * kb, n0 = 32 * nb;
#pragma unroll 8
    for (int i = 0; i < 32; ++i) { const int kk = 2 * i + (lane >> 5); float v = W[(size_t)(k0 + kk) * N + n0 + (lane & 31)]; if (kscale) v *= kscale[k0 + kk]; scr[kk * 33 + (lane & 31)] = v; }
    LDS_WAIT(); asm volatile("" ::: "memory");
    int prow0 = n0;
    if (permqk && n0 < 1024) { const int pn = n0 >> 8, lb = (n0 & 255) >> 5, wc = lb >> 1, bj = lb & 1; prow0 = 256 * pn + 128 * bj + 32 * wc; }
    const int c = lane & 7;
#pragma unroll
    for (int j = 0; j < 4; ++j) { const int n = (lane >> 3) + 8 * j; const LAS float* s = scr + (8 * c) * 33 + n;
        v4u o; o.x = pk2(s[0 * 33], s[1 * 33]); o.y = pk2(s[2 * 33], s[3 * 33]); o.z = pk2(s[4 * 33], s[5 * 33]); o.w = pk2(s[6 * 33], s[7 * 33]);
        *(GAS v4u*)(WT + (size_t)(prow0 + n) * K + k0 + 8 * c) = o; }
    LDS_WAIT(); asm volatile("" ::: "memory");
}
__device__ __forceinline__ void p0_prologue(Frame& F) {
    LAS float* scr = (LAS float*)(F.lds + F.wave * 16384);
    int lane_ = F.lane; asm volatile("" : "+v"(lane_));
    const int gw = F.vcu * 8 + F.wave, NGW = F.G * 8, lane = lane_;
    constexpr int I_1 = (DM / 64) * (PWID / 32), I_2 = (SW / 64) * (SW / 32), I_3 = (DM / 64) * (DM / 32), I_4 = (DM / 64) * (FF / 32), I_5 = I_4, I_6 = (FF / 64) * (DM / 32);
    constexpr int NITEMS = I_1 + I_2 + I_3 + I_4 + I_5 + I_6;
    for (int it = gw; it < NITEMS; it += NGW) {
        int r = it;
        if (r < I_1) { p0_tr_item(F.in[I_WIN], DM, PWID, F.WIN_t, scr, r, lane, nullptr, true); continue; } r -= I_1;
        if (r < I_2) { p0_tr_item(F.in[I_WGLU], SW, SW, F.WGLU_t, scr, r, lane, nullptr, false); continue; } r -= I_2;
        if (r < I_3) { p0_tr_item(F.in[I_WOUT], DM, DM, F.WOUT_t, scr, r, lane, nullptr, false); continue; } r -= I_3;
        if (r < I_4) { p0_tr_item(F.in[I_WGATE], DM, FF, F.WGATE_t, scr, r, lane, F.in[I_N2], false); continue; } r -= I_4;
        if (r < I_5) { p0_tr_item(F.in[I_WUP], DM, FF, F.WUP_t, scr, r, lane, F.in[I_N2], false); continue; } r -= I_5;
        p0_tr_item(F.in[I_WDOWN], FF, DM, F.WDOWN_t, scr, r, lane, nullptr, false);
    }
    {
        const GAS f32x4* g1 = (const GAS f32x4*)F.in[I_N1] + lane;
        f32x4 gv[4];
#pragma unroll
        for (int j = 0; j < 4; ++j) gv[j] = g1[64 * j];
        for (int m = gw; m < MPAD; m += NGW) {
            const float* src = xin_row(F, m);
            GAS unsigned long long* o8 = (GAS unsigned long long*)(F.XN + (size_t)m * DM) + lane;
            if (!src) {
#pragma unroll
                for (int j = 0; j < 4; ++j) o8[64 * j] = 0ull;
                continue; }
            const GAS f32x4* xr = (const GAS f32x4*)src + lane;
            f32x4 v[4]; float s = 0.f;
#pragma unroll
            for (int j = 0; j < 4; ++j) { v[j] = xr[64 * j]; s += (v[j].x * v[j].x + v[j].y * v[j].y) + (v[j].z * v[j].z + v[j].w * v[j].w); }
            const float r = rsqrtf(wave_sum(s) * (1.f / DM) + EPS);
#pragma unroll
            for (int j = 0; j < 4; ++j) { const f32x4 y = (v[j] * r) * gv[j]; o8[64 * j] = (unsigned long long)pk2(y.x, y.y) | ((unsigned long long)pk2(y.z, y.w) << 32); }
        }
    }
    if (gw < 32) {
        const int gp = gw * 64 + lane, g = gp >> 6;
        const float dt = expf(F.in[I_LDT][g]);
        const float ar = F.in[I_ARE][gp], ai = F.in[I_AIM][gp];
        const float mag = expf(ar * dt), abr = mag * cosf(ai * dt), abi = mag * sinf(ai * dt);
        const float den = ar * ar + ai * ai, nr = abr - 1.0f, ni = abi;
        const float gr = (nr * ar + ni * ai) / den, gi = (ni * ar - nr * ai) / den;
        F.PAR[PA_ABR + gp] = abr; F.PAR[PA_ABI + gp] = abi;
#pragma unroll
        for (int c = 0; c < 16; ++c) { const float br = F.in[I_BRE][gp * 16 + c], bi = F.in[I_BIM][gp * 16 + c];
            F.PAR[PA_BBR + gp * 16 + c] = gr * br - gi * bi; F.PAR[PA_BBI + gp * 16 + c] = gr * bi + gi * br; }
    } else if (gw == 32) {
        const float s0 = wave_sum(F.in[I_LQ][lane] * F.in[I_LK][lane]), s1 = wave_sum(F.in[I_LQ][64 + lane] * F.in[I_LK][64 + lane]);
        if (lane == 0) F.PAR[PA_LAM] = expf(s0) - expf(s1) + LAM_INIT;
    }
}

using pg8::Unit; using pg8::HALF; using pg8::BM;

struct EpiProj {
    static constexpr bool PERM = false, AFTER_DRAIN = false;
    bf16 *qb, *kb, *vb, *ub; float* out; const float *qn, *kn;
    __device__ __forceinline__ void operator()(const f32x4 (&acc)[2][2][4][2], const Unit& u, int wr, int wc, int fr, int fq) const {
        const int tt = u.pn >> 1, half = u.pn & 1;
        const int row0 = u.pm * BM + wr * 64 + fr;
        if (tt < 2) {
            const float* gsrc = (tt == 0 ? qn : kn) + (wc & 1) * 64 + 4 * fq;
            const float sc = (tt == 0) ? QSCALE : 1.0f;
            f32x4 gv[2][2];
#pragma unroll
            for (int bj = 0; bj < 2; ++bj)
#pragma unroll
                for (int n = 0; n < 2; ++n) gv[bj][n] = *(const f32x4*)(gsrc + 32 * bj + 16 * n) * sc;
            bf16* dstb = (tt == 0) ? qb : kb;
            const int colL = 256 * half + 64 * wc + 4 * fq;
#pragma unroll
            for (int ai = 0; ai < 2; ++ai)
#pragma unroll
                for (int m = 0; m < 4; ++m) {
                    float ss = 0.f;
#pragma unroll
                    for (int bj = 0; bj < 2; ++bj)
#pragma unroll
                        for (int n = 0; n < 2; ++n) { const f32x4 x = acc[ai][bj][m][n]; ss += (x[0] * x[0] + x[1] * x[1]) + (x[2] * x[2] + x[3] * x[3]); }
                    ss += __shfl_xor(ss, 16); ss += __shfl_xor(ss, 32);
                    const float r = rsqrtf(ss * (1.0f / 64.0f) + EPS);
                    const int row = row0 + ai * HALF + m * 16;
                    float* fo = nullptr;
                    if (tt == 1) { if (row < MP) fo = out + O_KP + (size_t)row * 512; else if (row < MV) fo = out + O_KS + (size_t)(row - MP) * 512; }
#pragma unroll
                    for (int bj = 0; bj < 2; ++bj)
#pragma unroll
                        for (int n = 0; n < 2; ++n) { const f32x4 kf = (acc[ai][bj][m][n] * r);
                            const f32x4 v = kf * gv[bj][n]; const int col = colL + 32 * bj + 16 * n;
                            v2u w; w.x = pk2(v[0], v[1]); w.y = pk2(v[2], v[3]); *(v2u*)(dstb + (size_t)row * 512 + col) = w;
                            if (fo) *(f32x4*)(fo + col) = v; }
                }
        } else {
            bf16* dstb = (tt == 2) ? vb : ub;
            const int col0 = 256 * half + 32 * wc + 4 * fq;
#pragma unroll
            for (int ai = 0; ai < 2; ++ai)
#pragma unroll
                for (int m = 0; m < 4; ++m) {
                    const int row = row0 + ai * HALF + m * 16;
                    float* fo = nullptr;
                    if (tt == 2) { if (row < MP) fo = out + O_VP + (size_t)row * 512; else if (row < MV) fo = out + O_VS + (size_t)(row - MP) * 512; }
#pragma unroll
                    for (int bj = 0; bj < 2; ++bj)
#pragma unroll
                        for (int n = 0; n < 2; ++n) { const f32x4 v = acc[ai][bj][m][n]; const int col = col0 + 128 * bj + 16 * n;
                            v2u w; w.x = pk2(v[0], v[1]); w.y = pk2(v[2], v[3]); *(v2u*)(dstb + (size_t)row * 512 + col) = w;
                            if (fo) *(f32x4*)(fo + col) = v; }
                }
        }
    }
};

struct EpiGlu {
    static constexpr bool PERM = false, AFTER_DRAIN = false;
    const bf16* gb; bf16* mix; const float* bias;
    __device__ __forceinline__ void operator()(const f32x4 (&acc)[2][2][4][2], const Unit& u, int wr, int wc, int fr, int fq) const {
        const int row0 = u.pm * BM + wr * 64 + fr, col0 = u.pn * BM + wc * 32 + 4 * fq;
        f32x4 bv[2][2];
#pragma unroll
        for (int bj = 0; bj < 2; ++bj)
#pragma unroll
            for (int n = 0; n < 2; ++n) bv[bj][n] = *(const f32x4*)(bias + col0 + bj * HALF + n * 16);
#pragma unroll
        for (int ai = 0; ai < 2; ++ai)
#pragma unroll
            for (int m = 0; m < 4; ++m) { const int row = row0 + ai * HALF + m * 16;
#pragma unroll
                for (int bj = 0; bj < 2; ++bj)
#pragma unroll
                    for (int n = 0; n < 2; ++n) { const int col = col0 + bj * HALF + n * 16;
                        const f32x4 z = acc[ai][bj][m][n] + bv[bj][n];
                        const v2u gw = *(const v2u*)(gb + (size_t)row * 512 + col);
                        float gg[4] = { bf2f((unsigned short)(gw.x & 0xffffu)), bf2f((unsigned short)(gw.x >> 16)), bf2f((unsigned short)(gw.y & 0xffffu)), bf2f((unsigned short)(gw.y >> 16)) };
                        float o[4];
#pragma unroll
                        for (int e = 0; e < 4; ++e) o[e] = gg[e] * __builtin_amdgcn_rcpf(1.0f + __builtin_amdgcn_exp2f(-1.4426950408889634f * z[e]));
                        v2u w; w.x = pk2(o[0], o[1]); w.y = pk2(o[2], o[3]); *(v2u*)(mix + (size_t)row * DM + 512 + col) = w; }
            }
    }
};

struct EpiOut {
    static constexpr bool PERM = false, AFTER_DRAIN = false;
    const float *xp, *xs, *meta; float* x1; bf16* x1b; float* rowss;
    __device__ __forceinline__ void operator()(const f32x4 (&acc)[2][2][4][2], const Unit& u, int wr, int wc, int fr, int fq) const {
        const int row0 = u.pm * BM + wr * 64 + fr, col0 = u.pn * BM + wc * 32 + 4 * fq;
#pragma unroll
        for (int ai = 0; ai < 2; ++ai)
#pragma unroll
            for (int m = 0; m < 4; ++m) { const int row = row0 + ai * HALF + m * 16;
                const float* src = nullptr;
                if (row < MP) { const int b = row / LP, t = row - b * LP; src = t < NMETA ? meta + (size_t)t * DM : xp + ((size_t)b * SEQ + (t - NMETA)) * DM; }
                else if (row < MV) src = xs + (size_t)(row - MP) * DM;
                float ss = 0.f;
#pragma unroll
                for (int bj = 0; bj < 2; ++bj)
#pragma unroll
                    for (int n = 0; n < 2; ++n) { const int col = col0 + bj * HALF + n * 16;
                        f32x4 v = acc[ai][bj][m][n]; if (src) v += *(const f32x4*)(src + col);
                        ss += (v[0] * v[0] + v[1] * v[1]) + (v[2] * v[2] + v[3] * v[3]);
                        *(f32x4*)(x1 + (size_t)row * DM + col) = v;
                        v2u w; w.x = pk2(v[0], v[1]); w.y = pk2(v[2], v[3]); *(v2u*)(x1b + (size_t)row * DM + col) = w; }
                ss += __shfl_xor(ss, 16); ss += __shfl_xor(ss, 32);
                if (fq == 0) atomicAdd(rowss + row, ss);
            }
    }
};

struct EpiGate {
    static constexpr bool PERM = false, AFTER_DRAIN = false;
    const float* rowss; bf16* ab; float* out;
    __device__ __forceinline__ void operator()(const f32x4 (&acc)[2][2][4][2], const Unit& u, int wr, int wc, int fr, int fq) const {
        const int row0 = u.pm * BM + wr * 64 + fr, col0 = u.pn * BM + wc * 32 + 4 * fq;
#pragma unroll
        for (int ai = 0; ai < 2; ++ai)
#pragma unroll
            for (int m = 0; m < 4; ++m) { const int row = row0 + ai * HALF + m * 16;
                const float rs = rsqrtf(rowss[row] * (1.0f / DM) + EPS);
                float* fo = nullptr;
                if (row < MP) { const int b = row / LP, t = row - b * LP; if (t >= LP - 2) fo = out + O_CP + (size_t)(b * 2 + (t - (LP - 2))) * FF; }
                else if (row < MV) { const int db = (row - MP) >> 2, t = (row - MP) & 3; if (t >= 2) fo = out + O_CS + (size_t)(db * 2 + (t - 2)) * FF; }
#pragma unroll
                for (int bj = 0; bj < 2; ++bj)
#pragma unroll
                    for (int n = 0; n < 2; ++n) { const int col = col0 + bj * HALF + n * 16; const f32x4 v = acc[ai][bj][m][n] * rs;
                        v2u w; w.x = pk2(v[0], v[1]); w.y = pk2(v[2], v[3]); *(v2u*)(ab + (size_t)row * FF + col) = w;
                        if (fo) *(f32x4*)(fo + col) = v; }
            }
    }
};

__device__ __forceinline__ f32x4 ld_bf4(const bf16* p) { const v2u w = *(const v2u*)p; return (f32x4){ bf2f((unsigned short)(w.x & 0xffffu)), bf2f((unsigned short)(w.x >> 16)), bf2f((unsigned short)(w.y & 0xffffu)), bf2f((unsigned short)(w.y >> 16)) }; }

struct EpiUp {
    static constexpr bool PERM = false, AFTER_DRAIN = false;
    const float* rowss; const bf16* ab; bf16* hb; const float *cw, *cb, *hist;
    __device__ __forceinline__ void operator()(const f32x4 (&acc)[2][2][4][2], const Unit& u, int wr, int wc, int fr, int fq) const {
        const int row0 = u.pm * BM + wr * 64 + fr, col0 = u.pn * BM + wc * 32 + 4 * fq;
#pragma unroll
        for (int ai = 0; ai < 2; ++ai)
#pragma unroll
            for (int m = 0; m < 4; ++m) { const int row = row0 + ai * HALF + m * 16;
                const float rs = rsqrtf(rowss[row] * (1.0f / DM) + EPS);
                int t; const float* hs = nullptr;
                if (row < MP) { const int b = row / LP; t = row - b * LP; }
                else if (row < MV) { const int db = (row - MP) >> 2; t = (row - MP) & 3; hs = hist + (size_t)db * 2 * FF; }
                else t = 2;
#pragma unroll
                for (int bj = 0; bj < 2; ++bj)
#pragma unroll
                    for (int n = 0; n < 2; ++n) { const int col = col0 + bj * HALF + n * 16;
                        const f32x4 c = acc[ai][bj][m][n] * rs;
                        const f32x4 a0 = ld_bf4(ab + (size_t)row * FF + col);
                        f32x4 a1, a2;
                        if (t >= 1) a1 = ld_bf4(ab + (size_t)(row - 1) * FF + col); else a1 = hs ? *(const f32x4*)(hs + FF + col) : (f32x4){0.f, 0.f, 0.f, 0.f};
                        if (t >= 2) a2 = ld_bf4(ab + (size_t)(row - 2) * FF + col); else a2 = hs ? *(const f32x4*)(hs + (size_t)t * FF + col) : (f32x4){0.f, 0.f, 0.f, 0.f};
                        const f32x4 w0 = *(const f32x4*)(cw + col), w1 = *(const f32x4*)(cw + FF + col), w2 = *(const f32x4*)(cw + 2 * FF + col), bb = *(const f32x4*)(cb + col);
                        const f32x4 cv = bb + w0 * a2 + w1 * a1 + w2 * a0;
                        float o[4];
#pragma unroll
                        for (int e = 0; e < 4; ++e) o[e] = gelu_tanh(cv[e]) * c[e];
                        v2u w; w.x = pk2(o[0], o[1]); w.y = pk2(o[2], o[3]); *(v2u*)(hb + (size_t)row * FF + col) = w; }
            }
    }
};

struct EpiDown {
    static constexpr bool PERM = false, AFTER_DRAIN = false;
    const float* x1; float* out;
    __device__ __forceinline__ void operator()(const f32x4 (&acc)[2][2][4][2], const Unit& u, int wr, int wc, int fr, int fq) const {
        const int row0 = u.pm * BM + wr * 64 + fr, col0 = u.pn * BM + wc * 32 + 4 * fq;
#pragma unroll
        for (int ai = 0; ai < 2; ++ai)
#pragma unroll
            for (int m = 0; m < 4; ++m) { const int row = row0 + ai * HALF + m * 16;
                float* fo = nullptr;
                if (row < MP) { const int b = row / LP, t = row - b * LP; if (t >= NMETA) fo = out + O_YP + ((size_t)b * SEQ + (t - NMETA)) * DM; }
                else if (row < MV) fo = out + O_YS + (size_t)(row - MP) * DM;
                if (fo) {
#pragma unroll
                    for (int bj = 0; bj < 2; ++bj)
#pragma unroll
                        for (int n = 0; n < 2; ++n) { const int col = col0 + bj * HALF + n * 16;
                            *(f32x4*)(fo + col) = acc[ai][bj][m][n] + *(const f32x4*)(x1 + (size_t)row * DM + col); }
                }
            }
    }
};

typedef LAS const char* lds_cptr;
__device__ __forceinline__ unsigned off_b(unsigned row, unsigned ch) { return 256u * row + 16u * (ch ^ (((row & 3u) << 2) | ((row >> 2) & 3u))); }
__device__ __forceinline__ s16x4 vtr(lds_cptr p) { return __builtin_bit_cast(s16x4, __builtin_amdgcn_ds_read_tr16_b64_v4i16((LAS s16x4*)p)); }
__device__ __forceinline__ int crow(int r, int hi) { return (r & 3) + 8 * (r >> 2) + 4 * hi; }
#define MFMA32(a, b, c) __builtin_amdgcn_mfma_f32_32x32x16_bf16((a), (b), (c), 0, 0, 0)
#define MFMA16(a, b, c) __builtin_amdgcn_mfma_f32_16x16x32_bf16((a), (b), (c), 0, 0, 0)

constexpr int ATT_K = 0, ATT_V = 32768, ATT_WS = 65536, ATT_Q = 67584;
__device__ __forceinline__ void attn_unit(Frame& F, int b, int h, int qi) {
    int lane_ = F.lane; asm volatile("" : "+v"(lane_));
    const int lane = lane_, w = F.wave, r32 = lane & 31, hi = lane >> 5;
    const int rowb = b * LP;
    const int Q0 = NMETA + 256 * qi + 32 * w;
    const int NT = 4 * qi + 5;
    LAS unsigned char* lds = F.lds;
    { LAS unsigned char* Qw = lds + ATT_Q + 8192 * w + 16 * lane; const bf16* qp = F.QB + ((long)(rowb + Q0 + r32)) * 512 + h * 128 + hi * 8;
#pragma unroll
      for (int ks = 0; ks < 8; ++ks) *(LAS v4u*)(Qw + 1024 * ks) = *(const v4u*)(qp + ks * 16); }
    f32x16 o0[4], o1[4];
#pragma unroll
    for (int c = 0; c < 4; ++c) { o0[c] = (f32x16){}; o1[c] = (f32x16){}; }
    float l0 = 0.f, l1 = 0.f;
    const char* kg = (const char*)(F.KB + (size_t)rowb * 512 + h * 128);
    const char* vg = (const char*)(F.VB + (size_t)rowb * 512 + h * 128);
#define ATT_STAGE(j, buf) do { const char* kt_ = kg + (size_t)(64 * (j)) * 1024; const char* vt_ = vg + (size_t)(64 * (j)) * 1024; unsigned ln_ = lane; asm volatile("" : "+v"(ln_)); \
        _Pragma("unroll") for (int i_ = 0; i_ < 2; ++i_) { const unsigned row_ = 4u * (w + 8 * i_) + (ln_ >> 4), ch_ = (ln_ & 15) ^ (((row_ & 3u) << 2) | ((row_ >> 2) & 3u)); \
        const unsigned vr_ = (row_ & ~12u) | ((row_ & 4u) << 1) | ((row_ & 8u) >> 1); \
        __builtin_amdgcn_global_load_lds((const unsigned*)(kt_ + (row_ * 1024u + ch_ * 16u)), (LAS unsigned*)(lds + ATT_K + (buf) * 16384 + (w + 8 * i_) * 1024), 16, 0, 0); \
        __builtin_amdgcn_global_load_lds((const unsigned*)(vt_ + (vr_ * 1024u + ch_ * 16u)), (LAS unsigned*)(lds + ATT_V + (buf) * 16384 + (w + 8 * i_) * 1024), 16, 0, 0); } } while (0)
    ATT_STAGE(0, 0); VM_WAIT(); __syncthreads();
    for (int j = 0; j < NT; ++j) {
        const int buf = j & 1;
        if (j + 1 < NT) ATT_STAGE(j + 1, buf ^ 1);
        if (64 * j <= Q0 + 31) {
            const LAS unsigned char* Kb = lds + ATT_K + buf * 16384; const LAS unsigned char* Vb = lds + ATT_V + buf * 16384;
            const bool needmask = (64 * j + 63 > Q0);
            unsigned ln = lane; asm volatile("" : "+v"(ln));
            const unsigned r32v = ln & 31u, hiv = ln >> 5, blk = (ln >> 4) & 1u, qq = (ln & 15u) >> 2, pp = ln & 3u;
            const unsigned kra = off_b(r32v, hiv);
            const unsigned vba = off_b(8 * hiv + qq, 2 * blk + (pp >> 1)) + 8 * (pp & 1), vbb = off_b(8 * hiv + 4 + qq, 2 * blk + (pp >> 1)) + 8 * (pp & 1);
            const LAS unsigned char* Qw = lds + ATT_Q + 8192 * w + 16 * ln;
            const int qpos = Q0 + (int)r32v;
            bf16x8 pk0[4], pk1[4];
#define PK8(X, B) __builtin_bit_cast(bf16x8, (v4u){ cvtpk(X[B], X[B + 1]), cvtpk(X[B + 2], X[B + 3]), cvtpk(X[B + 4], X[B + 5]), cvtpk(X[B + 6], X[B + 7]) })
#define ATT_QK(KS0, HALF_, PK, LACC) do { f32x16 sa; \
                if (needmask) { _Pragma("unroll") for (int r = 0; r < 16; ++r) sa[r] = (64 * j + 32 * (HALF_) + crow(r, (int)hiv) > qpos) ? -1.0e30f : 0.f; } else sa = (f32x16){}; \
                _Pragma("unroll") for (int ks = (KS0); ks < (KS0) + 4; ++ks) { const bf16x8 qv = *(const LAS bf16x8*)(Qw + 1024 * ks); \
                    const bf16x8 a0 = *(const LAS bf16x8*)(Kb + 8192 * (HALF_) + (kra ^ (32u * ks))); \
                    sa = MFMA32(a0, qv, sa); } \
                float ls_ = 0.f; \
                _Pragma("unroll") for (int r = 0; r < 16; ++r) { sa[r] = __builtin_amdgcn_exp2f(sa[r]); ls_ += sa[r]; } \
                LACC += ls_; PK[2 * (HALF_)] = PK8(sa, 0); PK[2 * (HALF_) + 1] = PK8(sa, 8); } while (0)
            ATT_QK(0, 0, pk0, l0); __builtin_amdgcn_sched_barrier(0);
            ATT_QK(0, 1, pk0, l0); __builtin_amdgcn_sched_barrier(0);
            ATT_QK(4, 0, pk1, l1); __builtin_amdgcn_sched_barrier(0);
            ATT_QK(4, 1, pk1, l1); __builtin_amdgcn_sched_barrier(0);
#undef ATT_QK
#undef PK8
#pragma unroll
            for (int c = 0; c < 4; ++c)
#pragma unroll
                for (int ks = 0; ks < 4; ++ks) {
                    const s16x4 lo = vtr((lds_cptr)(Vb + (vba ^ (64u * c)) + 4096 * ks)), hh = vtr((lds_cptr)(Vb + (vbb ^ (64u * c)) + 4096 * ks));
                    const bf16x8 vf = (bf16x8){ lo[0], lo[1], lo[2], lo[3], hh[0], hh[1], hh[2], hh[3] };
                    o0[c] = MFMA32(pk0[ks], vf, o0[c]); o1[c] = MFMA32(pk1[ks], vf, o1[c]);
                    if (ks == 3) __builtin_amdgcn_sched_barrier(0);
                }
        }
        VM_WAIT(); __syncthreads();
    }
#undef ATT_STAGE
    const float lam = F.PAR[PA_LAM];
    l0 += __shfl_xor(l0, 32); l1 += __shfl_xor(l1, 32);
    LAS float* wsf = (LAS float*)(lds + ATT_WS) + w * 64;
    if (hi == 0) { wsf[r32] = l0; wsf[32 + r32] = l1; }
    LDS_WAIT(); asm volatile("" ::: "memory");
    const float* subn = F.in[I_SUBN];
    float sn[4];
#pragma unroll
    for (int c = 0; c < 4; ++c) sn[c] = subn[32 * c + r32] * (1.0f - LAM_INIT);
#pragma unroll
    for (int r = 0; r < 16; ++r) {
        const int qr = crow(r, hi);
        const float i0 = 1.0f / wsf[qr], i1 = lam / wsf[32 + qr];
        float v[4]; float ss = 0.f;
#pragma unroll
        for (int c = 0; c < 4; ++c) { v[c] = o0[c][r] * i0 - o1[c][r] * i1; ss += v[c] * v[c]; }
        ss += __shfl_xor(ss, 1); ss += __shfl_xor(ss, 2); ss += __shfl_xor(ss, 4); ss += __shfl_xor(ss, 8); ss += __shfl_xor(ss, 16);
        const float rn = rsqrtf(ss * (1.0f / 128.0f) + EPS);
        const int pos = Q0 + qr;
        if (pos >= 0) { bf16* dst = F.MIX + (size_t)(rowb + pos) * DM + h * 128 + r32;
#pragma unroll
            for (int c = 0; c < 4; ++c) dst[32 * c] = (bf16)f2bf(v[c] * rn * sn[c]); }
    }
    LDS_WAIT();
}

constexpr int NSL = 4, PPG = NPG / NSL;
constexpr int DEC_RED = 0, DEC_P = 0, DEC_Q = 16384;
__device__ __forceinline__ bf16x8 cvt8(const f32x4 a, const f32x4 b) { return __builtin_bit_cast(bf16x8, (v4u){ cvtpk(a[0], a[1]), cvtpk(a[2], a[3]), cvtpk(b[0], b[1]), cvtpk(b[2], b[3]) }); }
__device__ __forceinline__ f32x4 ldnt4(const float* p) { return __builtin_nontemporal_load((const f32x4*)p); }
__device__ __forceinline__ void decode_unit(Frame& F, int db, int pg) {
    int lane_ = F.lane; asm volatile("" : "+v"(lane_));
    const int lane = lane_, w = F.wave, col = lane & 15, kg = lane >> 4;
    LAS unsigned char* lds = F.lds;
    if (w < 4) {
        const int h = w;
#pragma unroll
        for (int kb = 0; kb < 4; ++kb) { v4u q = (v4u){0u, 0u, 0u, 0u};
            if (col < 8 && (col >> 2) == (kb >> 1)) q = *(const v4u*)(F.QB + (size_t)(MP + db * 4 + (col & 3)) * 512 + h * 128 + kb * 32 + kg * 8);
            *(LAS v4u*)(lds + DEC_Q + ((h * 4 + kb) * 64 + lane) * 16) = q; }
    }
    __syncthreads();
    const int hb = (w >> 2) * 2, hl = lane >> 5;
    f32x4 O[8];
#pragma unroll
    for (int c = 0; c < 8; ++c) O[c] = (f32x4){0.f, 0.f, 0.f, 0.f};
    float lsum[2] = {0.f, 0.f};
    const int* pt = (const int*)F.in[I_PT] + db * NPG + pg * PPG;
    LAS float* Pw = (LAS float*)(lds + DEC_P + 1024 * w);
    const LAS unsigned char* Qf = lds + DEC_Q + (hb * 4 * 64 + lane) * 16;
    const size_t koff = (size_t)(32 * (w & 3) + col) * 512 + hb * 128 + kg * 8;
    const size_t voff = (size_t)(32 * (w & 3)) * 512 + hb * 128 + 4 * lane;
    f32x4 bA[16], bB[16];
#define LD_K(KP) do { _Pragma("unroll") for (int i = 0; i < 8; ++i) { bA[2 * i] = ldnt4((KP) + koff + i * 32); bA[2 * i + 1] = ldnt4((KP) + koff + i * 32 + 4); } } while (0)
#define LD_V(VP) do { _Pragma("unroll") for (int i = 0; i < 16; ++i) bB[i] = ldnt4((VP) + voff + (size_t)i * 512); } while (0)
    int page = __builtin_amdgcn_readfirstlane(pt[0]);
    LD_K(F.in[I_CK] + (size_t)page * PAGE * 512);
    LD_V(F.in[I_CV] + (size_t)page * PAGE * 512);
#define DEC_BODY(GI, LOADNEXT) do { \
        const int gn = (GI) + 1; \
        const int npage = __builtin_amdgcn_readfirstlane(pt[(LOADNEXT) ? (gn >> 1) : 0]); \
        const float* nkp = F.in[I_CK] + ((size_t)npage * PAGE + 16 * (gn & 1)) * 512; \
        const float* nvp = F.in[I_CV] + ((size_t)npage * PAGE + 16 * (gn & 1)) * 512; \
        f32x4 acc[2]; \
        _Pragma("unroll") for (int hh = 0; hh < 2; ++hh) { f32x4 ac = (f32x4){0.f, 0.f, 0.f, 0.f}; \
            _Pragma("unroll") for (int kb = 0; kb < 4; ++kb) { const bf16x8 a = cvt8(bA[2 * (hh * 4 + kb)], bA[2 * (hh * 4 + kb) + 1]); \
                const bf16x8 bq = *(const LAS bf16x8*)(Qf + (hh * 4 + kb) * 1024); ac = MFMA16(a, bq, ac); } \
            acc[hh] = ac; } \
        __builtin_amdgcn_sched_barrier(0); \
        if (LOADNEXT) LD_K(nkp); \
        __builtin_amdgcn_sched_barrier(0); \
        if (col < 8) { \
            _Pragma("unroll") for (int hh = 0; hh < 2; ++hh) \
                _Pragma("unroll") for (int e = 0; e < 4; ++e) { const float p = __builtin_amdgcn_exp2f(acc[hh][e]); lsum[hh] += p; Pw[((4 * kg + e) * 2 + hh) * 8 + col] = p; } \
        } \
        LDS_WAIT(); asm volatile("" ::: "memory"); \
        __builtin_amdgcn_sched_barrier(0); \
        _Pragma("unroll") for (int s_ = 0; s_ < 16; ++s_) { \
            const f32x4 pa = *(const LAS f32x4*)(Pw + (s_ * 2 + hl) * 8), pb = *(const LAS f32x4*)(Pw + (s_ * 2 + hl) * 8 + 4); \
            _Pragma("unroll") for (int c = 0; c < 4; ++c) { O[c] += bB[s_] * pa[c]; O[4 + c] += bB[s_] * pb[c]; } \
        } \
        __builtin_amdgcn_sched_barrier(0); \
        if (LOADNEXT) LD_V(nvp); \
        LDS_WAIT(); asm volatile("" ::: "memory"); \
        __builtin_amdgcn_sched_barrier(0); \
    } while (0)
#pragma unroll 1
    for (int gi = 0; gi < 2 * PPG - 1; ++gi) DEC_BODY(gi, true);
    DEC_BODY(2 * PPG - 1, false);
#undef DEC_BODY
#undef LD_K
#undef LD_V
    __syncthreads();
#pragma unroll
    for (int c = 0; c < 8; ++c) *(LAS f32x4*)(lds + DEC_RED + ((w * 8 + c) * 64 + lane) * 16) = O[c];
#pragma unroll
    for (int hh = 0; hh < 2; ++hh) { float l = lsum[hh]; l += __shfl_xor(l, 16); l += __shfl_xor(l, 32); if (lane < 8) ((LAS float*)(lds + 131072))[(w * 2 + hh) * 8 + lane] = l; }
    __syncthreads();
    float* slab = F.SLO + ((size_t)(db * NSL + pg)) * 4096;
#pragma unroll
    for (int k = 0; k < 2; ++k) { const int sc = 2 * w + k, set = sc >> 3, cc = sc & 7;
        f32x4 s = (f32x4){0.f, 0.f, 0.f, 0.f};
#pragma unroll
        for (int ww = 0; ww < 4; ++ww) s += *(const LAS f32x4*)(lds + DEC_RED + (((4 * set + ww) * 8 + cc) * 64 + lane) * 16);
        const int h = 2 * set + hl;
        *(f32x4*)(slab + (h * 8 + cc) * 128 + 4 * (lane & 31)) = s; }
    if (w == 0 && lane < 32) { const int h = lane >> 3, cc = lane & 7; float s = 0.f;
#pragma unroll
        for (int ww = 0; ww < 4; ++ww) s += ((const LAS float*)(lds + 131072))[((4 * (h >> 1) + ww) * 2 + (h & 1)) * 8 + cc];
        F.SLL[(size_t)(db * NSL + pg) * 32 + lane] = s; }
    __syncthreads();
}

__device__ __forceinline__ void decode_final(Frame& F, int db, int h) {
    int lane_ = F.lane; asm volatile("" : "+v"(lane_));
    const int lane = lane_;
    const float lam = F.PAR[PA_LAM];
    const float sn0 = F.in[I_SUBN][2 * lane] * (1.0f - LAM_INIT), sn1 = F.in[I_SUBN][2 * lane + 1] * (1.0f - LAM_INIT);
    const int rbase = MP + db * 4;
    float vn0[4], vn1[4];
#pragma unroll
    for (int j = 0; j < 4; ++j) { const unsigned vw = *(const unsigned*)(F.VB + (size_t)(rbase + j) * 512 + h * 128 + 2 * lane); vn0[j] = bf2f((unsigned short)(vw & 0xffffu)); vn1[j] = bf2f((unsigned short)(vw >> 16)); }
#pragma unroll
    for (int tq = 0; tq < 4; ++tq) {
        float o[2][2], l[2];
#pragma unroll
        for (int c = 0; c < 2; ++c) {
            const int cc = 4 * c + tq;
            float a0 = 0.f, a1 = 0.f, ls = 0.f;
#pragma unroll
            for (int pg = 0; pg < NSL; ++pg) { const f32x2 t = *(const f32x2*)(F.SLO + ((size_t)(db * NSL + pg) * 32 + h * 8 + cc) * 128 + 2 * lane); a0 += t.x; a1 += t.y; ls += F.SLL[(size_t)(db * NSL + pg) * 32 + h * 8 + cc]; }
            const float qv = bf2f(F.QB[(size_t)(rbase + tq) * 512 + h * 128 + c * 64 + lane]);
#pragma unroll
            for (int j = 0; j < 4; ++j) if (j <= tq) {
                const float kv = bf2f(F.KB[(size_t)(rbase + j) * 512 + h * 128 + c * 64 + lane]);
                const float p = __builtin_amdgcn_exp2f(wave_sum(qv * kv));
                ls += p; a0 += p * vn0[j]; a1 += p * vn1[j]; }
            o[c][0] = a0; o[c][1] = a1; l[c] = ls;
        }
        const float i0 = 1.0f / l[0], i1 = lam / l[1];
        const float y0 = o[0][0] * i0 - o[1][0] * i1, y1 = o[0][1] * i0 - o[1][1] * i1;
        const float rn = rsqrtf(wave_sum(y0 * y0 + y1 * y1) * (1.0f / 128.0f) + EPS);
        *(unsigned*)(F.MIX + (size_t)(rbase + tq) * DM + h * 128 + 2 * lane) = pk2(y0 * rn * sn0, y1 * rn * sn1);
    }
}

constexpr int SSM_LE = 131072, SSM_CF = 139264, SSM_HP = 136;
__device__ __forceinline__ void ssm_unit(Frame& F, int b, int g) {
    int lane_ = F.lane; asm volatile("" : "+v"(lane_));
    const int lane = lane_, w = F.wave, r32 = lane & 31, hi = lane >> 5;
    LAS unsigned char* lds = F.lds;
    LAS float* X = (LAS float*)(lds + 16384 * w);
    LAS unsigned short* Hb = (LAS unsigned short*)(lds + 16384 * w);
    LAS float* LE = (LAS float*)(lds + SSM_LE);
    const int rowb = b * LP;
    const float ar = F.PAR[PA_ABR + g * 64 + lane], ai = F.PAR[PA_ABI + g * 64 + lane];
    float a32r = ar, a32i = ai;
#pragma unroll
    for (int i = 0; i < 5; ++i) { const float nr = a32r * a32r - a32i * a32i, ni = 2.0f * a32r * a32i; a32r = nr; a32i = ni; }
    bf16x8 Bf[2][2];
#pragma unroll
    for (int ri = 0; ri < 2; ++ri)
#pragma unroll
        for (int nb = 0; nb < 2; ++nb) { const float* s = F.PAR + (ri ? PA_BBI : PA_BBR) + ((g * 64 + 32 * nb + r32) * 16 + 8 * hi);
            Bf[ri][nb] = cvt8(*(const f32x4*)s, *(const f32x4*)(s + 4)); }
    const int cfl = (r32 & 15) | (hi << 4);
    if (w == 0 && r32 < 16) {
#pragma unroll
        for (int s = 0; s < 8; ++s) { const float* src = (s < 4 ? F.in[I_CRE] : F.in[I_CIM]) + ((size_t)(g * 16 + r32) * 64 + 16 * (s & 3) + 8 * hi);
            f32x4 x0 = *(const f32x4*)src, x1 = *(const f32x4*)(src + 4); if (s >= 4) { x0 = -x0; x1 = -x1; }
            *(LAS bf16x8*)(lds + SSM_CF + (s * 32 + cfl) * 16) = cvt8(x0, x1); }
    }
    __syncthreads();
    const float dsk = (r32 < 16) ? F.in[I_DSK][g * 16 + r32] : 0.f;
    float cr = 0.f, ci = 0.f;
    for (int it = 0; it < 9; ++it) {
        const int ck = 8 * it + w, t0 = 32 * ck;
        const bool active = ck < 65;
        float hlr[32], hli[32];
        float er = 0.f, ei = 0.f;
        if (active) {
            const bf16x8 A = *(const bf16x8*)(F.UB + (size_t)(rowb + t0 + r32) * 512 + 16 * g + 8 * hi);
            const f32x16 z = (f32x16){};
            const f32x16 xr0 = MFMA32(A, Bf[0][0], z), xr1 = MFMA32(A, Bf[0][1], z), xi0 = MFMA32(A, Bf[1][0], z), xi1 = MFMA32(A, Bf[1][1], z);
#pragma unroll
            for (int r = 0; r < 16; ++r) { const int t = crow(r, hi);
                X[t * 64 + r32] = xr0[r]; X[t * 64 + 32 + r32] = xr1[r]; X[2048 + t * 64 + r32] = xi0[r]; X[2048 + t * 64 + 32 + r32] = xi1[r]; }
            LDS_WAIT(); asm volatile("" ::: "memory");
#pragma unroll
            for (int t = 0; t < 32; ++t) { const float xr = X[t * 64 + lane], xi = X[2048 + t * 64 + lane];
                const float nr = ar * er - ai * ei + xr, ni = ar * ei + ai * er + xi; er = nr; ei = ni; hlr[t] = nr; hli[t] = ni; }
        }
        LE[((it & 1) * 8 + w) * 128 + lane] = er; LE[((it & 1) * 8 + w) * 128 + 64 + lane] = ei;
        LDS_WAIT(); __builtin_amdgcn_s_barrier(); asm volatile("" ::: "memory");
        float cinr = 0.f, cini = 0.f;
#pragma unroll
        for (int j = 0; j < 8; ++j) {
            if (j == w) { cinr = cr; cini = ci; }
            const float lr = LE[((it & 1) * 8 + j) * 128 + lane], li = LE[((it & 1) * 8 + j) * 128 + 64 + lane];
            const float nr = a32r * cr - a32i * ci + lr, ni = a32r * ci + a32i * cr + li; cr = nr; ci = ni;
        }
        if (active) {
            float pr = ar, pi = ai;
#pragma unroll
            for (int t = 0; t < 32; ++t) {
                const float hr = hlr[t] + pr * cinr - pi * cini, hq = hli[t] + pr * cini + pi * cinr;
                Hb[t * SSM_HP + lane] = (unsigned short)f2bf(hr); Hb[t * SSM_HP + 64 + lane] = (unsigned short)f2bf(hq);
                if (ck == 64 && t == 15) { F.out[O_SRP + (size_t)(b * NG + g) * 64 + lane] = hr; F.out[O_SIP + (size_t)(b * NG + g) * 64 + lane] = hq; }
                const float npr = pr * ar - pi * ai, npi = pr * ai + pi * ar; pr = npr; pi = npi;
            }
            LDS_WAIT(); asm volatile("" ::: "memory");
            f32x16 y = (f32x16){};
#pragma unroll
            for (int s = 0; s < 8; ++s) { const bf16x8 Af = *(const LAS bf16x8*)((LAS unsigned char*)Hb + r32 * (SSM_HP * 2) + (16 * s + 8 * hi) * 2);
                bf16x8 cf = *(const LAS bf16x8*)(lds + SSM_CF + (s * 32 + cfl) * 16); if (r32 >= 16) cf = (bf16x8){0, 0, 0, 0, 0, 0, 0, 0};
                y = MFMA32(Af, cf, y); }
            if (r32 < 16) {
#pragma unroll
                for (int r = 0; r < 16; ++r) { const int pos = t0 + crow(r, hi);
                    if (pos < LP) { const float uu = bf2f(F.UB[(size_t)(rowb + pos) * 512 + 16 * g + r32]);
                        F.GB[(size_t)(rowb + pos) * 512 + 16 * g + r32] = (bf16)f2bf(gelu_tanh(y[r] + dsk * uu)); } }
            }
            LDS_WAIT(); asm volatile("" ::: "memory");
        }
    }
    __syncthreads();
}

__device__ __forceinline__ void ssm_sample_unit(Frame& F, int db, int g) {
    int lane_ = F.lane; asm volatile("" : "+v"(lane_));
    const int lane = lane_, w = F.wave;
    LAS float* S = (LAS float*)(F.lds + 4096 * w);
    const int gp = g * 64 + lane;
    const float ar = F.PAR[PA_ABR + gp], ai = F.PAR[PA_ABI + gp];
    float hr = F.in[I_SRE][(size_t)(db * NG + g) * 64 + lane], hq = F.in[I_SIM][(size_t)(db * NG + g) * 64 + lane];
    float br[16], bi[16];
#pragma unroll
    for (int c = 0; c < 16; ++c) { br[c] = F.PAR[PA_BBR + gp * 16 + c]; bi[c] = F.PAR[PA_BBI + gp * 16 + c]; }
    const int rbase = MP + db * 4;
#pragma unroll
    for (int t = 0; t < 4; ++t) {
        float xr = 0.f, xi = 0.f;
#pragma unroll
        for (int c = 0; c < 16; ++c) { const float uu = bf2f(F.UB[(size_t)(rbase + t) * 512 + 16 * g + c]); xr += br[c] * uu; xi += bi[c] * uu; }
        const float nr = ar * hr - ai * hq + xr, ni = ar * hq + ai * hr + xi; hr = nr; hq = ni;
        S[t * 128 + lane] = hr; S[t * 128 + 64 + lane] = hq;
    }
    F.out[O_SRS + (size_t)(db * NG + g) * 64 + lane] = hr; F.out[O_SIS + (size_t)(db * NG + g) * 64 + lane] = hq;
    LDS_WAIT(); asm volatile("" ::: "memory");
    const int t = lane >> 4, ch = lane & 15;
    const float* cre = F.in[I_CRE] + (size_t)(g * 16 + ch) * 64; const float* cim = F.in[I_CIM] + (size_t)(g * 16 + ch) * 64;
    float y = 0.f;
#pragma unroll 4
    for (int p = 0; p < 64; p += 4) { const f32x4 a = *(const f32x4*)(cre + p), c = *(const f32x4*)(cim + p);
        const f32x4 sr = *(const LAS f32x4*)(S + t * 128 + p), si = *(const LAS f32x4*)(S + t * 128 + 64 + p);
        y += (a[0] * sr[0] - c[0] * si[0]) + (a[1] * sr[1] - c[1] * si[1]) + (a[2] * sr[2] - c[2] * si[2]) + (a[3] * sr[3] - c[3] * si[3]); }
    const float uu = bf2f(F.UB[(size_t)(rbase + t) * 512 + 16 * g + ch]);
    F.GB[(size_t)(rbase + t) * 512 + 16 * g + ch] = (bf16)f2bf(gelu_tanh(y + F.in[I_DSK][g * 16 + ch] * uu));
    LDS_WAIT(); asm volatile("" ::: "memory");
}

struct Args { const void* in[N_IN]; float* out; unsigned char* ws; };
constexpr int NQ_MAIN = 4 * 288, NQ_SS = 64, NQ = NQ_MAIN + NQ_SS;

__global__ void __launch_bounds__(512, 2) hymba_fwd(Args args) {
    extern __shared__ __attribute__((aligned(16))) unsigned char lds_raw[];
    Frame F;
    F.lds = (LAS unsigned char*)lds_raw;
    F.MISC = (volatile LAS unsigned*)(F.lds + MISC_OFF);
    F.tid = threadIdx.x; F.lane = F.tid & 63; F.wave = __builtin_amdgcn_readfirstlane(F.tid >> 6);
    F.G = gridDim.x; { const int bx = blockIdx.x; F.vcu = (F.G % 8 == 0) ? (bx % 8) * (F.G / 8) + bx / 8 : bx; }
    unsigned char* ws = args.ws;
    F.ws = ws; F.out = args.out;
#pragma unroll
    for (int i = 0; i < N_IN; ++i) F.in[i] = (const float*)args.in[i];
    F.ctl = (gu32*)(ws + WS_CTL);
    F.WIN_t = (bf16*)(ws + WS_WIN); F.WGLU_t = (bf16*)(ws + WS_WGLU); F.WOUT_t = (bf16*)(ws + WS_WOUT); F.WGATE_t = (bf16*)(ws + WS_WGATE); F.WUP_t = (bf16*)(ws + WS_WUP); F.WDOWN_t = (bf16*)(ws + WS_WDOWN);
    F.XN = (bf16*)(ws + WS_XN); F.QB = (bf16*)(ws + WS_QB); F.KB = (bf16*)(ws + WS_KB); F.VB = (bf16*)(ws + WS_VB); F.UB = (bf16*)(ws + WS_UB);
    F.MIX = (bf16*)(ws + WS_MIX); F.GB = (bf16*)(ws + WS_G); F.AB = (bf16*)(ws + WS_A); F.HB = (bf16*)(ws + WS_H);
    F.X1 = (float*)(ws + WS_X1); F.PAR = (float*)(ws + WS_PAR); F.ROWSS = (float*)(ws + WS_CTL) + CW_ROWSS; F.SLO = (float*)(ws + WS_SLO); F.SLL = (float*)(ws + WS_SLL);
    for (int u = F.tid; u < (LDS_BYTES - MISC_OFF) / 4; u += 512) ((LAS unsigned*)(F.lds + MISC_OFF))[u] = 0u;
    __syncthreads();
    XcdBarrier bar = xcd_barrier_post((unsigned*)(F.ctl + CW_BAR), F.MISC + 8);

    p0_prologue(F);
    xcd_barrier(bar);

    {
        pg8::Gemm g{F.XN, F.WIN_t, MPAD, PWID, DM, DM}; pg8::StaticOrder S; S.init(MPAD, PWID, F.G, (int)blockIdx.x);
        EpiProj E{F.QB, F.KB, F.VB, F.UB, F.out, F.in[I_QN], F.in[I_KN]};
        pg8::gemm_phase<EpiProj, pg8::StaticOrder, true, true>(F.lds, g, S, E);
    }
    xcd_barrier(bar);

#define P2_QUEUE(QI, NUNITS, ...) do { for (;;) { \
        if (F.tid == 0) F.MISC[0] = __hip_atomic_fetch_add((unsigned*)(F.ctl + CW_QUEUE + 64 * (QI)), 1u, RLX_AGENT); \
        __syncthreads(); const int n = (int)F.MISC[0]; __syncthreads(); \
        if (n >= (NUNITS)) break; __VA_ARGS__; } } while (0)
#ifndef NO_SSM
    P2_QUEUE(0, 256, ssm_unit(F, n >> 5, n & 31));
#endif
#ifndef NO_ATT
    P2_QUEUE(1, 288, { const int qi = 7 - n / 32, bh = n % 32; attn_unit(F, bh >> 2, bh & 3, qi); });
#endif
#ifndef NO_DEC
    P2_QUEUE(2, DB * NSL, decode_unit(F, n / NSL, n % NSL));
#endif
#ifndef NO_SSMS
    P2_QUEUE(3, 64, { _Pragma("unroll 1") for (int i = 0; i < 8; ++i) { const int uidx = n * 64 + F.wave * 8 + i; ssm_sample_unit(F, uidx >> 5, uidx & 31); } });
#endif
#undef P2_QUEUE
    xcd_barrier(bar);

    {
        pg8::Gemm g{F.GB, F.WGLU_t, MPAD, SW, SW, SW}; pg8::StaticOrder S; S.init(MPAD, SW, F.G, (int)blockIdx.x);
        EpiGlu E{F.GB, F.MIX, F.in[I_BGLU]};
        pg8::gemm_phase<EpiGlu, pg8::StaticOrder, true, true>(F.lds, g, S, E);
        for (int uidx = (F.G - 1 - (int)blockIdx.x) * 8 + F.wave; uidx < DB * NH; uidx += F.G * 8) decode_final(F, uidx >> 2, uidx & 3);
    }
    xcd_barrier(bar);

    {
        pg8::Gemm g{F.MIX, F.WOUT_t, MPAD, DM, DM, DM}; pg8::StaticOrder S; S.init(MPAD, DM, F.G, (int)blockIdx.x);
        EpiOut E{F.in[I_XP], F.in[I_XS], F.in[I_META], F.X1, F.XN, F.ROWSS};
        pg8::gemm_phase<EpiOut, pg8::StaticOrder, true, true>(F.lds, g, S, E);
    }
    xcd_barrier(bar);

    {
        pg8::Gemm g{F.XN, F.WGATE_t, MPAD, FF, DM, DM}; pg8::StaticOrder S; S.init(MPAD, FF, F.G, (int)blockIdx.x);
        EpiGate E{F.ROWSS, F.AB, F.out};
        pg8::gemm_phase<EpiGate, pg8::StaticOrder, true, true>(F.lds, g, S, E);
    }
    xcd_barrier(bar);

    {
        pg8::Gemm g{F.XN, F.WUP_t, MPAD, FF, DM, DM}; pg8::StaticOrder S; S.init(MPAD, FF, F.G, (int)blockIdx.x);
        EpiUp E{F.ROWSS, F.AB, F.HB, F.in[I_CW], F.in[I_CB], F.in[I_SCONV]};
        pg8::gemm_phase<EpiUp, pg8::StaticOrder, true, true>(F.lds, g, S, E);
    }
    xcd_barrier(bar);

    {
        pg8::Gemm g{F.HB, F.WDOWN_t, MPAD, DM, FF, FF}; pg8::StaticOrder S; S.init(MPAD, DM, F.G, (int)blockIdx.x);
        EpiDown E{F.X1, F.out};
        pg8::gemm_phase<EpiDown, pg8::StaticOrder, true, true>(F.lds, g, S, E);
    }
}

extern "C" void kernel_launch(void* const* d_in, const int* in_sizes, int n_in, void* d_out, int out_size, void* d_ws, size_t ws_size, hipStream_t stream) {
    static int grid = 0;
    if (grid == 0) {
        if (n_in != N_IN || (size_t)out_size != O_END || ws_size < WS_END) { fprintf(stderr, "kernel_launch: unexpected shapes (n_in %d, out %d, ws %zu); nothing launched\n", n_in, out_size, ws_size); grid = -1; return; }
        int dev = 0, cus = 0, per_cu = 0;
        if (hipGetDevice(&dev) != hipSuccess || hipDeviceGetAttribute(&cus, hipDeviceAttributeMultiprocessorCount, dev) != hipSuccess) { grid = -1; return; }
        if (hipFuncSetAttribute((const void*)hymba_fwd, hipFuncAttributeMaxDynamicSharedMemorySize, LDS_BYTES) != hipSuccess) { fprintf(stderr, "kernel_launch: hipFuncSetAttribute failed\n"); grid = -1; return; }
        if (hipOccupancyMaxActiveBlocksPerMultiprocessor(&per_cu, (const void*)hymba_fwd, 512, LDS_BYTES) != hipSuccess || per_cu < 1)
            fprintf(stderr, "kernel_launch: note: occupancy query reports %d workgroups per CU\n", per_cu);
        (void)hipGetLastError();
        grid = cus;
    }
    if (grid < 0) return;
    if (hipMemsetAsync((char*)d_ws + WS_CTL, 0, CTL_ZERO_BYTES, stream) != hipSuccess) return;
    Args a{};
    for (int i = 0; i < N_IN; ++i) a.in[i] = d_in[i];
    a.out = (float*)d_out; a.ws = (unsigned char*)d_ws;
    hipLaunchKernelGGL(hymba_fwd, dim3(grid), dim3(512), LDS_BYTES, stream, a);
}
```

```cpp
#include <hip/hip_runtime.h>
#include <hip/hip_bf16.h>
#include <cstdio>
#include <cstdint>
#include <cmath>
namespace pg8 {
#define PG8_LAS __attribute__((address_space(3)))
typedef unsigned short bf16_t;
typedef short bf16x8 __attribute__((ext_vector_type(8)));
typedef float f32x4 __attribute__((ext_vector_type(4)));
typedef unsigned u32x4 __attribute__((ext_vector_type(4)));
constexpr int BM = 256, BK = 64, HALF = 128, HTB = HALF * BK * 2  , STAGE_BYTES = 8 * HTB, NXCD = 8, WGM = 8;

__host__ __device__ __forceinline__ int lds_byte(int r, int c) { const int st = (r >> 4) * 2 + (c >> 5), rr = r & 15, cc = c & 31, ob = rr * 64 + cc * 2; return st * 1024 + (ob ^ (((ob >> 9) & 1) << 5)); }
__host__ __device__ __forceinline__ void stage_rc(int b, int& R, int& C) { const int st = b / 1024, sb = b % 1024, swz = sb ^ (((sb >> 9) & 1) << 5); R = (st >> 1) * 16 + swz / 64; C = (st & 1) * 32 + (swz % 64) / 2; }
__host__ __device__ __forceinline__ int perm32(int rho) { const int n = rho >> 4, i = rho & 15; return 8 * (i >> 2) + 4 * n + (i & 3); }

struct Unit { int pm, pn; };
struct Gemm { const bf16_t* A; const bf16_t* Bt; int M, N, K, ld, mstep; };

struct StaticOrder {
    int nM, nN, nwg, G, c;
    __host__ __device__ void init(int M, int N, int G_, int c_) { nM = M / BM; nN = N / BM; nwg = nM * nN; G = G_; c = c_; }
    __host__ __device__ bool next(int i, Unit& u) const {
        const long L = (long)i * G + c; if (L >= nwg) return false;
        int wgid = (int)L; { const int q = nwg / NXCD, r = nwg % NXCD, xcd = wgid % NXCD, off = wgid / NXCD; wgid = (xcd < r ? xcd * (q + 1) : r * (q + 1) + (xcd - r) * q) + off; }
        const int nig = WGM * nN, gid = wgid / nig, fm = gid * WGM, gsz = (nM - fm) < WGM ? (nM - fm) : WGM;
        u.pm = fm + ((wgid % nig) % gsz); u.pn = (wgid % nig) / gsz; return true;
    }
    __device__ __forceinline__ void a_ready(const Unit&) const {}
    __device__ __forceinline__ void done(const Unit&) const {}
};

__device__ __forceinline__ unsigned cvt_pk_bf16(float lo, float hi) { unsigned r; asm volatile("v_cvt_pk_bf16_f32 %0, %1, %2" : "=v"(r) : "v"(lo), "v"(hi)); return r; }
typedef float f32x2 __attribute__((ext_vector_type(2)));
__device__ __forceinline__ f32x2 gelu_pk(f32x2 v) {
    const f32x2 av = __builtin_elementwise_abs(v), d = av * 0.2316418882f + 1.0f;
    f32x2 t; t.x = __builtin_amdgcn_rcpf(d.x); t.y = __builtin_amdgcn_rcpf(d.y);
    f32x2 q = t * 0.5307027145f + (-0.7265760135f); q = q * t + 0.7107068705f; q = q * t + (-0.142248368f); q = q * t + 0.127414796f; q = q * t;
    const f32x2 s = (v * v) * (-0.72134752044f);
    f32x2 e; e.x = __builtin_amdgcn_exp2f(s.x); e.y = __builtin_amdgcn_exp2f(s.y);
    const f32x2 m = v * (q * e), r = v - m;
    f32x2 o; o.x = v.x < 0.f ? m.x : r.x; o.y = v.y < 0.f ? m.y : r.y; return o;
}

template <int ACT  > struct EpiBf16 {
    static constexpr bool PERM = true, AFTER_DRAIN = false; static_assert(ACT == 0 || ACT == 1, "EpiBf16: ACT is 0 (none) or 1 (gelu_pk)");
    bf16_t* O; int ldc; const float* bias; int split_cols; size_t split_stride; float scale0;
    __device__ __forceinline__ void operator()(const f32x4 (&acc)[2][2][4][2], const Unit& u, int wr, int wc, int fr, int fq) const {
        const int row0 = u.pm * BM + wr * 64 + fr; int colt = u.pn * BM; bf16_t* base = O;
        float sc = 1.f; if (split_cols) { const int t = colt / split_cols; base += (size_t)t * split_stride; colt -= t * split_cols; if (t == 0) sc = scale0; }
        const int col0 = colt + wc * 32 + 8 * fq, bcol0 = u.pn * BM + wc * 32 + 8 * fq;
        f32x4 bv[2][2];
#pragma unroll
        for (int bj = 0; bj < 2; ++bj)
#pragma unroll
            for (int n = 0; n < 2; ++n) bv[bj][n] = bias ? *(const f32x4*)(bias + bcol0 + bj * HALF + 4 * n) : (f32x4){0.f, 0.f, 0.f, 0.f};
#pragma unroll
        for (int ai = 0; ai < 2; ++ai)
#pragma unroll
            for (int m = 0; m < 4; ++m) { bf16_t* rowp = base + (size_t)(row0 + ai * HALF + m * 16) * ldc + col0;
#pragma unroll
                for (int bj = 0; bj < 2; ++bj) { f32x4 v0 = acc[ai][bj][m][0] + bv[bj][0], v1 = acc[ai][bj][m][1] + bv[bj][1];
                    if (ACT == 1) { f32x2 a = gelu_pk((f32x2){v0[0], v0[1]}), b = gelu_pk((f32x2){v0[2], v0[3]}), c = gelu_pk((f32x2){v1[0], v1[1]}), d = gelu_pk((f32x2){v1[2], v1[3]});
                        v0 = (f32x4){a.x, a.y, b.x, b.y}; v1 = (f32x4){c.x, c.y, d.x, d.y}; }
                    v0 = v0 * sc; v1 = v1 * sc; u32x4 w; w.x = cvt_pk_bf16(v0[0], v0[1]); w.y = cvt_pk_bf16(v0[2], v0[3]); w.z = cvt_pk_bf16(v1[0], v1[1]); w.w = cvt_pk_bf16(v1[2], v1[3]);
                    *(u32x4*)(rowp + bj * HALF) = w; } }
    }
};

template <class Epi, class Sched, bool ALIGN_EPI = false, bool SP2 = false>
__device__ __forceinline__ void gemm_phase(PG8_LAS unsigned char* lds, const Gemm g, const Sched& S, const Epi& E) {
    int tid_ = threadIdx.x; asm volatile("" : "+v"(tid_));
    const int tid = tid_, wid = __builtin_amdgcn_readfirstlane(tid >> 6), lane = tid & 63, wr = wid >> 2, wc = wid & 3, fr = lane & 15, fq = lane >> 4;
    const int K = g.ld, nt = g.K / BK;
    unsigned voffA[2], voffB[2];
#pragma unroll
    for (int i = 0; i < 2; ++i) { int R, C; stage_rc(tid * 16 + i * 8192, R, C); const int Rb = Epi::PERM ? ((R & ~31) + perm32(R & 31)) : R;
        voffA[i] = (unsigned)(R * K + C) * 2u; voffB[i] = (unsigned)(Rb * K + C) * 2u; }
    const size_t kstep = (size_t)(BK * 2);
    const size_t hstep = (size_t)HALF * K * 2;
    const size_t tstep = 2 * hstep, tstepA = (size_t)g.mstep * K * 2;
    const unsigned ldsw = (unsigned)wid * 1024u;
    const int aoff = lds_byte(wr * 64 + fr, fq * 8), boff = lds_byte(wc * 32 + fr, fq * 8);
#define PG8_SA(b, h) (((b) * 2 + (h)) * HTB)
#define PG8_SB(b, h) ((4 + (b) * 2 + (h)) * HTB)
#define PG8_STAGE(bufoff, gbase, voff) do { _Pragma("unroll") for (int _i = 0; _i < 2; ++_i) \
        __builtin_amdgcn_global_load_lds((const unsigned*)((const char*)(gbase) + (voff)[_i]), (PG8_LAS unsigned*)(lds + (bufoff) + ldsw + _i * 8192), 16, 0, 0); } while (0)
#define PG8_LDA(dst, b, h) do { _Pragma("unroll") for (int m = 0; m < 4; ++m) _Pragma("unroll") for (int k = 0; k < 2; ++k) dst[m][k] = *(const PG8_LAS bf16x8*)(lds + PG8_SA(b, h) + aoff + m * 2048 + k * 1024); } while (0)
#define PG8_LDB(dst, b, h) do { _Pragma("unroll") for (int n = 0; n < 2; ++n) _Pragma("unroll") for (int k = 0; k < 2; ++k) dst[n][k] = *(const PG8_LAS bf16x8*)(lds + PG8_SB(b, h) + boff + n * 2048 + k * 1024); } while (0)
#define PG8_MMA(ai, bj, At, Bt) do { __builtin_amdgcn_s_setprio(1); _Pragma("unroll") for (int m = 0; m < 4; ++m) _Pragma("unroll") for (int n = 0; n < 2; ++n) _Pragma("unroll") for (int k = 0; k < 2; ++k) \
        acc[ai][bj][m][n] = __builtin_amdgcn_mfma_f32_16x16x32_bf16(Bt[n][k], At[m][k], acc[ai][bj][m][n], 0, 0, 0); __builtin_amdgcn_s_setprio(0); } while (0)
#define PG8_WAIT_V(n) asm volatile("s_waitcnt vmcnt(" #n ")" ::: "memory")
#define PG8_WAIT_L(n) asm volatile("s_waitcnt lgkmcnt(" #n ")" ::: "memory")
#define PG8_BAR __builtin_amdgcn_s_barrier()
#define PG8_SCHED __builtin_amdgcn_sched_barrier(0)
    Unit cur, nxt; int ui = 0;
    if (!S.next(0, cur)) return;
    f32x4 acc[2][2][4][2];
#pragma unroll
    for (int a = 0; a < 2; ++a)
#pragma unroll
        for (int b = 0; b < 2; ++b)
#pragma unroll
            for (int m = 0; m < 4; ++m)
#pragma unroll
                for (int n = 0; n < 2; ++n) acc[a][b][m][n] = (f32x4){0.f, 0.f, 0.f, 0.f};
    bf16x8 At[4][2], B0[2][2], B1[2][2];
    const char* cA = (const char*)g.A + (size_t)cur.pm * tstepA; const char* cB = (const char*)g.Bt + (size_t)cur.pn * tstep;
    S.a_ready(cur);
    if constexpr (SP2) {
        PG8_STAGE(PG8_SB(0, 0), cB, voffB); PG8_STAGE(PG8_SB(0, 1), cB + hstep, voffB); PG8_STAGE(PG8_SA(0, 0), cA, voffA); PG8_STAGE(PG8_SA(0, 1), cA + hstep, voffA);
        if (wr == 1) PG8_BAR;
        PG8_WAIT_V(2); PG8_BAR;
        PG8_STAGE(PG8_SB(1, 0), cB + kstep, voffB); PG8_STAGE(PG8_SA(1, 0), cA + kstep, voffA); PG8_STAGE(PG8_SB(1, 1), cB + hstep + kstep, voffB);
        PG8_WAIT_V(6); PG8_BAR;
    } else {
        PG8_STAGE(PG8_SB(0, 0), cB, voffB); PG8_STAGE(PG8_SA(0, 0), cA, voffA); PG8_STAGE(PG8_SB(0, 1), cB + hstep, voffB); PG8_STAGE(PG8_SA(0, 1), cA + hstep, voffA);
        if (wr == 1) PG8_BAR;
        PG8_WAIT_V(4); PG8_BAR;
        PG8_STAGE(PG8_SB(1, 0), cB + kstep, voffB); PG8_STAGE(PG8_SA(1, 0), cA + kstep, voffA); PG8_STAGE(PG8_SB(1, 1), cB + hstep + kstep, voffB);
        PG8_WAIT_V(6); PG8_BAR;
    }
    for (;;) {
        const bool has_next = S.next(ui + 1, nxt);
        const char* nA = has_next ? (const char*)g.A + (size_t)nxt.pm * tstepA : cA; const char* nB = has_next ? (const char*)g.Bt + (size_t)nxt.pn * tstep : cB;
        for (int t = 0; t < nt; t += 2) {
            const bool last = (t == nt - 2);
            const char* a1 = cA + (size_t)(t + 1) * kstep;
            const char* a2 = last ? nA : cA + (size_t)(t + 2) * kstep; const char* b2 = last ? nB : cB + (size_t)(t + 2) * kstep;
            const char* a3 = a2 + kstep; const char* b3 = b2 + kstep;
            if (last && has_next) S.a_ready(nxt);
            if constexpr (SP2) {
            PG8_LDB(B0, 0, 0); PG8_LDB(B1, 0, 1); PG8_SCHED; PG8_LDA(At, 0, 0); PG8_STAGE(PG8_SA(1, 1), a1 + hstep, voffA);
            PG8_WAIT_V(8); PG8_WAIT_L(0); PG8_BAR; PG8_MMA(0, 0, At, B0); PG8_MMA(0, 1, At, B1); PG8_BAR; PG8_SCHED;
            PG8_LDA(At, 0, 1); PG8_STAGE(PG8_SB(0, 0), b2, voffB); PG8_STAGE(PG8_SB(0, 1), b2 + hstep, voffB); PG8_STAGE(PG8_SA(0, 0), a2, voffA);
            PG8_WAIT_V(8); PG8_WAIT_L(0); PG8_BAR; PG8_MMA(1, 0, At, B0); PG8_MMA(1, 1, At, B1); PG8_BAR; PG8_SCHED;
            PG8_LDB(B0, 1, 0); PG8_LDB(B1, 1, 1); PG8_SCHED; PG8_LDA(At, 1, 0); PG8_STAGE(PG8_SA(0, 1), a2 + hstep, voffA);
            PG8_WAIT_V(8); PG8_WAIT_L(0); PG8_BAR; PG8_MMA(0, 0, At, B0); PG8_MMA(0, 1, At, B1); PG8_BAR; PG8_SCHED;
            PG8_LDA(At, 1, 1); PG8_STAGE(PG8_SB(1, 0), b3, voffB); PG8_STAGE(PG8_SB(1, 1), b3 + hstep, voffB); PG8_STAGE(PG8_SA(1, 0), a3, voffA);
            PG8_WAIT_V(8); PG8_WAIT_L(0); PG8_BAR; PG8_MMA(1, 0, At, B0); PG8_MMA(1, 1, At, B1); PG8_BAR; PG8_SCHED;
            } else {
            PG8_LDB(B0, 0, 0); PG8_SCHED; PG8_LDA(At, 0, 0); PG8_STAGE(PG8_SA(1, 1), a1 + hstep, voffA);
            PG8_WAIT_L(8); PG8_BAR; PG8_WAIT_L(0); PG8_MMA(0, 0, At, B0); PG8_BAR; PG8_SCHED;
            PG8_LDB(B1, 0, 1); PG8_STAGE(PG8_SB(0, 0), b2, voffB);
            PG8_BAR; PG8_WAIT_L(0); PG8_MMA(0, 1, At, B1); PG8_BAR;
            PG8_LDA(At, 0, 1); PG8_STAGE(PG8_SA(0, 0), a2, voffA);
            PG8_BAR; PG8_WAIT_L(0); PG8_MMA(1, 0, At, B0); PG8_BAR; PG8_SCHED;
            PG8_STAGE(PG8_SB(0, 1), b2 + hstep, voffB);
            PG8_WAIT_V(6); PG8_BAR; PG8_MMA(1, 1, At, B1); PG8_BAR;
            PG8_LDB(B0, 1, 0); PG8_SCHED; PG8_LDA(At, 1, 0); PG8_STAGE(PG8_SA(0, 1), a2 + hstep, voffA);
            PG8_WAIT_L(8); PG8_BAR; PG8_WAIT_L(0); PG8_MMA(0, 0, At, B0); PG8_BAR; PG8_SCHED;
            PG8_LDB(B1, 1, 1); PG8_STAGE(PG8_SB(1, 0), b3, voffB);
            PG8_BAR; PG8_WAIT_L(0); PG8_MMA(0, 1, At, B1); PG8_BAR;
            PG8_LDA(At, 1, 1); PG8_STAGE(PG8_SA(1, 0), a3, voffA);
            PG8_BAR; PG8_WAIT_L(0); PG8_MMA(1, 0, At, B0); PG8_BAR; PG8_SCHED;
            PG8_STAGE(PG8_SB(1, 1), b3 + hstep, voffB);
            PG8_WAIT_V(6); PG8_BAR; PG8_MMA(1, 1, At, B1); PG8_BAR;
            }
        }
        if constexpr (ALIGN_EPI) { if (wr == 0) PG8_BAR; }
        if constexpr (!Epi::AFTER_DRAIN) { E(acc, cur, wr, wc, fr, fq); S.done(cur); }
        if (!has_next) break;
#pragma unroll
        for (int a = 0; a < 2; ++a)
#pragma unroll
            for (int b = 0; b < 2; ++b)
#pragma unroll
                for (int m = 0; m < 4; ++m)
#pragma unroll
                    for (int n = 0; n < 2; ++n) acc[a][b][m][n] = (f32x4){0.f, 0.f, 0.f, 0.f};
        cur = nxt; cA = nA; cB = nB; ++ui;
        if constexpr (ALIGN_EPI) { if (wr == 1) PG8_BAR; }
    }
    PG8_WAIT_V(0);
    if constexpr (!ALIGN_EPI) { if (wr == 0) PG8_BAR; }
    PG8_BAR;
    if constexpr (Epi::AFTER_DRAIN) { E.fused(acc, cur, wr, wc, fr, fq, lds, wid, lane); S.done(cur); }
#undef PG8_SA
#undef PG8_SB
#undef PG8_STAGE
#undef PG8_LDA
#undef PG8_LDB
#undef PG8_MMA
#undef PG8_WAIT_V
#undef PG8_WAIT_L
#undef PG8_BAR
#undef PG8_SCHED
}
}

constexpr int DM = 1024, NB = 8, SEQ = 2048, NMETA = 16, LP = SEQ + NMETA, DB = 128, TS = 4;
constexpr int MP = NB * LP, MS = DB * TS, MV = MP + MS, MPAD = 17152;
constexpr int NH = 4, HD = 128, QKD = 64, AW = 512, SW = 512, NG = 32, SG = 16, NST = 64, FF = 2816, PWID = 2048;
constexpr int NPG = 16, PAGE = 128;
constexpr float EPS = 1e-6f;
constexpr float QSCALE = 0.125f * 1.4426950408889634f;
constexpr float LAM_INIT = 0.2f;
constexpr size_t O_YP = 0, O_YS = O_YP + (size_t)NB * SEQ * DM, O_KP = O_YS + (size_t)MS * DM, O_VP = O_KP + (size_t)MP * 512,
                 O_KS = O_VP + (size_t)MP * 512, O_VS = O_KS + (size_t)MS * 512, O_SRP = O_VS + (size_t)MS * 512, O_SIP = O_SRP + NB * NG * NST,
                 O_SRS = O_SIP + NB * NG * NST, O_SIS = O_SRS + DB * NG * NST, O_CP = O_SIS + DB * NG * NST, O_CS = O_CP + (size_t)NB * 2 * FF,
                 O_END = O_CS + (size_t)DB * 2 * FF;
enum { I_XP = 0, I_XS, I_CK, I_CV, I_SRE, I_SIM, I_SCONV, I_PT, I_META, I_N1, I_WIN, I_QN, I_KN, I_LQ, I_LK, I_SUBN, I_ARE, I_AIM, I_LDT, I_BRE, I_BIM,
       I_CRE, I_CIM, I_DSK, I_WGLU, I_BGLU, I_WOUT, I_N2, I_WGATE, I_WUP, I_CW, I_CB, I_WDOWN, N_IN };

constexpr size_t MiB = 1u << 20;
constexpr size_t WS_CTL = 0, CTL_ZERO_BYTES = 1 * MiB;
constexpr size_t WS_PAR = 1 * MiB;
constexpr size_t WS_WIN = 2 * MiB, WS_WGLU = 6 * MiB, WS_WOUT = 7 * MiB, WS_WGATE = 9 * MiB, WS_WUP = 15 * MiB, WS_WDOWN = 21 * MiB;
constexpr size_t WS_XN = 32 * MiB;
constexpr size_t WS_QB = 66 * MiB, WS_KB = 83 * MiB, WS_VB = 100 * MiB, WS_UB = 117 * MiB;
constexpr size_t WS_MIX = 134 * MiB;
constexpr size_t WS_G = 168 * MiB;
constexpr size_t WS_X1 = 185 * MiB;
constexpr size_t WS_A = 252 * MiB;
constexpr size_t WS_H = 345 * MiB;
constexpr size_t WS_SLO = 438 * MiB, WS_SLL = 447 * MiB, WS_END = 448 * MiB;
constexpr int CW_BAR = 4096;
constexpr int CW_QUEUE = 8192;
constexpr int CW_ROWSS = 16384;
static_assert((CW_ROWSS + MPAD) * 4 <= (int)CTL_ZERO_BYTES, "ctl");
constexpr int PA_ABR = 0, PA_ABI = 2048, PA_BBR = 4096, PA_BBI = 4096 + 32768, PA_LAM = 4096 + 65536;

constexpr int RING_BYTES = 131072;
constexpr int LDS_BYTES = 147456;
constexpr int MISC_OFF = LDS_BYTES - 512;

#define GAS __attribute__((address_space(1)))
#define LAS __attribute__((address_space(3)))
typedef unsigned short bf16;
typedef unsigned v4u __attribute__((ext_vector_type(4)));
typedef unsigned v2u __attribute__((ext_vector_type(2)));
typedef float f32x4 __attribute__((ext_vector_type(4)));
typedef float f32x2 __attribute__((ext_vector_type(2)));
typedef float f32x16 __attribute__((ext_vector_type(16)));
typedef short bf16x8 __attribute__((ext_vector_type(8)));
typedef short s16x4 __attribute__((ext_vector_type(4)));
typedef GAS unsigned gu32;
#define RLX_AGENT __ATOMIC_RELAXED, __HIP_MEMORY_SCOPE_AGENT
#define LDS_WAIT() asm volatile("s_waitcnt lgkmcnt(0)" ::: "memory")
#define VM_WAIT() asm volatile("s_waitcnt vmcnt(0)" ::: "memory")
__device__ __forceinline__ unsigned f2bf(float f) { unsigned u = __builtin_bit_cast(unsigned, f); return (u + 0x7fffu + ((u >> 16) & 1u)) >> 16; }
__device__ __forceinline__ unsigned pk2(float lo, float hi) { return f2bf(lo) | (f2bf(hi) << 16); }
__device__ __forceinline__ float bf2f(unsigned short b) { return __builtin_bit_cast(float, (unsigned)b << 16); }
__device__ __forceinline__ unsigned cvtpk(float lo, float hi) { unsigned r; asm volatile("v_cvt_pk_bf16_f32 %0, %1, %2" : "=v"(r) : "v"(lo), "v"(hi)); return r; }
__device__ __forceinline__ float gelu_tanh(float x) {
    const float z = x * (1.0f + 0.044715f * x * x);
    const float e = __builtin_amdgcn_exp2f(z * (-2.0f * 0.7978845608028654f * 1.4426950408889634f));
    return x * __builtin_amdgcn_rcpf(1.0f + e);
}
__device__ __forceinline__ float wave_sum(float v) {
#pragma unroll
    for (int o = 1; o < 64; o <<= 1) v += __shfl_xor(v, o);
    return v;
}

#define XB_TMO      128
#define XB_XCNT(j)  (256  + 64 * (j))
#define XB_XSUB(j)  (1280 + 64 * (j))
#define XB_XGEN(j)  (2304 + 64 * (j))
#define XB_TOP      3328
#define XB_TOPGEN   3392
#define XCD_BAR_WORDS 3456
#define XB_SPIN_CAP (1u << 18)
__device__ __forceinline__ unsigned xb_ld(unsigned* p)              { return __hip_atomic_load(p, __ATOMIC_RELAXED, __HIP_MEMORY_SCOPE_AGENT); }
__device__ __forceinline__ unsigned xb_add(unsigned* p, unsigned v) { return __hip_atomic_fetch_add(p, v, __ATOMIC_RELAXED, __HIP_MEMORY_SCOPE_AGENT); }
__device__ __forceinline__ unsigned xb_xcc_id() { return (unsigned)__builtin_amdgcn_s_getreg((3 << 11) | 20) & 0xFu; }
#define XB_SPIN(cond, bar) do { unsigned _sp = 0; while (cond) { __builtin_amdgcn_s_sleep(1); \
    if ((++_sp & 255u) == 0u) { if (xb_ld(&(bar)[XB_TMO])) break; if (_sp > XB_SPIN_CAP) { atomicAdd(&(bar)[XB_TMO], 1u); break; } } } } while (0)
struct XcdBarrier { unsigned* bar; unsigned x; volatile LAS unsigned* st; };
__device__ __forceinline__ XcdBarrier xcd_barrier_post(unsigned* bar, volatile LAS unsigned* st) {
    XcdBarrier b; b.bar = bar; b.x = xb_xcc_id(); b.st = st;
    if (threadIdx.x == 0) (void)xb_add(&bar[XB_XCNT(b.x)], 1u);
    return b;
}
__device__ __forceinline__ void xcd_barrier_complete(unsigned* bar, unsigned x, unsigned& nloc, unsigned& nx) {
    const unsigned G = gridDim.x * gridDim.y * gridDim.z;
    unsigned sum, cnt, mine, sp = 0u;
    for (;;) {
        sum = 0u; cnt = 0u; mine = 0u;
#pragma unroll
        for (unsigned j = 0; j < 16; ++j) { const unsigned c = xb_ld(&bar[XB_XCNT(j)]); sum += c; cnt += (c > 0u) ? 1u : 0u; mine = (j == x) ? c : mine; }
        if (sum == G) break;
        __builtin_amdgcn_s_sleep(1);
        if ((++sp & 255u) == 0u) { if (xb_ld(&bar[XB_TMO])) break; if (sp > XB_SPIN_CAP) { atomicAdd(&bar[XB_TMO], 1u); break; } }
    }
    nloc = mine > 0u ? mine : 1u; nx = cnt > 0u ? cnt : 1u;
}
__device__ __forceinline__ void xcd_barrier(const XcdBarrier& b) {
    asm volatile("s_waitcnt vmcnt(0)" ::: "memory");
    __syncthreads();
    if (threadIdx.x == 0) {
        unsigned* bar = b.bar;
        __builtin_amdgcn_s_waitcnt(0);
        unsigned nloc = b.st[0], nx = b.st[1];
        if (nloc == 0u) { xcd_barrier_complete(bar, b.x, nloc, nx); b.st[0] = nloc; b.st[1] = nx; }
        const unsigned old = xb_add(&bar[XB_XSUB(b.x)], 1u);
        const unsigned gen = old / nloc;
        if (old + 1u == (gen + 1u) * nloc) {
            __builtin_amdgcn_fence(__ATOMIC_RELEASE, "agent");
            asm volatile("s_waitcnt vmcnt(0)" ::: "memory");
            const unsigned og = xb_add(&bar[XB_TOP], 1u);
            const unsigned tg = og / nx;
            if (og + 1u == (tg + 1u) * nx) xb_add(&bar[XB_TOPGEN], 1u);
            else XB_SPIN(xb_ld(&bar[XB_TOPGEN]) == tg, bar);
            __builtin_amdgcn_fence(__ATOMIC_ACQUIRE, "agent");
            xb_add(&bar[XB_XGEN(b.x)], 1u);
            asm volatile("s_waitcnt vmcnt(0)" ::: "memory");
        } else {
            XB_SPIN(xb_ld(&bar[XB_XGEN(b.x)]) == gen, bar);
            __builtin_amdgcn_fence(__ATOMIC_ACQUIRE, "agent");
            asm volatile("s_waitcnt vmcnt(0)" ::: "memory");
        }
    }
    __syncthreads();
}

struct Frame {
    LAS unsigned char* lds;
    volatile LAS unsigned* MISC;
    gu32* ctl;
    int tid, lane, wave, vcu, G;
    const float* in[N_IN];
    float* out;
    unsigned char* ws;
    bf16 *WIN_t, *WGLU_t, *WOUT_t, *WGATE_t, *WUP_t, *WDOWN_t;
    bf16 *XN, *QB, *KB, *VB, *UB, *MIX, *GB, *AB, *HB;
    float *X1, *PAR, *ROWSS, *SLO, *SLL;
};

__device__ __forceinline__ const float* xin_row(const Frame& F, int m) {
    if (m < MP) { const int b = m / LP, t = m - b * LP; return t < NMETA ? F.in[I_META] + (size_t)t * DM : F.in[I_XP] + ((size_t)b * SEQ + (t - NMETA)) * DM; }
    if (m < MV) return F.in[I_XS] + (size_t)(m - MP) * DM;
    return nullptr;
}

__device__ __forceinline__ void p0_tr_item(const float* W, int K, int N, bf16* WT, LAS float* scr, int item, int lane, const float* kscale, int mode) {
    const int nblk = N / 32, kb = item / nblk, nb = item % nblk, k0 = 64 * kb, n0 = 32 * nb;
#pragma unroll 8
    for (int i = 0; i < 32; ++i) { const int kk = 2 * i + (lane >> 5); float v = W[(size_t)(k0 + kk) * N + n0 + (lane & 31)]; if (kscale) v *= kscale[k0 + kk]; scr[kk * 33 + (lane & 31)] = v; }
    LDS_WAIT(); asm volatile("" ::: "memory");
    int prow0 = n0;
    if (mode == 1 && n0 < 1024) { const int pn = n0 >> 8, lb = (n0 & 255) >> 5, wc = lb >> 1, bj = lb & 1; prow0 = 256 * pn + 128 * bj + 32 * wc; }
    if (mode >= 2) prow0 = 256 * (n0 >> 7) + (n0 & 127) + (mode == 3 ? 128 : 0);
    const int c = lane & 7;
#pragma unroll
    for (int j = 0; j < 4; ++j) { const int n = (lane >> 3) + 8 * j; const LAS float* s = scr + (8 * c) * 33 + n;
        v4u o; o.x = pk2(s[0 * 33], s[1 * 33]); o.y = pk2(s[2 * 33], s[3 * 33]); o.z = pk2(s[4 * 33], s[5 * 33]); o.w = pk2(s[6 * 33], s[7 * 33]);
        *(GAS v4u*)(WT + (size_t)(prow0 + n) * K + k0 + 8 * c) = o; }
    LDS_WAIT(); asm volatile("" ::: "memory");
}
__device__ __forceinline__ void p0_prologue(Frame& F) {
    LAS float* scr = (LAS float*)(F.lds + F.wave * 16384);
    int lane_ = F.lane; asm volatile("" : "+v"(lane_));
    const int gw = F.vcu * 8 + F.wave, NGW = F.G * 8, lane = lane_;
    constexpr int I_1 = (DM / 64) * (PWID / 32), I_2 = (SW / 64) * (SW / 32), I_3 = (DM / 64) * (DM / 32), I_4 = (DM / 64) * (FF / 32), I_5 = I_4, I_6 = (FF / 64) * (DM / 32);
    constexpr int NITEMS = I_1 + I_2 + I_3 + I_4 + I_5 + I_6;
    for (int it = gw; it < NITEMS; it += NGW) {
        int r = it;
        if (r < I_1) { p0_tr_item(F.in[I_WIN], DM, PWID, F.WIN_t, scr, r, lane, nullptr, 1); continue; } r -= I_1;
        if (r < I_2) { p0_tr_item(F.in[I_WGLU], SW, SW, F.WGLU_t, scr, r, lane, nullptr, 0); continue; } r -= I_2;
        if (r < I_3) { p0_tr_item(F.in[I_WOUT], DM, DM, F.WOUT_t, scr, r, lane, nullptr, 0); continue; } r -= I_3;
        if (r < I_4) { p0_tr_item(F.in[I_WGATE], DM, FF, F.WGATE_t, scr, r, lane, F.in[I_N2], 2); continue; } r -= I_4;
        if (r < I_5) { p0_tr_item(F.in[I_WUP], DM, FF, F.WGATE_t, scr, r, lane, F.in[I_N2], 3); continue; } r -= I_5;
        p0_tr_item(F.in[I_WDOWN], FF, DM, F.WDOWN_t, scr, r, lane, nullptr, 0);
    }
    {
        const GAS f32x4* g1 = (const GAS f32x4*)F.in[I_N1] + lane;
        f32x4 gv[4];
#pragma unroll
        for (int j = 0; j < 4; ++j) gv[j] = g1[64 * j];
        for (int m = gw; m < MPAD; m += NGW) {
            const float* src = xin_row(F, m);
            GAS unsigned long long* o8 = (GAS unsigned long long*)(F.XN + (size_t)m * DM) + lane;
            if (!src) {
#pragma unroll
                for (int j = 0; j < 4; ++j) o8[64 * j] = 0ull;
                continue; }
            const GAS f32x4* xr = (const GAS f32x4*)src + lane;
            f32x4 v[4]; float s = 0.f;
#pragma unroll
            for (int j = 0; j < 4; ++j) { v[j] = xr[64 * j]; s += (v[j].x * v[j].x + v[j].y * v[j].y) + (v[j].z * v[j].z + v[j].w * v[j].w); }
            const float r = rsqrtf(wave_sum(s) * (1.f / DM) + EPS);
#pragma unroll
            for (int j = 0; j < 4; ++j) { const f32x4 y = (v[j] * r) * gv[j]; o8[64 * j] = (unsigned long long)pk2(y.x, y.y) | ((unsigned long long)pk2(y.z, y.w) << 32); }
        }
    }
    if (gw < 32) {
        const int gp = gw * 64 + lane, g = gp >> 6;
        const float dt = expf(F.in[I_LDT][g]);
        const float ar = F.in[I_ARE][gp], ai = F.in[I_AIM][gp];
        const float mag = expf(ar * dt), abr = mag * cosf(ai * dt), abi = mag * sinf(ai * dt);
        const float den = ar * ar + ai * ai, nr = abr - 1.0f, ni = abi;
        const float gr = (nr * ar + ni * ai) / den, gi = (ni * ar - nr * ai) / den;
        F.PAR[PA_ABR + gp] = abr; F.PAR[PA_ABI + gp] = abi;
#pragma unroll
        for (int c = 0; c < 16; ++c) { const float br = F.in[I_BRE][gp * 16 + c], bi = F.in[I_BIM][gp * 16 + c];
            F.PAR[PA_BBR + gp * 16 + c] = gr * br - gi * bi; F.PAR[PA_BBI + gp * 16 + c] = gr * bi + gi * br; }
    } else if (gw == 32) {
        const float s0 = wave_sum(F.in[I_LQ][lane] * F.in[I_LK][lane]), s1 = wave_sum(F.in[I_LQ][64 + lane] * F.in[I_LK][64 + lane]);
        if (lane == 0) F.PAR[PA_LAM] = expf(s0) - expf(s1) + LAM_INIT;
    }
}

using pg8::Unit; using pg8::HALF; using pg8::BM;

struct EpiProj {
    static constexpr bool PERM = false, AFTER_DRAIN = false;
    bf16 *qb, *kb, *vb, *ub; float* out; const float *qn, *kn;
    __device__ __forceinline__ void operator()(const f32x4 (&acc)[2][2][4][2], const Unit& u, int wr, int wc, int fr, int fq) const {
        const int tt = u.pn >> 1, half = u.pn & 1;
        const int row0 = u.pm * BM + wr * 64 + fr;
        if (tt < 2) {
            const float* gsrc = (tt == 0 ? qn : kn) + (wc & 1) * 64 + 4 * fq;
            const float sc = (tt == 0) ? QSCALE : 1.0f;
            f32x4 gv[2][2];
#pragma unroll
            for (int bj = 0; bj < 2; ++bj)
#pragma unroll
                for (int n = 0; n < 2; ++n) gv[bj][n] = *(const f32x4*)(gsrc + 32 * bj + 16 * n) * sc;
            bf16* dstb = (tt == 0) ? qb : kb;
            const int colL = 256 * half + 64 * wc + 4 * fq;
#pragma unroll
            for (int ai = 0; ai < 2; ++ai)
#pragma unroll
                for (int m = 0; m < 4; ++m) {
                    float ss = 0.f;
#pragma unroll
                    for (int bj = 0; bj < 2; ++bj)
#pragma unroll
                        for (int n = 0; n < 2; ++n) { const f32x4 x = acc[ai][bj][m][n]; ss += (x[0] * x[0] + x[1] * x[1]) + (x[2] * x[2] + x[3] * x[3]); }
                    ss += __shfl_xor(ss, 16); ss += __shfl_xor(ss, 32);
                    const float r = rsqrtf(ss * (1.0f / 64.0f) + EPS);
                    const int row = row0 + ai * HALF + m * 16;
                    float* fo = nullptr;
                    if (tt == 1) { if (row < MP) fo = out + O_KP + (size_t)row * 512; else if (row < MV) fo = out + O_KS + (size_t)(row - MP) * 512; }
#pragma unroll
                    for (int bj = 0; bj < 2; ++bj)
#pragma unroll
                        for (int n = 0; n < 2; ++n) { const f32x4 kf = (acc[ai][bj][m][n] * r);
                            const f32x4 v = kf * gv[bj][n]; const int col = colL + 32 * bj + 16 * n;
                            v2u w; w.x = pk2(v[0], v[1]); w.y = pk2(v[2], v[3]); *(v2u*)(dstb + (size_t)row * 512 + col) = w;
                            if (fo) *(f32x4*)(fo + col) = v; }
                }
        } else {
            bf16* dstb = (tt == 2) ? vb : ub;
            const int col0 = 256 * half + 32 * wc + 4 * fq;
#pragma unroll
            for (int ai = 0; ai < 2; ++ai)
#pragma unroll
                for (int m = 0; m < 4; ++m) {
                    const int row = row0 + ai * HALF + m * 16;
                    float* fo = nullptr;
                    if (tt == 2) { if (row < MP) fo = out + O_VP + (size_t)row * 512; else if (row < MV) fo = out + O_VS + (size_t)(row - MP) * 512; }
#pragma unroll
                    for (int bj = 0; bj < 2; ++bj)
#pragma unroll
                        for (int n = 0; n < 2; ++n) { const f32x4 v = acc[ai][bj][m][n]; const int col = col0 + 128 * bj + 16 * n;
                            v2u w; w.x = pk2(v[0], v[1]); w.y = pk2(v[2], v[3]); *(v2u*)(dstb + (size_t)row * 512 + col) = w;
                            if (fo) *(f32x4*)(fo + col) = v; }
                }
        }
    }
};

struct EpiGlu {
    static constexpr bool PERM = false, AFTER_DRAIN = false;
    const bf16* gb; bf16* mix; const float* bias;
    __device__ __forceinline__ void operator()(const f32x4 (&acc)[2][2][4][2], const Unit& u, int wr, int wc, int fr, int fq) const {
        const int row0 = u.pm * BM + wr * 64 + fr, col0 = u.pn * BM + wc * 32 + 4 * fq;
        f32x4 bv[2][2];
#pragma unroll
        for (int bj = 0; bj < 2; ++bj)
#pragma unroll
            for (int n = 0; n < 2; ++n) bv[bj][n] = *(const f32x4*)(bias + col0 + bj * HALF + n * 16);
#pragma unroll
        for (int ai = 0; ai < 2; ++ai)
#pragma unroll
            for (int m = 0; m < 4; ++m) { const int row = row0 + ai * HALF + m * 16;
#pragma unroll
                for (int bj = 0; bj < 2; ++bj)
#pragma unroll
                    for (int n = 0; n < 2; ++n) { const int col = col0 + bj * HALF + n * 16;
                        const f32x4 z = acc[ai][bj][m][n] + bv[bj][n];
                        const v2u gw = *(const v2u*)(gb + (size_t)row * 512 + col);
                        float gg[4] = { bf2f((unsigned short)(gw.x & 0xffffu)), bf2f((unsigned short)(gw.x >> 16)), bf2f((unsigned short)(gw.y & 0xffffu)), bf2f((unsigned short)(gw.y >> 16)) };
                        float o[4];
#pragma unroll
                        for (int e = 0; e < 4; ++e) o[e] = gg[e] * __builtin_amdgcn_rcpf(1.0f + __builtin_amdgcn_exp2f(-1.4426950408889634f * z[e]));
                        v2u w; w.x = pk2(o[0], o[1]); w.y = pk2(o[2], o[3]); *(v2u*)(mix + (size_t)row * DM + 512 + col) = w; }
            }
    }
};

struct EpiOut {
    static constexpr bool PERM = false, AFTER_DRAIN = false;
    const float *xp, *xs, *meta; float* x1; bf16* x1b; float* rowss;
    __device__ __forceinline__ void operator()(const f32x4 (&acc)[2][2][4][2], const Unit& u, int wr, int wc, int fr, int fq) const {
        const int row0 = u.pm * BM + wr * 64 + fr, col0 = u.pn * BM + wc * 32 + 4 * fq;
#pragma unroll
        for (int ai = 0; ai < 2; ++ai)
#pragma unroll
            for (int m = 0; m < 4; ++m) { const int row = row0 + ai * HALF + m * 16;
                const float* src = nullptr;
                if (row < MP) { const int b = row / LP, t = row - b * LP; src = t < NMETA ? meta + (size_t)t * DM : xp + ((size_t)b * SEQ + (t - NMETA)) * DM; }
                else if (row < MV) src = xs + (size_t)(row - MP) * DM;
                float ss = 0.f;
#pragma unroll
                for (int bj = 0; bj < 2; ++bj)
#pragma unroll
                    for (int n = 0; n < 2; ++n) { const int col = col0 + bj * HALF + n * 16;
                        f32x4 v = acc[ai][bj][m][n]; if (src) v += *(const f32x4*)(src + col);
                        ss += (v[0] * v[0] + v[1] * v[1]) + (v[2] * v[2] + v[3] * v[3]);
                        *(f32x4*)(x1 + (size_t)row * DM + col) = v;
                        v2u w; w.x = pk2(v[0], v[1]); w.y = pk2(v[2], v[3]); *(v2u*)(x1b + (size_t)row * DM + col) = w; }
                ss += __shfl_xor(ss, 16); ss += __shfl_xor(ss, 32);
                if (fq == 0) atomicAdd(rowss + row, ss);
            }
    }
};

__device__ __forceinline__ float dpp_ror1(float v) { return __builtin_bit_cast(float, __builtin_amdgcn_update_dpp(0, __builtin_bit_cast(int, v), 0x121, 0xf, 0xf, false)); }
__device__ __forceinline__ float dpp_ror2(float v) { return __builtin_bit_cast(float, __builtin_amdgcn_update_dpp(0, __builtin_bit_cast(int, v), 0x122, 0xf, 0xf, false)); }
constexpr int MT2 = 68, MSTEP2 = 254;
struct EpiGateUp {
    static constexpr bool PERM = false, AFTER_DRAIN = false;
    const float* rowss; bf16* hb; float* out; const float *cw, *cb, *hist; LAS float* xch;
    __device__ __forceinline__ void operator()(const f32x4 (&acc)[2][2][4][2], const Unit& u, int wr, int wc, int fr, int fq) const {
        const int trow0 = wr * 64 + fr;
        const int grow0 = u.pm * MSTEP2 - 2 + trow0;
        const int colw = wc * 32 + 4 * fq;
        const int col0 = u.pn * 128 + colw;
#pragma unroll
        for (int ai = 0; ai < 2; ++ai) { int R = grow0 + ai * HALF + 48; R = R < 0 ? 0 : (R >= MPAD ? MPAD - 1 : R);
            const float rs = rsqrtf(rowss[R] * (1.0f / DM) + EPS);
            if (fr >= 14) {
#pragma unroll
                for (int n = 0; n < 2; ++n) *(LAS f32x4*)(xch + ((ai * 2 + wr) * 2 + (fr - 14)) * 128 + colw + 16 * n) = acc[ai][0][3][n] * rs; } }
        asm volatile("s_waitcnt lgkmcnt(0)" ::: "memory"); __builtin_amdgcn_s_barrier(); asm volatile("" ::: "memory");
        f32x4 w0[2], w1[2], w2[2], bb[2];
#pragma unroll
        for (int n = 0; n < 2; ++n) { w0[n] = *(const f32x4*)(cw + col0 + 16 * n); w1[n] = *(const f32x4*)(cw + FF + col0 + 16 * n); w2[n] = *(const f32x4*)(cw + 2 * FF + col0 + 16 * n); bb[n] = *(const f32x4*)(cb + col0 + 16 * n); }
#pragma unroll
        for (int ai = 0; ai < 2; ++ai) {
            f32x4 pr1[2], pr2[2];
            {   const bool hasprev = !(ai == 0 && wr == 0);
                const int pg = (wr == 1) ? (ai * 2) : ((ai - 1) * 2 + 1);
#pragma unroll
                for (int n = 0; n < 2; ++n) { f32x4 x62 = (f32x4){0.f, 0.f, 0.f, 0.f}, x63 = x62;
                    if (hasprev) { x62 = *(const LAS f32x4*)(xch + (pg * 2 + 0) * 128 + colw + 16 * n); x63 = *(const LAS f32x4*)(xch + (pg * 2 + 1) * 128 + colw + 16 * n); }
                    pr1[n] = x63; pr2[n] = (fr == 0) ? x62 : x63; } }
#pragma unroll
            for (int m = 0; m < 4; ++m) {
                const int trow = trow0 + ai * HALF + m * 16, R = grow0 + ai * HALF + m * 16;
                const int Rc = R < 0 ? 0 : (R >= MPAD ? MPAD - 1 : R);
                const float rs = rsqrtf(rowss[Rc] * (1.0f / DM) + EPS);
                int t = 2; const float* hs = nullptr; float* fo = nullptr;
                if (Rc < MP) { const int b = Rc / LP; t = Rc - b * LP; if (t >= LP - 2) fo = out + O_CP + (size_t)(b * 2 + (t - (LP - 2))) * FF; }
                else if (Rc < MV) { const int db = (Rc - MP) >> 2; t = (Rc - MP) & 3; hs = hist + (size_t)db * 2 * FF; if (t >= 2) fo = out + O_CS + (size_t)(db * 2 + (t - 2)) * FF; }
                const bool store = (trow >= 2) && (R < MPAD);
#pragma unroll
                for (int n = 0; n < 2; ++n) {
                    const f32x4 a0 = acc[ai][0][m][n] * rs, c = acc[ai][1][m][n] * rs;
                    f32x4 r1, r2;
#pragma unroll
                    for (int e = 0; e < 4; ++e) { r1[e] = dpp_ror1(a0[e]); r2[e] = dpp_ror2(a0[e]); }
                    f32x4 a1, a2;
#pragma unroll
                    for (int e = 0; e < 4; ++e) { a1[e] = (fr >= 1) ? r1[e] : pr1[n][e]; a2[e] = (fr >= 2) ? r2[e] : pr2[n][e]; }
                    pr1[n] = r1; pr2[n] = r2;
                    if (t < 2) {
                        const f32x4 z = (f32x4){0.f, 0.f, 0.f, 0.f};
                        if (t == 0) { a1 = hs ? *(const f32x4*)(hs + FF + col0 + 16 * n) : z; a2 = hs ? *(const f32x4*)(hs + col0 + 16 * n) : z; }
                        else a2 = hs ? *(const f32x4*)(hs + FF + col0 + 16 * n) : z;
                    }
                    if (store) {
                        const f32x4 cv = bb[n] + w0[n] * a2 + w1[n] * a1 + w2[n] * a0;
                        float o[4];
#pragma unroll
                        for (int e = 0; e < 4; ++e) o[e] = gelu_tanh(cv[e]) * c[e];
                        v2u w; w.x = pk2(o[0], o[1]); w.y = pk2(o[2], o[3]); *(v2u*)(hb + (size_t)R * FF + col0 + 16 * n) = w;
                        if (fo) *(f32x4*)(fo + col0 + 16 * n) = a0;
                    }
                }
            }
        }
    }
};

struct EpiDown {
    static constexpr bool PERM = false, AFTER_DRAIN = false;
    const float* x1; float* out;
    __device__ __forceinline__ void operator()(const f32x4 (&acc)[2][2][4][2], const Unit& u, int wr, int wc, int fr, int fq) const {
        const int row0 = u.pm * BM + wr * 64 + fr, col0 = u.pn * BM + wc * 32 + 4 * fq;
#pragma unroll
        for (int ai = 0; ai < 2; ++ai)
#pragma unroll
            for (int m = 0; m < 4; ++m) { const int row = row0 + ai * HALF + m * 16;
                float* fo = nullptr;
                if (row < MP) { const int b = row / LP, t = row - b * LP; if (t >= NMETA) fo = out + O_YP + ((size_t)b * SEQ + (t - NMETA)) * DM; }
                else if (row < MV) fo = out + O_YS + (size_t)(row - MP) * DM;
                if (fo) {
#pragma unroll
                    for (int bj = 0; bj < 2; ++bj)
#pragma unroll
                        for (int n = 0; n < 2; ++n) { const int col = col0 + bj * HALF + n * 16;
                            *(f32x4*)(fo + col) = acc[ai][bj][m][n] + *(const f32x4*)(x1 + (size_t)row * DM + col); }
                }
            }
    }
};

typedef LAS const char* lds_cptr;
__device__ __forceinline__ unsigned off_b(unsigned row, unsigned ch) { return 256u * row + 16u * (ch ^ (((row & 3u) << 2) | ((row >> 2) & 3u))); }
__device__ __forceinline__ s16x4 vtr(lds_cptr p) { return __builtin_bit_cast(s16x4, __builtin_amdgcn_ds_read_tr16_b64_v4i16((LAS s16x4*)p)); }
__device__ __forceinline__ int crow(int r, int hi) { return (r & 3) + 8 * (r >> 2) + 4 * hi; }
#define MFMA32(a, b, c) __builtin_amdgcn_mfma_f32_32x32x16_bf16((a), (b), (c), 0, 0, 0)
#define MFMA16(a, b, c) __builtin_amdgcn_mfma_f32_16x16x32_bf16((a), (b), (c), 0, 0, 0)

constexpr int ATT_K = 0, ATT_V = 32768, ATT_WS = 65536, ATT_Q = 67584;
__device__ __forceinline__ void attn_unit(Frame& F, int b, int h, int qi) {
    int lane_ = F.lane; asm volatile("" : "+v"(lane_));
    const int lane = lane_, w = F.wave, r32 = lane & 31, hi = lane >> 5;
    const int rowb = b * LP;
    const int Q0 = NMETA + 256 * qi + 32 * w;
    const int NT = 4 * qi + 5;
    LAS unsigned char* lds = F.lds;
    { LAS unsigned char* Qw = lds + ATT_Q + 8192 * w + 16 * lane; const bf16* qp = F.QB + ((long)(rowb + Q0 + r32)) * 512 + h * 128 + hi * 8;
#pragma unroll
      for (int ks = 0; ks < 8; ++ks) *(LAS v4u*)(Qw + 1024 * ks) = *(const v4u*)(qp + ks * 16); }
    f32x16 o0[4], o1[4];
#pragma unroll
    for (int c = 0; c < 4; ++c) { o0[c] = (f32x16){}; o1[c] = (f32x16){}; }
    float l0 = 0.f, l1 = 0.f;
    const char* kg = (const char*)(F.KB + (size_t)rowb * 512 + h * 128);
    const char* vg = (const char*)(F.VB + (size_t)rowb * 512 + h * 128);
#define ATT_STAGE(j, buf) do { const char* kt_ = kg + (size_t)(64 * (j)) * 1024; const char* vt_ = vg + (size_t)(64 * (j)) * 1024; unsigned ln_ = lane; asm volatile("" : "+v"(ln_)); \
        _Pragma("unroll") for (int i_ = 0; i_ < 2; ++i_) { const unsigned row_ = 4u * (w + 8 * i_) + (ln_ >> 4), ch_ = (ln_ & 15) ^ (((row_ & 3u) << 2) | ((row_ >> 2) & 3u)); \
        const unsigned vr_ = (row_ & ~12u) | ((row_ & 4u) << 1) | ((row_ & 8u) >> 1); \
        __builtin_amdgcn_global_load_lds((const unsigned*)(kt_ + (row_ * 1024u + ch_ * 16u)), (LAS unsigned*)(lds + ATT_K + (buf) * 16384 + (w + 8 * i_) * 1024), 16, 0, 0); \
        __builtin_amdgcn_global_load_lds((const unsigned*)(vt_ + (vr_ * 1024u + ch_ * 16u)), (LAS unsigned*)(lds + ATT_V + (buf) * 16384 + (w + 8 * i_) * 1024), 16, 0, 0); } } while (0)
    ATT_STAGE(0, 0); VM_WAIT(); __syncthreads();
    for (int j = 0; j < NT; ++j) {
        const int buf = j & 1;
        if (j + 1 < NT) ATT_STAGE(j + 1, buf ^ 1);
        if (64 * j <= Q0 + 31) {
            const LAS unsigned char* Kb = lds + ATT_K + buf * 16384; const LAS unsigned char* Vb = lds + ATT_V + buf * 16384;
            const bool needmask = (64 * j + 63 > Q0);
            unsigned ln = lane; asm volatile("" : "+v"(ln));
            const unsigned r32v = ln & 31u, hiv = ln >> 5, blk = (ln >> 4) & 1u, qq = (ln & 15u) >> 2, pp = ln & 3u;
            const unsigned kra = off_b(r32v, hiv);
            const unsigned vba = off_b(8 * hiv + qq, 2 * blk + (pp >> 1)) + 8 * (pp & 1), vbb = off_b(8 * hiv + 4 + qq, 2 * blk + (pp >> 1)) + 8 * (pp & 1);
            const LAS unsigned char* Qw = lds + ATT_Q + 8192 * w + 16 * ln;
            const int qpos = Q0 + (int)r32v;
            bf16x8 pk0[4], pk1[4];
#define PK8(X, B) __builtin_bit_cast(bf16x8, (v4u){ cvtpk(X[B], X[B + 1]), cvtpk(X[B + 2], X[B + 3]), cvtpk(X[B + 4], X[B + 5]), cvtpk(X[B + 6], X[B + 7]) })
#define ATT_QK(KS0, HALF_, PK, LACC) do { f32x16 sa; \
                if (needmask) { _Pragma("unroll") for (int r = 0; r < 16; ++r) sa[r] = (64 * j + 32 * (HALF_) + crow(r, (int)hiv) > qpos) ? -1.0e30f : 0.f; } else sa = (f32x16){}; \
                _Pragma("unroll") for (int ks = (KS0); ks < (KS0) + 4; ++ks) { const bf16x8 qv = *(const LAS bf16x8*)(Qw + 1024 * ks); \
                    const bf16x8 a0 = *(const LAS bf16x8*)(Kb + 8192 * (HALF_) + (kra ^ (32u * ks))); \
                    sa = MFMA32(a0, qv, sa); } \
                float ls_ = 0.f; \
                _Pragma("unroll") for (int r = 0; r < 16; ++r) { sa[r] = __builtin_amdgcn_exp2f(sa[r]); ls_ += sa[r]; } \
                LACC += ls_; PK[2 * (HALF_)] = PK8(sa, 0); PK[2 * (HALF_) + 1] = PK8(sa, 8); } while (0)
            ATT_QK(0, 0, pk0, l0); __builtin_amdgcn_sched_barrier(0);
            ATT_QK(0, 1, pk0, l0); __builtin_amdgcn_sched_barrier(0);
            ATT_QK(4, 0, pk1, l1); __builtin_amdgcn_sched_barrier(0);
            ATT_QK(4, 1, pk1, l1); __builtin_amdgcn_sched_barrier(0);
#undef ATT_QK
#undef PK8
#pragma unroll
            for (int c = 0; c < 4; ++c)
#pragma unroll
                for (int ks = 0; ks < 4; ++ks) {
                    const s16x4 lo = vtr((lds_cptr)(Vb + (vba ^ (64u * c)) + 4096 * ks)), hh = vtr((lds_cptr)(Vb + (vbb ^ (64u * c)) + 4096 * ks));
                    const bf16x8 vf = (bf16x8){ lo[0], lo[1], lo[2], lo[3], hh[0], hh[1], hh[2], hh[3] };
                    o0[c] = MFMA32(pk0[ks], vf, o0[c]); o1[c] = MFMA32(pk1[ks], vf, o1[c]);
                    if (ks == 3) __builtin_amdgcn_sched_barrier(0);
                }
        }
        VM_WAIT(); __syncthreads();
    }
#undef ATT_STAGE
    const float lam = F.PAR[PA_LAM];
    l0 += __shfl_xor(l0, 32); l1 += __shfl_xor(l1, 32);
    LAS float* wsf = (LAS float*)(lds + ATT_WS) + w * 64;
    if (hi == 0) { wsf[r32] = l0; wsf[32 + r32] = l1; }
    LDS_WAIT(); asm volatile("" ::: "memory");
    const float* subn = F.in[I_SUBN];
    float sn[4];
#pragma unroll
    for (int c = 0; c < 4; ++c) sn[c] = subn[32 * c + r32] * (1.0f - LAM_INIT);
#pragma unroll
    for (int r = 0; r < 16; ++r) {
        const int qr = crow(r, hi);
        const float i0 = 1.0f / wsf[qr], i1 = lam / wsf[32 + qr];
        float v[4]; float ss = 0.f;
#pragma unroll
        for (int c = 0; c < 4; ++c) { v[c] = o0[c][r] * i0 - o1[c][r] * i1; ss += v[c] * v[c]; }
        ss += __shfl_xor(ss, 1); ss += __shfl_xor(ss, 2); ss += __shfl_xor(ss, 4); ss += __shfl_xor(ss, 8); ss += __shfl_xor(ss, 16);
        const float rn = rsqrtf(ss * (1.0f / 128.0f) + EPS);
        const int pos = Q0 + qr;
        if (pos >= 0) { bf16* dst = F.MIX + (size_t)(rowb + pos) * DM + h * 128 + r32;
#pragma unroll
            for (int c = 0; c < 4; ++c) dst[32 * c] = (bf16)f2bf(v[c] * rn * sn[c]); }
    }
    LDS_WAIT();
}

constexpr int NSL = 4, PPG = NPG / NSL;
constexpr int DEC_RED = 0, DEC_P = 0, DEC_Q = 16384;
__device__ __forceinline__ bf16x8 cvt8(const f32x4 a, const f32x4 b) { return __builtin_bit_cast(bf16x8, (v4u){ cvtpk(a[0], a[1]), cvtpk(a[2], a[3]), cvtpk(b[0], b[1]), cvtpk(b[2], b[3]) }); }
__device__ __forceinline__ f32x4 ldnt4(const float* p) { return __builtin_nontemporal_load((const f32x4*)p); }
__device__ __forceinline__ void decode_unit(Frame& F, int db, int pg) {
    int lane_ = F.lane; asm volatile("" : "+v"(lane_));
    const int lane = lane_, w = F.wave, col = lane & 15, kg = lane >> 4;
    LAS unsigned char* lds = F.lds;
    if (w < 4) {
        const int h = w;
#pragma unroll
        for (int kb = 0; kb < 4; ++kb) { v4u q = (v4u){0u, 0u, 0u, 0u};
            if (col < 8 && (col >> 2) == (kb >> 1)) q = *(const v4u*)(F.QB + (size_t)(MP + db * 4 + (col & 3)) * 512 + h * 128 + kb * 32 + kg * 8);
            *(LAS v4u*)(lds + DEC_Q + ((h * 4 + kb) * 64 + lane) * 16) = q; }
    }
    __syncthreads();
    const int hb = (w >> 2) * 2, hl = lane >> 5;
    f32x4 O[8];
#pragma unroll
    for (int c = 0; c < 8; ++c) O[c] = (f32x4){0.f, 0.f, 0.f, 0.f};
    float lsum[2] = {0.f, 0.f};
    const int* pt = (const int*)F.in[I_PT] + db * NPG + pg * PPG;
    LAS float* Pw = (LAS float*)(lds + DEC_P + 1024 * w);
    const LAS unsigned char* Qf = lds + DEC_Q + (hb * 4 * 64 + lane) * 16;
    const size_t koff = (size_t)(32 * (w & 3) + col) * 512 + hb * 128 + kg * 8;
    const size_t voff = (size_t)(32 * (w & 3)) * 512 + hb * 128 + 4 * lane;
    f32x4 bA[16], bB[16];
#define LD_K(KP) do { _Pragma("unroll") for (int i = 0; i < 8; ++i) { bA[2 * i] = ldnt4((KP) + koff + i * 32); bA[2 * i + 1] = ldnt4((KP) + koff + i * 32 + 4); } } while (0)
#define LD_V(VP) do { _Pragma("unroll") for (int i = 0; i < 16; ++i) bB[i] = ldnt4((VP) + voff + (size_t)i * 512); } while (0)
    int page = __builtin_amdgcn_readfirstlane(pt[0]);
    LD_K(F.in[I_CK] + (size_t)page * PAGE * 512);
    LD_V(F.in[I_CV] + (size_t)page * PAGE * 512);
#define DEC_BODY(GI, LOADNEXT) do { \
        const int gn = (GI) + 1; \
        const int npage = __builtin_amdgcn_readfirstlane(pt[(LOADNEXT) ? (gn >> 1) : 0]); \
        const float* nkp = F.in[I_CK] + ((size_t)npage * PAGE + 16 * (gn & 1)) * 512; \
        const float* nvp = F.in[I_CV] + ((size_t)npage * PAGE + 16 * (gn & 1)) * 512; \
        f32x4 acc[2]; \
        _Pragma("unroll") for (int hh = 0; hh < 2; ++hh) { f32x4 ac = (f32x4){0.f, 0.f, 0.f, 0.f}; \
            _Pragma("unroll") for (int kb = 0; kb < 4; ++kb) { const bf16x8 a = cvt8(bA[2 * (hh * 4 + kb)], bA[2 * (hh * 4 + kb) + 1]); \
                const bf16x8 bq = *(const LAS bf16x8*)(Qf + (hh * 4 + kb) * 1024); ac = MFMA16(a, bq, ac); } \
            acc[hh] = ac; } \
        __builtin_amdgcn_sched_barrier(0); \
        if (LOADNEXT) LD_K(nkp); \
        __builtin_amdgcn_sched_barrier(0); \
        if (col < 8) { \
            _Pragma("unroll") for (int hh = 0; hh < 2; ++hh) \
                _Pragma("unroll") for (int e = 0; e < 4; ++e) { const float p = __builtin_amdgcn_exp2f(acc[hh][e]); lsum[hh] += p; Pw[((4 * kg + e) * 2 + hh) * 8 + col] = p; } \
        } \
        LDS_WAIT(); asm volatile("" ::: "memory"); \
        __builtin_amdgcn_sched_barrier(0); \
        _Pragma("unroll") for (int s_ = 0; s_ < 16; ++s_) { \
            const f32x4 pa = *(const LAS f32x4*)(Pw + (s_ * 2 + hl) * 8), pb = *(const LAS f32x4*)(Pw + (s_ * 2 + hl) * 8 + 4); \
            _Pragma("unroll") for (int c = 0; c < 4; ++c) { O[c] += bB[s_] * pa[c]; O[4 + c] += bB[s_] * pb[c]; } \
        } \
        __builtin_amdgcn_sched_barrier(0); \
        if (LOADNEXT) LD_V(nvp); \
        LDS_WAIT(); asm volatile("" ::: "memory"); \
        __builtin_amdgcn_sched_barrier(0); \
    } while (0)
#pragma unroll 1
    for (int gi = 0; gi < 2 * PPG - 1; ++gi) DEC_BODY(gi, true);
    DEC_BODY(2 * PPG - 1, false);
#undef DEC_BODY
#undef LD_K
#undef LD_V
    __syncthreads();
#pragma unroll
    for (int c = 0; c < 8; ++c) *(LAS f32x4*)(lds + DEC_RED + ((w * 8 + c) * 64 + lane) * 16) = O[c];
#pragma unroll
    for (int hh = 0; hh < 2; ++hh) { float l = lsum[hh]; l += __shfl_xor(l, 16); l += __shfl_xor(l, 32); if (lane < 8) ((LAS float*)(lds + 131072))[(w * 2 + hh) * 8 + lane] = l; }
    __syncthreads();
    float* slab = F.SLO + ((size_t)(db * NSL + pg)) * 4096;
#pragma unroll
    for (int k = 0; k < 2; ++k) { const int sc = 2 * w + k, set = sc >> 3, cc = sc & 7;
        f32x4 s = (f32x4){0.f, 0.f, 0.f, 0.f};
#pragma unroll
        for (int ww = 0; ww < 4; ++ww) s += *(const LAS f32x4*)(lds + DEC_RED + (((4 * set + ww) * 8 + cc) * 64 + lane) * 16);
        const int h = 2 * set + hl;
        *(f32x4*)(slab + (h * 8 + cc) * 128 + 4 * (lane & 31)) = s; }
    if (w == 0 && lane < 32) { const int h = lane >> 3, cc = lane & 7; float s = 0.f;
#pragma unroll
        for (int ww = 0; ww < 4; ++ww) s += ((const LAS float*)(lds + 131072))[((4 * (h >> 1) + ww) * 2 + (h & 1)) * 8 + cc];
        F.SLL[(size_t)(db * NSL + pg) * 32 + lane] = s; }
    __syncthreads();
}

__device__ __forceinline__ void decode_final(Frame& F, int db, int h) {
    int lane_ = F.lane; asm volatile("" : "+v"(lane_));
    const int lane = lane_;
    const float lam = F.PAR[PA_LAM];
    const float sn0 = F.in[I_SUBN][2 * lane] * (1.0f - LAM_INIT), sn1 = F.in[I_SUBN][2 * lane + 1] * (1.0f - LAM_INIT);
    const int rbase = MP + db * 4;
    float vn0[4], vn1[4];
#pragma unroll
    for (int j = 0; j < 4; ++j) { const unsigned vw = *(const unsigned*)(F.VB + (size_t)(rbase + j) * 512 + h * 128 + 2 * lane); vn0[j] = bf2f((unsigned short)(vw & 0xffffu)); vn1[j] = bf2f((unsigned short)(vw >> 16)); }
#pragma unroll
    for (int tq = 0; tq < 4; ++tq) {
        float o[2][2], l[2];
#pragma unroll
        for (int c = 0; c < 2; ++c) {
            const int cc = 4 * c + tq;
            float a0 = 0.f, a1 = 0.f, ls = 0.f;
#pragma unroll
            for (int pg = 0; pg < NSL; ++pg) { const f32x2 t = *(const f32x2*)(F.SLO + ((size_t)(db * NSL + pg) * 32 + h * 8 + cc) * 128 + 2 * lane); a0 += t.x; a1 += t.y; ls += F.SLL[(size_t)(db * NSL + pg) * 32 + h * 8 + cc]; }
            const float qv = bf2f(F.QB[(size_t)(rbase + tq) * 512 + h * 128 + c * 64 + lane]);
#pragma unroll
            for (int j = 0; j < 4; ++j) if (j <= tq) {
                const float kv = bf2f(F.KB[(size_t)(rbase + j) * 512 + h * 128 + c * 64 + lane]);
                const float p = __builtin_amdgcn_exp2f(wave_sum(qv * kv));
                ls += p; a0 += p * vn0[j]; a1 += p * vn1[j]; }
            o[c][0] = a0; o[c][1] = a1; l[c] = ls;
        }
        const float i0 = 1.0f / l[0], i1 = lam / l[1];
        const float y0 = o[0][0] * i0 - o[1][0] * i1, y1 = o[0][1] * i0 - o[1][1] * i1;
        const float rn = rsqrtf(wave_sum(y0 * y0 + y1 * y1) * (1.0f / 128.0f) + EPS);
        *(unsigned*)(F.MIX + (size_t)(rbase + tq) * DM + h * 128 + 2 * lane) = pk2(y0 * rn * sn0, y1 * rn * sn1);
    }
}

constexpr int SSM_LE = 131072, SSM_CF = 139264, SSM_HP = 136;
__device__ __forceinline__ void ssm_unit(Frame& F, int b, int g) {
    int lane_ = F.lane; asm volatile("" : "+v"(lane_));
    const int lane = lane_, w = F.wave, r32 = lane & 31, hi = lane >> 5;
    LAS unsigned char* lds = F.lds;
    LAS float* X = (LAS float*)(lds + 16384 * w);
    LAS unsigned short* Hb = (LAS unsigned short*)(lds + 16384 * w);
    LAS float* LE = (LAS float*)(lds + SSM_LE);
    const int rowb = b * LP;
    const float ar = F.PAR[PA_ABR + g * 64 + lane], ai = F.PAR[PA_ABI + g * 64 + lane];
    float a32r = ar, a32i = ai;
#pragma unroll
    for (int i = 0; i < 5; ++i) { const float nr = a32r * a32r - a32i * a32i, ni = 2.0f * a32r * a32i; a32r = nr; a32i = ni; }
    bf16x8 Bf[2][2];
#pragma unroll
    for (int ri = 0; ri < 2; ++ri)
#pragma unroll
        for (int nb = 0; nb < 2; ++nb) { const float* s = F.PAR + (ri ? PA_BBI : PA_BBR) + ((g * 64 + 32 * nb + r32) * 16 + 8 * hi);
            Bf[ri][nb] = cvt8(*(const f32x4*)s, *(const f32x4*)(s + 4)); }
    const int cfl = (r32 & 15) | (hi << 4);
    if (w == 0 && r32 < 16) {
#pragma unroll
        for (int s = 0; s < 8; ++s) { const float* src = (s < 4 ? F.in[I_CRE] : F.in[I_CIM]) + ((size_t)(g * 16 + r32) * 64 + 16 * (s & 3) + 8 * hi);
            f32x4 x0 = *(const f32x4*)src, x1 = *(const f32x4*)(src + 4); if (s >= 4) { x0 = -x0; x1 = -x1; }
            *(LAS bf16x8*)(lds + SSM_CF + (s * 32 + cfl) * 16) = cvt8(x0, x1); }
    }
    __syncthreads();
    const float dsk = (r32 < 16) ? F.in[I_DSK][g * 16 + r32] : 0.f;
    float cr = 0.f, ci = 0.f;
    for (int it = 0; it < 9; ++it) {
        const int ck = 8 * it + w, t0 = 32 * ck;
        const bool active = ck < 65;
        float hlr[32], hli[32];
        float er = 0.f, ei = 0.f;
        if (active) {
            const bf16x8 A = *(const bf16x8*)(F.UB + (size_t)(rowb + t0 + r32) * 512 + 16 * g + 8 * hi);
            const f32x16 z = (f32x16){};
            const f32x16 xr0 = MFMA32(A, Bf[0][0], z), xr1 = MFMA32(A, Bf[0][1], z), xi0 = MFMA32(A, Bf[1][0], z), xi1 = MFMA32(A, Bf[1][1], z);
#pragma unroll
            for (int r = 0; r < 16; ++r) { const int t = crow(r, hi);
                X[t * 64 + r32] = xr0[r]; X[t * 64 + 32 + r32] = xr1[r]; X[2048 + t * 64 + r32] = xi0[r]; X[2048 + t * 64 + 32 + r32] = xi1[r]; }
            LDS_WAIT(); asm volatile("" ::: "memory");
#pragma unroll
            for (int t = 0; t < 32; ++t) { const float xr = X[t * 64 + lane], xi = X[2048 + t * 64 + lane];
                const float nr = ar * er - ai * ei + xr, ni = ar * ei + ai * er + xi; er = nr; ei = ni; hlr[t] = nr; hli[t] = ni; }
        }
        LE[((it & 1) * 8 + w) * 128 + lane] = er; LE[((it & 1) * 8 + w) * 128 + 64 + lane] = ei;
        LDS_WAIT(); __builtin_amdgcn_s_barrier(); asm volatile("" ::: "memory");
        float cinr = 0.f, cini = 0.f;
#pragma unroll
        for (int j = 0; j < 8; ++j) {
            if (j == w) { cinr = cr; cini = ci; }
            const float lr = LE[((it & 1) * 8 + j) * 128 + lane], li = LE[((it & 1) * 8 + j) * 128 + 64 + lane];
            const float nr = a32r * cr - a32i * ci + lr, ni = a32r * ci + a32i * cr + li; cr = nr; ci = ni;
        }
        if (active) {
            float pr = ar, pi = ai;
#pragma unroll
            for (int t = 0; t < 32; ++t) {
                const float hr = hlr[t] + pr * cinr - pi * cini, hq = hli[t] + pr * cini + pi * cinr;
                Hb[t * SSM_HP + lane] = (unsigned short)f2bf(hr); Hb[t * SSM_HP + 64 + lane] = (unsigned short)f2bf(hq);
                if (ck == 64 && t == 15) { F.out[O_SRP + (size_t)(b * NG + g) * 64 + lane] = hr; F.out[O_SIP + (size_t)(b * NG + g) * 64 + lane] = hq; }
                const float npr = pr * ar - pi * ai, npi = pr * ai + pi * ar; pr = npr; pi = npi;
            }
            LDS_WAIT(); asm volatile("" ::: "memory");
            f32x16 y = (f32x16){};
#pragma unroll
            for (int s = 0; s < 8; ++s) { const bf16x8 Af = *(const LAS bf16x8*)((LAS unsigned char*)Hb + r32 * (SSM_HP * 2) + (16 * s + 8 * hi) * 2);
                bf16x8 cf = *(const LAS bf16x8*)(lds + SSM_CF + (s * 32 + cfl) * 16); if (r32 >= 16) cf = (bf16x8){0, 0, 0, 0, 0, 0, 0, 0};
                y = MFMA32(Af, cf, y); }
            if (r32 < 16) {
#pragma unroll
                for (int r = 0; r < 16; ++r) { const int pos = t0 + crow(r, hi);
                    if (pos < LP) { const float uu = bf2f(F.UB[(size_t)(rowb + pos) * 512 + 16 * g + r32]);
                        F.GB[(size_t)(rowb + pos) * 512 + 16 * g + r32] = (bf16)f2bf(gelu_tanh(y[r] + dsk * uu)); } }
            }
            LDS_WAIT(); asm volatile("" ::: "memory");
        }
    }
    __syncthreads();
}

__device__ __forceinline__ void ssm_sample_unit(Frame& F, int db, int g) {
    int lane_ = F.lane; asm volatile("" : "+v"(lane_));
    const int lane = lane_, w = F.wave;
    LAS float* S = (LAS float*)(F.lds + 4096 * w);
    const int gp = g * 64 + lane;
    const float ar = F.PAR[PA_ABR + gp], ai = F.PAR[PA_ABI + gp];
    float hr = F.in[I_SRE][(size_t)(db * NG + g) * 64 + lane], hq = F.in[I_SIM][(size_t)(db * NG + g) * 64 + lane];
    float br[16], bi[16];
#pragma unroll
    for (int c = 0; c < 16; ++c) { br[c] = F.PAR[PA_BBR + gp * 16 + c]; bi[c] = F.PAR[PA_BBI + gp * 16 + c]; }
    const int rbase = MP + db * 4;
#pragma unroll
    for (int t = 0; t < 4; ++t) {
        float xr = 0.f, xi = 0.f;
#pragma unroll
        for (int c = 0; c < 16; ++c) { const float uu = bf2f(F.UB[(size_t)(rbase + t) * 512 + 16 * g + c]); xr += br[c] * uu; xi += bi[c] * uu; }
        const float nr = ar * hr - ai * hq + xr, ni = ar * hq + ai * hr + xi; hr = nr; hq = ni;
        S[t * 128 + lane] = hr; S[t * 128 + 64 + lane] = hq;
    }
    F.out[O_SRS + (size_t)(db * NG + g) * 64 + lane] = hr; F.out[O_SIS + (size_t)(db * NG + g) * 64 + lane] = hq;
    LDS_WAIT(); asm volatile("" ::: "memory");
    const int t = lane >> 4, ch = lane & 15;
    const float* cre = F.in[I_CRE] + (size_t)(g * 16 + ch) * 64; const float* cim = F.in[I_CIM] + (size_t)(g * 16 + ch) * 64;
    float y = 0.f;
#pragma unroll 4
    for (int p = 0; p < 64; p += 4) { const f32x4 a = *(const f32x4*)(cre + p), c = *(const f32x4*)(cim + p);
        const f32x4 sr = *(const LAS f32x4*)(S + t * 128 + p), si = *(const LAS f32x4*)(S + t * 128 + 64 + p);
        y += (a[0] * sr[0] - c[0] * si[0]) + (a[1] * sr[1] - c[1] * si[1]) + (a[2] * sr[2] - c[2] * si[2]) + (a[3] * sr[3] - c[3] * si[3]); }
    const float uu = bf2f(F.UB[(size_t)(rbase + t) * 512 + 16 * g + ch]);
    F.GB[(size_t)(rbase + t) * 512 + 16 * g + ch] = (bf16)f2bf(gelu_tanh(y + F.in[I_DSK][g * 16 + ch] * uu));
    LDS_WAIT(); asm volatile("" ::: "memory");
}

struct Args { const void* in[N_IN]; float* out; unsigned char* ws; };
constexpr int NQ_MAIN = 4 * 288, NQ_SS = 64, NQ = NQ_MAIN + NQ_SS;

__global__ void __launch_bounds__(512, 2) hymba_fwd(Args args) {
    extern __shared__ __attribute__((aligned(16))) unsigned char lds_raw[];
    Frame F;
    F.lds = (LAS unsigned char*)lds_raw;
    F.MISC = (volatile LAS unsigned*)(F.lds + MISC_OFF);
    F.tid = threadIdx.x; F.lane = F.tid & 63; F.wave = __builtin_amdgcn_readfirstlane(F.tid >> 6);
    F.G = gridDim.x; { const int bx = blockIdx.x; F.vcu = (F.G % 8 == 0) ? (bx % 8) * (F.G / 8) + bx / 8 : bx; }
    unsigned char* ws = args.ws;
    F.ws = ws; F.out = args.out;
#pragma unroll
    for (int i = 0; i < N_IN; ++i) F.in[i] = (const float*)args.in[i];
    F.ctl = (gu32*)(ws + WS_CTL);
    F.WIN_t = (bf16*)(ws + WS_WIN); F.WGLU_t = (bf16*)(ws + WS_WGLU); F.WOUT_t = (bf16*)(ws + WS_WOUT); F.WGATE_t = (bf16*)(ws + WS_WGATE); F.WUP_t = (bf16*)(ws + WS_WUP); F.WDOWN_t = (bf16*)(ws + WS_WDOWN);
    F.XN = (bf16*)(ws + WS_XN); F.QB = (bf16*)(ws + WS_QB); F.KB = (bf16*)(ws + WS_KB); F.VB = (bf16*)(ws + WS_VB); F.UB = (bf16*)(ws + WS_UB);
    F.MIX = (bf16*)(ws + WS_MIX); F.GB = (bf16*)(ws + WS_G); F.AB = (bf16*)(ws + WS_A); F.HB = (bf16*)(ws + WS_H);
    F.X1 = (float*)(ws + WS_X1); F.PAR = (float*)(ws + WS_PAR); F.ROWSS = (float*)(ws + WS_CTL) + CW_ROWSS; F.SLO = (float*)(ws + WS_SLO); F.SLL = (float*)(ws + WS_SLL);
    for (int u = F.tid; u < (LDS_BYTES - MISC_OFF) / 4; u += 512) ((LAS unsigned*)(F.lds + MISC_OFF))[u] = 0u;
    __syncthreads();
#if defined(REP_BAR) && REP_BAR > 1
#define xcd_barrier(b) do { xcd_barrier(b); xcd_barrier(b); } while (0)
#endif
    XcdBarrier bar = xcd_barrier_post((unsigned*)(F.ctl + CW_BAR), F.MISC + 8);

    p0_prologue(F);
#if defined(REP_P0) && REP_P0 > 1
    __syncthreads(); p0_prologue(F);
#endif
    xcd_barrier(bar);

    {
        pg8::Gemm g{F.XN, F.WIN_t, MPAD, PWID, DM, DM, 256}; pg8::StaticOrder S; S.init(MPAD, PWID, F.G, (int)blockIdx.x);
        EpiProj E{F.QB, F.KB, F.VB, F.UB, F.out, F.in[I_QN], F.in[I_KN]};
        pg8::gemm_phase<EpiProj, pg8::StaticOrder, true, true>(F.lds, g, S, E);
#if defined(REP_P1) && REP_P1 > 1
        __syncthreads();
        pg8::gemm_phase<EpiProj, pg8::StaticOrder, true, true>(F.lds, g, S, E);
#endif
    }
    xcd_barrier(bar);

#define P2_QUEUE(QI, NUNITS, ...) do { for (;;) { \
        if (F.tid == 0) F.MISC[0] = __hip_atomic_fetch_add((unsigned*)(F.ctl + CW_QUEUE + 64 * (QI)), 1u, RLX_AGENT); \
        __syncthreads(); const int n = (int)F.MISC[0]; __syncthreads(); \
        if (n >= (NUNITS)) break; __VA_ARGS__; } } while (0)
#ifndef REP_SSM
#define REP_SSM 1
#endif
#ifndef REP_ATT
#define REP_ATT 1
#endif
#ifndef REP_DEC
#define REP_DEC 1
#endif
#pragma unroll 1
    for (int rep = 0; rep < REP_SSM; ++rep) P2_QUEUE(0 + 4 * rep, 256, ssm_unit(F, n >> 5, n & 31));
#pragma unroll 1
    for (int rep = 0; rep < REP_ATT; ++rep) P2_QUEUE(1 + 4 * rep, 288, { const int qi = 7 - n / 32, bh = n % 32; attn_unit(F, bh >> 2, bh & 3, qi); });
#pragma unroll 1
    for (int rep = 0; rep < REP_DEC; ++rep) P2_QUEUE(2 + 4 * rep, DB * NSL, decode_unit(F, n / NSL, n % NSL));
    P2_QUEUE(3, 64, { _Pragma("unroll 1") for (int i = 0; i < 8; ++i) { const int uidx = n * 64 + F.wave * 8 + i; ssm_sample_unit(F, uidx >> 5, uidx & 31); } });
#undef P2_QUEUE
    xcd_barrier(bar);

    {
        pg8::Gemm g{F.GB, F.WGLU_t, MPAD, SW, SW, SW, 256}; pg8::StaticOrder S; S.init(MPAD, SW, F.G, (int)blockIdx.x);
        EpiGlu E{F.GB, F.MIX, F.in[I_BGLU]};
        pg8::gemm_phase<EpiGlu, pg8::StaticOrder, true, true>(F.lds, g, S, E);
#if defined(REP_P3) && REP_P3 > 1
        __syncthreads();
        pg8::gemm_phase<EpiGlu, pg8::StaticOrder, true, true>(F.lds, g, S, E);
#endif
        for (int uidx = (F.G - 1 - (int)blockIdx.x) * 8 + F.wave; uidx < DB * NH; uidx += F.G * 8) decode_final(F, uidx >> 2, uidx & 3);
    }
    xcd_barrier(bar);

    {
        pg8::Gemm g{F.MIX, F.WOUT_t, MPAD, DM, DM, DM, 256}; pg8::StaticOrder S; S.init(MPAD, DM, F.G, (int)blockIdx.x);
        EpiOut E{F.in[I_XP], F.in[I_XS], F.in[I_META], F.X1, F.XN, F.ROWSS};
        pg8::gemm_phase<EpiOut, pg8::StaticOrder, true, true>(F.lds, g, S, E);
#if defined(REP_P4) && REP_P4 > 1
        __syncthreads();
        { EpiOut E2{F.in[I_XP], F.in[I_XS], F.in[I_META], F.X1, F.XN, F.SLO}; pg8::gemm_phase<EpiOut, pg8::StaticOrder, true, true>(F.lds, g, S, E2); }
#endif
    }
    xcd_barrier(bar);

    {
        pg8::Gemm g{F.XN - 2 * DM, F.WGATE_t, MT2 * 256, 2 * FF, DM, DM, MSTEP2}; pg8::StaticOrder S; S.init(MT2 * 256, 2 * FF, F.G, (int)blockIdx.x);
        EpiGateUp E{F.ROWSS, F.HB, F.out, F.in[I_CW], F.in[I_CB], F.in[I_SCONV], (LAS float*)(F.lds + RING_BYTES)};
        pg8::gemm_phase<EpiGateUp, pg8::StaticOrder, true, true>(F.lds, g, S, E);
#if defined(REP_P5) && REP_P5 > 1
        __syncthreads();
        pg8::gemm_phase<EpiGateUp, pg8::StaticOrder, true, true>(F.lds, g, S, E);
#endif
    }
    xcd_barrier(bar);

    {
        pg8::Gemm g{F.HB, F.WDOWN_t, MPAD, DM, FF, FF, 256}; pg8::StaticOrder S; S.init(MPAD, DM, F.G, (int)blockIdx.x);
        EpiDown E{F.X1, F.out};
        pg8::gemm_phase<EpiDown, pg8::StaticOrder, true, true>(F.lds, g, S, E);
#if defined(REP_P7) && REP_P7 > 1
        __syncthreads();
        pg8::gemm_phase<EpiDown, pg8::StaticOrder, true, true>(F.lds, g, S, E);
#endif
    }
}

extern "C" void kernel_launch(void* const* d_in, const int* in_sizes, int n_in, void* d_out, int out_size, void* d_ws, size_t ws_size, hipStream_t stream) {
    static int grid = 0;
    if (grid == 0) {
        if (n_in != N_IN || (size_t)out_size != O_END || ws_size < WS_END) { fprintf(stderr, "kernel_launch: unexpected shapes (n_in %d, out %d, ws %zu); nothing launched\n", n_in, out_size, ws_size); grid = -1; return; }
        int dev = 0, cus = 0, per_cu = 0;
        if (hipGetDevice(&dev) != hipSuccess || hipDeviceGetAttribute(&cus, hipDeviceAttributeMultiprocessorCount, dev) != hipSuccess) { grid = -1; return; }
        if (hipFuncSetAttribute((const void*)hymba_fwd, hipFuncAttributeMaxDynamicSharedMemorySize, LDS_BYTES) != hipSuccess) { fprintf(stderr, "kernel_launch: hipFuncSetAttribute failed\n"); grid = -1; return; }
        if (hipOccupancyMaxActiveBlocksPerMultiprocessor(&per_cu, (const void*)hymba_fwd, 512, LDS_BYTES) != hipSuccess || per_cu < 1)
            fprintf(stderr, "kernel_launch: note: occupancy query reports %d workgroups per CU\n", per_cu);
        (void)hipGetLastError();
        grid = cus;
    }
    if (grid < 0) return;
    if (hipMemsetAsync((char*)d_ws + WS_CTL, 0, CTL_ZERO_BYTES, stream) != hipSuccess) return;
    Args a{};
    for (int i = 0; i < N_IN; ++i) a.in[i] = d_in[i];
    a.out = (float*)d_out; a.ws = (unsigned char*)d_ws;
    hipLaunchKernelGGL(hymba_fwd, dim3(grid), dim3(512), LDS_BYTES, stream, a);
}
```

```cpp
#include <hip/hip_runtime.h>
#include <hip/hip_bf16.h>
#include <cstdio>
#include <cstdint>
#include <cmath>
namespace pg8 {
#define PG8_LAS __attribute__((address_space(3)))
typedef unsigned short bf16_t;
typedef short bf16x8 __attribute__((ext_vector_type(8)));
typedef float f32x4 __attribute__((ext_vector_type(4)));
typedef unsigned u32x4 __attribute__((ext_vector_type(4)));
constexpr int BM = 256, BK = 64, HALF = 128, HTB = HALF * BK * 2  , STAGE_BYTES = 8 * HTB, NXCD = 8, WGM = 8;

__host__ __device__ __forceinline__ int lds_byte(int r, int c) { const int st = (r >> 4) * 2 + (c >> 5), rr = r & 15, cc = c & 31, ob = rr * 64 + cc * 2; return st * 1024 + (ob ^ (((ob >> 9) & 1) << 5)); }
__host__ __device__ __forceinline__ void stage_rc(int b, int& R, int& C) { const int st = b / 1024, sb = b % 1024, swz = sb ^ (((sb >> 9) & 1) << 5); R = (st >> 1) * 16 + swz / 64; C = (st & 1) * 32 + (swz % 64) / 2; }
__host__ __device__ __forceinline__ int perm32(int rho) { const int n = rho >> 4, i = rho & 15; return 8 * (i >> 2) + 4 * n + (i & 3); }

struct Unit { int pm, pn; };
struct Gemm { const bf16_t* A; const bf16_t* Bt; int M, N, K, ld, mstep; };

struct StaticOrder {
    int nM, nN, nwg, G, c;
    __host__ __device__ void init(int M, int N, int G_, int c_) { nM = M / BM; nN = N / BM; nwg = nM * nN; G = G_; c = c_; }
    __host__ __device__ bool next(int i, Unit& u) const {
        const long L = (long)i * G + c; if (L >= nwg) return false;
        int wgid = (int)L; { const int q = nwg / NXCD, r = nwg % NXCD, xcd = wgid % NXCD, off = wgid / NXCD; wgid = (xcd < r ? xcd * (q + 1) : r * (q + 1) + (xcd - r) * q) + off; }
        const int nig = WGM * nN, gid = wgid / nig, fm = gid * WGM, gsz = (nM - fm) < WGM ? (nM - fm) : WGM;
        u.pm = fm + ((wgid % nig) % gsz); u.pn = (wgid % nig) / gsz; return true;
    }
    __device__ __forceinline__ void a_ready(const Unit&) const {}
    __device__ __forceinline__ void done(const Unit&) const {}
};

__device__ __forceinline__ unsigned cvt_pk_bf16(float lo, float hi) { unsigned r; asm volatile("v_cvt_pk_bf16_f32 %0, %1, %2" : "=v"(r) : "v"(lo), "v"(hi)); return r; }
typedef float f32x2 __attribute__((ext_vector_type(2)));
__device__ __forceinline__ f32x2 gelu_pk(f32x2 v) {
    const f32x2 av = __builtin_elementwise_abs(v), d = av * 0.2316418882f + 1.0f;
    f32x2 t; t.x = __builtin_amdgcn_rcpf(d.x); t.y = __builtin_amdgcn_rcpf(d.y);
    f32x2 q = t * 0.5307027145f + (-0.7265760135f); q = q * t + 0.7107068705f; q = q * t + (-0.142248368f); q = q * t + 0.127414796f; q = q * t;
    const f32x2 s = (v * v) * (-0.72134752044f);
    f32x2 e; e.x = __builtin_amdgcn_exp2f(s.x); e.y = __builtin_amdgcn_exp2f(s.y);
    const f32x2 m = v * (q * e), r = v - m;
    f32x2 o; o.x = v.x < 0.f ? m.x : r.x; o.y = v.y < 0.f ? m.y : r.y; return o;
}

template <int ACT  > struct EpiBf16 {
    static constexpr bool PERM = true, AFTER_DRAIN = false; static_assert(ACT == 0 || ACT == 1, "EpiBf16: ACT is 0 (none) or 1 (gelu_pk)");
    bf16_t* O; int ldc; const float* bias; int split_cols; size_t split_stride; float scale0;
    __device__ __forceinline__ void operator()(const f32x4 (&acc)[2][2][4][2], const Unit& u, int wr, int wc, int fr, int fq) const {
        const int row0 = u.pm * BM + wr * 64 + fr; int colt = u.pn * BM; bf16_t* base = O;
        float sc = 1.f; if (split_cols) { const int t = colt / split_cols; base += (size_t)t * split_stride; colt -= t * split_cols; if (t == 0) sc = scale0; }
        const int col0 = colt + wc * 32 + 8 * fq, bcol0 = u.pn * BM + wc * 32 + 8 * fq;
        f32x4 bv[2][2];
#pragma unroll
        for (int bj = 0; bj < 2; ++bj)
#pragma unroll
            for (int n = 0; n < 2; ++n) bv[bj][n] = bias ? *(const f32x4*)(bias + bcol0 + bj * HALF + 4 * n) : (f32x4){0.f, 0.f, 0.f, 0.f};
#pragma unroll
        for (int ai = 0; ai < 2; ++ai)
#pragma unroll
            for (int m = 0; m < 4; ++m) { bf16_t* rowp = base + (size_t)(row0 + ai * HALF + m * 16) * ldc + col0;
#pragma unroll
                for (int bj = 0; bj < 2; ++bj) { f32x4 v0 = acc[ai][bj][m][0] + bv[bj][0], v1 = acc[ai][bj][m][1] + bv[bj][1];
                    if (ACT == 1) { f32x2 a = gelu_pk((f32x2){v0[0], v0[1]}), b = gelu_pk((f32x2){v0[2], v0[3]}), c = gelu_pk((f32x2){v1[0], v1[1]}), d = gelu_pk((f32x2){v1[2], v1[3]});
                        v0 = (f32x4){a.x, a.y, b.x, b.y}; v1 = (f32x4){c.x, c.y, d.x, d.y}; }
                    v0 = v0 * sc; v1 = v1 * sc; u32x4 w; w.x = cvt_pk_bf16(v0[0], v0[1]); w.y = cvt_pk_bf16(v0[2], v0[3]); w.z = cvt_pk_bf16(v1[0], v1[1]); w.w = cvt_pk_bf16(v1[2], v1[3]);
                    *(u32x4*)(rowp + bj * HALF) = w; } }
    }
};

template <class Epi, class Sched, bool ALIGN_EPI = false, bool SP2 = false>
__device__ __forceinline__ void gemm_phase(PG8_LAS unsigned char* lds, const Gemm g, const Sched& S, const Epi& E) {
    int tid_ = threadIdx.x; asm volatile("" : "+v"(tid_));
    const int tid = tid_, wid = __builtin_amdgcn_readfirstlane(tid >> 6), lane = tid & 63, wr = wid >> 2, wc = wid & 3, fr = lane & 15, fq = lane >> 4;
    const int K = g.ld, nt = g.K / BK;
    unsigned voffA[2], voffB[2];
#pragma unroll
    for (int i = 0; i < 2; ++i) { int R, C; stage_rc(tid * 16 + i * 8192, R, C); const int Rb = Epi::PERM ? ((R & ~31) + perm32(R & 31)) : R;
        voffA[i] = (unsigned)(R * K + C) * 2u; voffB[i] = (unsigned)(Rb * K + C) * 2u; }
    const size_t kstep = (size_t)(BK * 2);
    const size_t hstep = (size_t)HALF * K * 2;
    const size_t tstep = 2 * hstep, tstepA = (size_t)g.mstep * K * 2;
    const unsigned ldsw = (unsigned)wid * 1024u;
    const int aoff = lds_byte(wr * 64 + fr, fq * 8), boff = lds_byte(wc * 32 + fr, fq * 8);
#define PG8_SA(b, h) (((b) * 2 + (h)) * HTB)
#define PG8_SB(b, h) ((4 + (b) * 2 + (h)) * HTB)
#define PG8_STAGE(bufoff, gbase, voff) do { _Pragma("unroll") for (int _i = 0; _i < 2; ++_i) \
        __builtin_amdgcn_global_load_lds((const unsigned*)((const char*)(gbase) + (voff)[_i]), (PG8_LAS unsigned*)(lds + (bufoff) + ldsw + _i * 8192), 16, 0, 0); } while (0)
#define PG8_LDA(dst, b, h) do { _Pragma("unroll") for (int m = 0; m < 4; ++m) _Pragma("unroll") for (int k = 0; k < 2; ++k) dst[m][k] = *(const PG8_LAS bf16x8*)(lds + PG8_SA(b, h) + aoff + m * 2048 + k * 1024); } while (0)
#define PG8_LDB(dst, b, h) do { _Pragma("unroll") for (int n = 0; n < 2; ++n) _Pragma("unroll") for (int k = 0; k < 2; ++k) dst[n][k] = *(const PG8_LAS bf16x8*)(lds + PG8_SB(b, h) + boff + n * 2048 + k * 1024); } while (0)
#define PG8_MMA(ai, bj, At, Bt) do { __builtin_amdgcn_s_setprio(1); _Pragma("unroll") for (int m = 0; m < 4; ++m) _Pragma("unroll") for (int n = 0; n < 2; ++n) _Pragma("unroll") for (int k = 0; k < 2; ++k) \
        acc[ai][bj][m][n] = __builtin_amdgcn_mfma_f32_16x16x32_bf16(Bt[n][k], At[m][k], acc[ai][bj][m][n], 0, 0, 0); __builtin_amdgcn_s_setprio(0); } while (0)
#define PG8_WAIT_V(n) asm volatile("s_waitcnt vmcnt(" #n ")" ::: "memory")
#define PG8_WAIT_L(n) asm volatile("s_waitcnt lgkmcnt(" #n ")" ::: "memory")
#define PG8_BAR __builtin_amdgcn_s_barrier()
#define PG8_SCHED __builtin_amdgcn_sched_barrier(0)
    Unit cur, nxt; int ui = 0;
    if (!S.next(0, cur)) return;
    f32x4 acc[2][2][4][2];
#pragma unroll
    for (int a = 0; a < 2; ++a)
#pragma unroll
        for (int b = 0; b < 2; ++b)
#pragma unroll
            for (int m = 0; m < 4; ++m)
#pragma unroll
                for (int n = 0; n < 2; ++n) acc[a][b][m][n] = (f32x4){0.f, 0.f, 0.f, 0.f};
    bf16x8 At[4][2], B0[2][2], B1[2][2];
    const char* cA = (const char*)g.A + (size_t)cur.pm * tstepA; const char* cB = (const char*)g.Bt + (size_t)cur.pn * tstep;
    S.a_ready(cur);
    if constexpr (SP2) {
        PG8_STAGE(PG8_SB(0, 0), cB, voffB); PG8_STAGE(PG8_SB(0, 1), cB + hstep, voffB); PG8_STAGE(PG8_SA(0, 0), cA, voffA); PG8_STAGE(PG8_SA(0, 1), cA + hstep, voffA);
        if (wr == 1) PG8_BAR;
        PG8_WAIT_V(2); PG8_BAR;
        PG8_STAGE(PG8_SB(1, 0), cB + kstep, voffB); PG8_STAGE(PG8_SA(1, 0), cA + kstep, voffA); PG8_STAGE(PG8_SB(1, 1), cB + hstep + kstep, voffB);
        PG8_WAIT_V(6); PG8_BAR;
    } else {
        PG8_STAGE(PG8_SB(0, 0), cB, voffB); PG8_STAGE(PG8_SA(0, 0), cA, voffA); PG8_STAGE(PG8_SB(0, 1), cB + hstep, voffB); PG8_STAGE(PG8_SA(0, 1), cA + hstep, voffA);
        if (wr == 1) PG8_BAR;
        PG8_WAIT_V(4); PG8_BAR;
        PG8_STAGE(PG8_SB(1, 0), cB + kstep, voffB); PG8_STAGE(PG8_SA(1, 0), cA + kstep, voffA); PG8_STAGE(PG8_SB(1, 1), cB + hstep + kstep, voffB);
        PG8_WAIT_V(6); PG8_BAR;
    }
    for (;;) {
        const bool has_next = S.next(ui + 1, nxt);
        const char* nA = has_next ? (const char*)g.A + (size_t)nxt.pm * tstepA : cA; const char* nB = has_next ? (const char*)g.Bt + (size_t)nxt.pn * tstep : cB;
        for (int t = 0; t < nt; t += 2) {
            const bool last = (t == nt - 2);
            const char* a1 = cA + (size_t)(t + 1) * kstep;
            const char* a2 = last ? nA : cA + (size_t)(t + 2) * kstep; const char* b2 = last ? nB : cB + (size_t)(t + 2) * kstep;
            const char* a3 = a2 + kstep; const char* b3 = b2 + kstep;
            if (last && has_next) S.a_ready(nxt);
            if constexpr (SP2) {
            PG8_LDB(B0, 0, 0); PG8_LDB(B1, 0, 1); PG8_SCHED; PG8_LDA(At, 0, 0); PG8_STAGE(PG8_SA(1, 1), a1 + hstep, voffA);
            PG8_WAIT_V(8); PG8_WAIT_L(0); PG8_BAR; PG8_MMA(0, 0, At, B0); PG8_MMA(0, 1, At, B1); PG8_BAR; PG8_SCHED;
            PG8_LDA(At, 0, 1); PG8_STAGE(PG8_SB(0, 0), b2, voffB); PG8_STAGE(PG8_SB(0, 1), b2 + hstep, voffB); PG8_STAGE(PG8_SA(0, 0), a2, voffA);
            PG8_WAIT_V(8); PG8_WAIT_L(0); PG8_BAR; PG8_MMA(1, 0, At, B0); PG8_MMA(1, 1, At, B1); PG8_BAR; PG8_SCHED;
            PG8_LDB(B0, 1, 0); PG8_LDB(B1, 1, 1); PG8_SCHED; PG8_LDA(At, 1, 0); PG8_STAGE(PG8_SA(0, 1), a2 + hstep, voffA);
            PG8_WAIT_V(8); PG8_WAIT_L(0); PG8_BAR; PG8_MMA(0, 0, At, B0); PG8_MMA(0, 1, At, B1); PG8_BAR; PG8_SCHED;
            PG8_LDA(At, 1, 1); PG8_STAGE(PG8_SB(1, 0), b3, voffB); PG8_STAGE(PG8_SB(1, 1), b3 + hstep, voffB); PG8_STAGE(PG8_SA(1, 0), a3, voffA);
            PG8_WAIT_V(8); PG8_WAIT_L(0); PG8_BAR; PG8_MMA(1, 0, At, B0); PG8_MMA(1, 1, At, B1); PG8_BAR; PG8_SCHED;
            } else {
            PG8_LDB(B0, 0, 0); PG8_SCHED; PG8_LDA(At, 0, 0); PG8_STAGE(PG8_SA(1, 1), a1 + hstep, voffA);
            PG8_WAIT_L(8); PG8_BAR; PG8_WAIT_L(0); PG8_MMA(0, 0, At, B0); PG8_BAR; PG8_SCHED;
            PG8_LDB(B1, 0, 1); PG8_STAGE(PG8_SB(0, 0), b2, voffB);
            PG8_BAR; PG8_WAIT_L(0); PG8_MMA(0, 1, At, B1); PG8_BAR;
            PG8_LDA(At, 0, 1); PG8_STAGE(PG8_SA(0, 0), a2, voffA);
            PG8_BAR; PG8_WAIT_L(0); PG8_MMA(1, 0, At, B0); PG8_BAR; PG8_SCHED;
            PG8_STAGE(PG8_SB(0, 1), b2 + hstep, voffB);
            PG8_WAIT_V(6); PG8_BAR; PG8_MMA(1, 1, At, B1); PG8_BAR;
            PG8_LDB(B0, 1, 0); PG8_SCHED; PG8_LDA(At, 1, 0); PG8_STAGE(PG8_SA(0, 1), a2 + hstep, voffA);
            PG8_WAIT_L(8); PG8_BAR; PG8_WAIT_L(0); PG8_MMA(0, 0, At, B0); PG8_BAR; PG8_SCHED;
            PG8_LDB(B1, 1, 1); PG8_STAGE(PG8_SB(1, 0), b3, voffB);
            PG8_BAR; PG8_WAIT_L(0); PG8_MMA(0, 1, At, B1); PG8_BAR;
            PG8_LDA(At, 1, 1); PG8_STAGE(PG8_SA(1, 0), a3, voffA);
            PG8_BAR; PG8_WAIT_L(0); PG8_MMA(1, 0, At, B0); PG8_BAR; PG8_SCHED;
            PG8_STAGE(PG8_SB(1, 1), b3 + hstep, voffB);
            PG8_WAIT_V(6); PG8_BAR; PG8_MMA(1, 1, At, B1); PG8_BAR;
            }
        }
        if constexpr (ALIGN_EPI) { if (wr == 0) PG8_BAR; }
        if constexpr (!Epi::AFTER_DRAIN) { E(acc, cur, wr, wc, fr, fq); S.done(cur); }
        if (!has_next) break;
#pragma unroll
        for (int a = 0; a < 2; ++a)
#pragma unroll
            for (int b = 0; b < 2; ++b)
#pragma unroll
                for (int m = 0; m < 4; ++m)
#pragma unroll
                    for (int n = 0; n < 2; ++n) acc[a][b][m][n] = (f32x4){0.f, 0.f, 0.f, 0.f};
        cur = nxt; cA = nA; cB = nB; ++ui;
        if constexpr (ALIGN_EPI) { if (wr == 1) PG8_BAR; }
    }
    PG8_WAIT_V(0);
    if constexpr (!ALIGN_EPI) { if (wr == 0) PG8_BAR; }
    PG8_BAR;
    if constexpr (Epi::AFTER_DRAIN) { E.fused(acc, cur, wr, wc, fr, fq, lds, wid, lane); S.done(cur); }
#undef PG8_SA
#undef PG8_SB
#undef PG8_STAGE
#undef PG8_LDA
#undef PG8_LDB
#undef PG8_MMA
#undef PG8_WAIT_V
#undef PG8_WAIT_L
#undef PG8_BAR
#undef PG8_SCHED
}
}

constexpr int DM = 1024, NB = 8, SEQ = 2048, NMETA = 16, LP = SEQ + NMETA, DB = 128, TS = 4;
constexpr int MP = NB * LP, MS = DB * TS, MV = MP + MS, MPAD = 17152;
constexpr int NH = 4, HD = 128, QKD = 64, AW = 512, SW = 512, NG = 32, SG = 16, NST = 64, FF = 2816, PWID = 2048;
constexpr int NPG = 16, PAGE = 128;
constexpr float EPS = 1e-6f;
constexpr float QSCALE = 0.125f * 1.4426950408889634f;
constexpr float LAM_INIT = 0.2f;
constexpr size_t O_YP = 0, O_YS = O_YP + (size_t)NB * SEQ * DM, O_KP = O_YS + (size_t)MS * DM, O_VP = O_KP + (size_t)MP * 512,
                 O_KS = O_VP + (size_t)MP * 512, O_VS = O_KS + (size_t)MS * 512, O_SRP = O_VS + (size_t)MS * 512, O_SIP = O_SRP + NB * NG * NST,
                 O_SRS = O_SIP + NB * NG * NST, O_SIS = O_SRS + DB * NG * NST, O_CP = O_SIS + DB * NG * NST, O_CS = O_CP + (size_t)NB * 2 * FF,
                 O_END = O_CS + (size_t)DB * 2 * FF;
enum { I_XP = 0, I_XS, I_CK, I_CV, I_SRE, I_SIM, I_SCONV, I_PT, I_META, I_N1, I_WIN, I_QN, I_KN, I_LQ, I_LK, I_SUBN, I_ARE, I_AIM, I_LDT, I_BRE, I_BIM,
       I_CRE, I_CIM, I_DSK, I_WGLU, I_BGLU, I_WOUT, I_N2, I_WGATE, I_WUP, I_CW, I_CB, I_WDOWN, N_IN };

constexpr size_t MiB = 1u << 20;
constexpr size_t WS_CTL = 0, CTL_ZERO_BYTES = 1 * MiB;
constexpr size_t WS_PAR = 1 * MiB;
constexpr size_t WS_WIN = 2 * MiB, WS_WGLU = 6 * MiB, WS_WOUT = 7 * MiB, WS_WGATE = 9 * MiB, WS_WUP = 15 * MiB, WS_WDOWN = 21 * MiB;
constexpr size_t WS_XN = 32 * MiB;
constexpr size_t WS_QB = 66 * MiB, WS_KB = 83 * MiB, WS_VB = 100 * MiB, WS_UB = 117 * MiB;
constexpr size_t WS_MIX = 134 * MiB;
constexpr size_t WS_G = 168 * MiB;
constexpr size_t WS_X1 = 185 * MiB;
constexpr size_t WS_A = 252 * MiB;
constexpr size_t WS_H = 345 * MiB;
constexpr size_t WS_SLO = 438 * MiB, WS_SLL = 447 * MiB, WS_END = 448 * MiB;
constexpr int CW_BAR = 4096;
constexpr int CW_QUEUE = 8192;
constexpr int CW_ROWSS = 16384;
static_assert((CW_ROWSS + MPAD) * 4 <= (int)CTL_ZERO_BYTES, "ctl");
constexpr int PA_ABR = 0, PA_ABI = 2048, PA_BBR = 4096, PA_BBI = 4096 + 32768, PA_LAM = 4096 + 65536;

constexpr int RING_BYTES = 131072;
constexpr int LDS_BYTES = 147456;
constexpr int MISC_OFF = LDS_BYTES - 512;

#define GAS __attribute__((address_space(1)))
#define LAS __attribute__((address_space(3)))
typedef unsigned short bf16;
typedef unsigned v4u __attribute__((ext_vector_type(4)));
typedef unsigned v2u __attribute__((ext_vector_type(2)));
typedef float f32x4 __attribute__((ext_vector_type(4)));
typedef float f32x2 __attribute__((ext_vector_type(2)));
typedef float f32x16 __attribute__((ext_vector_type(16)));
typedef short bf16x8 __attribute__((ext_vector_type(8)));
typedef short s16x4 __attribute__((ext_vector_type(4)));
typedef GAS unsigned gu32;
#define RLX_AGENT __ATOMIC_RELAXED, __HIP_MEMORY_SCOPE_AGENT
#define LDS_WAIT() asm volatile("s_waitcnt lgkmcnt(0)" ::: "memory")
#define VM_WAIT() asm volatile("s_waitcnt vmcnt(0)" ::: "memory")
__device__ __forceinline__ unsigned f2bf(float f) { unsigned u = __builtin_bit_cast(unsigned, f); return (u + 0x7fffu + ((u >> 16) & 1u)) >> 16; }
__device__ __forceinline__ unsigned pk2(float lo, float hi) { return f2bf(lo) | (f2bf(hi) << 16); }
__device__ __forceinline__ float bf2f(unsigned short b) { return __builtin_bit_cast(float, (unsigned)b << 16); }
__device__ __forceinline__ f32x4 ld_bf4(const bf16* p) { const v2u w = *(const v2u*)p; return (f32x4){ bf2f((unsigned short)(w.x & 0xffffu)), bf2f((unsigned short)(w.x >> 16)), bf2f((unsigned short)(w.y & 0xffffu)), bf2f((unsigned short)(w.y >> 16)) }; }
__device__ __forceinline__ unsigned cvtpk(float lo, float hi) { unsigned r; asm volatile("v_cvt_pk_bf16_f32 %0, %1, %2" : "=v"(r) : "v"(lo), "v"(hi)); return r; }
__device__ __forceinline__ float gelu_tanh(float x) {
    const float z = x * (1.0f + 0.044715f * x * x);
    const float e = __builtin_amdgcn_exp2f(z * (-2.0f * 0.7978845608028654f * 1.4426950408889634f));
    return x * __builtin_amdgcn_rcpf(1.0f + e);
}
__device__ __forceinline__ float wave_sum(float v) {
#pragma unroll
    for (int o = 1; o < 64; o <<= 1) v += __shfl_xor(v, o);
    return v;
}

#define XB_TMO      128
#define XB_XCNT(j)  (256  + 64 * (j))
#define XB_XSUB(j)  (1280 + 64 * (j))
#define XB_XGEN(j)  (2304 + 64 * (j))
#define XB_TOP      3328
#define XB_TOPGEN   3392
#define XCD_BAR_WORDS 3456
#define XB_SPIN_CAP (1u << 18)
__device__ __forceinline__ unsigned xb_ld(unsigned* p)              { return __hip_atomic_load(p, __ATOMIC_RELAXED, __HIP_MEMORY_SCOPE_AGENT); }
__device__ __forceinline__ unsigned xb_add(unsigned* p, unsigned v) { return __hip_atomic_fetch_add(p, v, __ATOMIC_RELAXED, __HIP_MEMORY_SCOPE_AGENT); }
__device__ __forceinline__ unsigned xb_xcc_id() { return (unsigned)__builtin_amdgcn_s_getreg((3 << 11) | 20) & 0xFu; }
#define XB_SPIN(cond, bar) do { unsigned _sp = 0; while (cond) { __builtin_amdgcn_s_sleep(1); \
    if ((++_sp & 255u) == 0u) { if (xb_ld(&(bar)[XB_TMO])) break; if (_sp > XB_SPIN_CAP) { atomicAdd(&(bar)[XB_TMO], 1u); break; } } } } while (0)
struct XcdBarrier { unsigned* bar; unsigned x; volatile LAS unsigned* st; };
__device__ __forceinline__ XcdBarrier xcd_barrier_post(unsigned* bar, volatile LAS unsigned* st) {
    XcdBarrier b; b.bar = bar; b.x = xb_xcc_id(); b.st = st;
    if (threadIdx.x == 0) (void)xb_add(&bar[XB_XCNT(b.x)], 1u);
    return b;
}
__device__ __forceinline__ void xcd_barrier_complete(unsigned* bar, unsigned x, unsigned& nloc, unsigned& nx) {
    const unsigned G = gridDim.x * gridDim.y * gridDim.z;
    unsigned sum, cnt, mine, sp = 0u;
    for (;;) {
        sum = 0u; cnt = 0u; mine = 0u;
#pragma unroll
        for (unsigned j = 0; j < 16; ++j) { const unsigned c = xb_ld(&bar[XB_XCNT(j)]); sum += c; cnt += (c > 0u) ? 1u : 0u; mine = (j == x) ? c : mine; }
        if (sum == G) break;
        __builtin_amdgcn_s_sleep(1);
        if ((++sp & 255u) == 0u) { if (xb_ld(&bar[XB_TMO])) break; if (sp > XB_SPIN_CAP) { atomicAdd(&bar[XB_TMO], 1u); break; } }
    }
    nloc = mine > 0u ? mine : 1u; nx = cnt > 0u ? cnt : 1u;
}
__device__ __forceinline__ void xcd_barrier(const XcdBarrier& b) {
    asm volatile("s_waitcnt vmcnt(0)" ::: "memory");
    __syncthreads();
    if (threadIdx.x == 0) {
        unsigned* bar = b.bar;
        __builtin_amdgcn_s_waitcnt(0);
        unsigned nloc = b.st[0], nx = b.st[1];
        if (nloc == 0u) { xcd_barrier_complete(bar, b.x, nloc, nx); b.st[0] = nloc; b.st[1] = nx; }
        const unsigned old = xb_add(&bar[XB_XSUB(b.x)], 1u);
        const unsigned gen = old / nloc;
        if (old + 1u == (gen + 1u) * nloc) {
            __builtin_amdgcn_fence(__ATOMIC_RELEASE, "agent");
            asm volatile("s_waitcnt vmcnt(0)" ::: "memory");
            const unsigned og = xb_add(&bar[XB_TOP], 1u);
            const unsigned tg = og / nx;
            if (og + 1u == (tg + 1u) * nx) xb_add(&bar[XB_TOPGEN], 1u);
            else XB_SPIN(xb_ld(&bar[XB_TOPGEN]) == tg, bar);
            __builtin_amdgcn_fence(__ATOMIC_ACQUIRE, "agent");
            xb_add(&bar[XB_XGEN(b.x)], 1u);
            asm volatile("s_waitcnt vmcnt(0)" ::: "memory");
        } else {
            XB_SPIN(xb_ld(&bar[XB_XGEN(b.x)]) == gen, bar);
            __builtin_amdgcn_fence(__ATOMIC_ACQUIRE, "agent");
            asm volatile("s_waitcnt vmcnt(0)" ::: "memory");
        }
    }
    __syncthreads();
}

struct Frame {
    LAS unsigned char* lds;
    volatile LAS unsigned* MISC;
    gu32* ctl;
    int tid, lane, wave, vcu, G;
    const float* in[N_IN];
    float* out;
    unsigned char* ws;
    bf16 *WIN_t, *WGLU_t, *WOUT_t, *WGATE_t, *WUP_t, *WDOWN_t;
    bf16 *XN, *QB, *KB, *VB, *UB, *MIX, *GB, *AB, *HB;
    float *X1, *PAR, *ROWSS, *SLO, *SLL;
};

__device__ __forceinline__ const float* xin_row(const Frame& F, int m) {
    if (m < MP) { const int b = m / LP, t = m - b * LP; return t < NMETA ? F.in[I_META] + (size_t)t * DM : F.in[I_XP] + ((size_t)b * SEQ + (t - NMETA)) * DM; }
    if (m < MV) return F.in[I_XS] + (size_t)(m - MP) * DM;
    return nullptr;
}

__device__ __forceinline__ void p0_tr_item(const float* W, int K, int N, bf16* WT, LAS float* scr, int item, int lane, const float* kscale, int mode) {
    const int nblk = N / 32, kb = item / nblk, nb = item % nblk, k0 = 64 * kb, n0 = 32 * nb;
#pragma unroll 8
    for (int i = 0; i < 32; ++i) { const int kk = 2 * i + (lane >> 5); float v = W[(size_t)(k0 + kk) * N + n0 + (lane & 31)]; if (kscale) v *= kscale[k0 + kk]; scr[kk * 33 + (lane & 31)] = v; }
    LDS_WAIT(); asm volatile("" ::: "memory");
    int prow0 = n0;
    if (mode == 1 && n0 < 1024) { const int pn = n0 >> 8, lb = (n0 & 255) >> 5, wc = lb >> 1, bj = lb & 1; prow0 = 256 * pn + 128 * bj + 32 * wc; }
    if (mode >= 2) prow0 = 256 * (n0 >> 7) + (n0 & 127) + (mode == 3 ? 128 : 0);
    const int c = lane & 7;
#pragma unroll
    for (int j = 0; j < 4; ++j) { const int n = (lane >> 3) + 8 * j; const LAS float* s = scr + (8 * c) * 33 + n;
        v4u o; o.x = pk2(s[0 * 33], s[1 * 33]); o.y = pk2(s[2 * 33], s[3 * 33]); o.z = pk2(s[4 * 33], s[5 * 33]); o.w = pk2(s[6 * 33], s[7 * 33]);
        *(GAS v4u*)(WT + (size_t)(prow0 + n) * K + k0 + 8 * c) = o; }
    LDS_WAIT(); asm volatile("" ::: "memory");
}
__device__ __forceinline__ void p0_prologue(Frame& F) {
    LAS float* scr = (LAS float*)(F.lds + F.wave * 16384);
    int lane_ = F.lane; asm volatile("" : "+v"(lane_));
    const int gw = F.vcu * 8 + F.wave, NGW = F.G * 8, lane = lane_;
    constexpr int I_1 = (DM / 64) * (PWID / 32);
    for (int it = gw; it < I_1; it += NGW) p0_tr_item(F.in[I_WIN], DM, PWID, F.WIN_t, scr, it, lane, nullptr, 1);
    {
        const GAS f32x4* g1 = (const GAS f32x4*)F.in[I_N1] + lane;
        f32x4 gv[4];
#pragma unroll
        for (int j = 0; j < 4; ++j) gv[j] = g1[64 * j];
        for (int m = gw; m < MPAD; m += NGW) {
            const float* src = xin_row(F, m);
            GAS unsigned long long* o8 = (GAS unsigned long long*)(F.XN + (size_t)m * DM) + lane;
            if (!src) {
#pragma unroll
                for (int j = 0; j < 4; ++j) o8[64 * j] = 0ull;
                continue; }
            const GAS f32x4* xr = (const GAS f32x4*)src + lane;
            f32x4 v[4]; float s = 0.f;
#pragma unroll
            for (int j = 0; j < 4; ++j) { v[j] = xr[64 * j]; s += (v[j].x * v[j].x + v[j].y * v[j].y) + (v[j].z * v[j].z + v[j].w * v[j].w); }
            const float r = rsqrtf(wave_sum(s) * (1.f / DM) + EPS);
#pragma unroll
            for (int j = 0; j < 4; ++j) { const f32x4 y = (v[j] * r) * gv[j]; o8[64 * j] = (unsigned long long)pk2(y.x, y.y) | ((unsigned long long)pk2(y.z, y.w) << 32); }
        }
    }
    if (gw < 32) {
        const int gp = gw * 64 + lane, g = gp >> 6;
        const float dt = expf(F.in[I_LDT][g]);
        const float ar = F.in[I_ARE][gp], ai = F.in[I_AIM][gp];
        const float mag = expf(ar * dt), abr = mag * cosf(ai * dt), abi = mag * sinf(ai * dt);
        const float den = ar * ar + ai * ai, nr = abr - 1.0f, ni = abi;
        const float gr = (nr * ar + ni * ai) / den, gi = (ni * ar - nr * ai) / den;
        F.PAR[PA_ABR + gp] = abr; F.PAR[PA_ABI + gp] = abi;
#pragma unroll
        for (int c = 0; c < 16; ++c) { const float br = F.in[I_BRE][gp * 16 + c], bi = F.in[I_BIM][gp * 16 + c];
            F.PAR[PA_BBR + gp * 16 + c] = gr * br - gi * bi; F.PAR[PA_BBI + gp * 16 + c] = gr * bi + gi * br; }
    } else if (gw == 32) {
        const float s0 = wave_sum(F.in[I_LQ][lane] * F.in[I_LK][lane]), s1 = wave_sum(F.in[I_LQ][64 + lane] * F.in[I_LK][64 + lane]);
        if (lane == 0) F.PAR[PA_LAM] = expf(s0) - expf(s1) + LAM_INIT;
    }
}

constexpr int WCV_I2 = (SW / 64) * (SW / 32), WCV_I3 = (DM / 64) * (DM / 32), WCV_I4 = (DM / 64) * (FF / 32), WCV_I6 = (FF / 64) * (DM / 32);
constexpr int WCV_ITEMS = WCV_I2 + WCV_I3 + 2 * WCV_I4 + WCV_I6, WCV_UNITS = (WCV_ITEMS + 7) / 8;
__device__ __forceinline__ void wcv_unit(Frame& F, int n) {
    int lane_ = F.lane; asm volatile("" : "+v"(lane_));
    const int lane = lane_;
    LAS float* scr = (LAS float*)(F.lds + F.wave * 16384);
    int r = n * 8 + F.wave;
    if (r >= WCV_ITEMS) return;
    if (r < WCV_I2) { p0_tr_item(F.in[I_WGLU], SW, SW, F.WGLU_t, scr, r, lane, nullptr, 0); return; } r -= WCV_I2;
    if (r < WCV_I3) { p0_tr_item(F.in[I_WOUT], DM, DM, F.WOUT_t, scr, r, lane, nullptr, 0); return; } r -= WCV_I3;
    if (r < WCV_I4) { p0_tr_item(F.in[I_WGATE], DM, FF, F.WGATE_t, scr, r, lane, F.in[I_N2], 2); return; } r -= WCV_I4;
    if (r < WCV_I4) { p0_tr_item(F.in[I_WUP], DM, FF, F.WGATE_t, scr, r, lane, F.in[I_N2], 3); return; } r -= WCV_I4;
    p0_tr_item(F.in[I_WDOWN], FF, DM, F.WDOWN_t, scr, r, lane, nullptr, 0);
}

using pg8::Unit; using pg8::HALF; using pg8::BM;

struct EpiProj {
    static constexpr bool PERM = false, AFTER_DRAIN = false;
    bf16 *qb, *kb, *vb, *ub; float* out; const float *qn, *kn;
    __device__ __forceinline__ void operator()(const f32x4 (&acc)[2][2][4][2], const Unit& u, int wr, int wc, int fr, int fq) const {
        const int tt = u.pn >> 1, half = u.pn & 1;
        const int row0 = u.pm * BM + wr * 64 + fr;
        if (tt < 2) {
            const float* gsrc = (tt == 0 ? qn : kn) + (wc & 1) * 64 + 4 * fq;
            const float sc = (tt == 0) ? QSCALE : 1.0f;
            f32x4 gv[2][2];
#pragma unroll
            for (int bj = 0; bj < 2; ++bj)
#pragma unroll
                for (int n = 0; n < 2; ++n) gv[bj][n] = *(const f32x4*)(gsrc + 32 * bj + 16 * n) * sc;
            bf16* dstb = (tt == 0) ? qb : kb;
            const int colL = 256 * half + 64 * wc + 4 * fq;
#pragma unroll
            for (int ai = 0; ai < 2; ++ai)
#pragma unroll
                for (int m = 0; m < 4; ++m) {
                    float ss = 0.f;
#pragma unroll
                    for (int bj = 0; bj < 2; ++bj)
#pragma unroll
                        for (int n = 0; n < 2; ++n) { const f32x4 x = acc[ai][bj][m][n]; ss += (x[0] * x[0] + x[1] * x[1]) + (x[2] * x[2] + x[3] * x[3]); }
                    ss += __shfl_xor(ss, 16); ss += __shfl_xor(ss, 32);
                    const float r = rsqrtf(ss * (1.0f / 64.0f) + EPS);
                    const int row = row0 + ai * HALF + m * 16;
                    float* fo = nullptr;
                    if (tt == 1) { if (row < MP) fo = out + O_KP + (size_t)row * 512; else if (row < MV) fo = out + O_KS + (size_t)(row - MP) * 512; }
#pragma unroll
                    for (int bj = 0; bj < 2; ++bj)
#pragma unroll
                        for (int n = 0; n < 2; ++n) { const f32x4 kf = (acc[ai][bj][m][n] * r);
                            const f32x4 v = kf * gv[bj][n]; const int col = colL + 32 * bj + 16 * n;
                            v2u w; w.x = pk2(v[0], v[1]); w.y = pk2(v[2], v[3]); *(v2u*)(dstb + (size_t)row * 512 + col) = w;
                            if (fo) *(f32x4*)(fo + col) = v; }
                }
        } else {
            bf16* dstb = (tt == 2) ? vb : ub;
            const int col0 = 256 * half + 32 * wc + 4 * fq;
#pragma unroll
            for (int ai = 0; ai < 2; ++ai)
#pragma unroll
                for (int m = 0; m < 4; ++m) {
                    const int row = row0 + ai * HALF + m * 16;
                    float* fo = nullptr;
                    if (tt == 2) { if (row < MP) fo = out + O_VP + (size_t)row * 512; else if (row < MV) fo = out + O_VS + (size_t)(row - MP) * 512; }
#pragma unroll
                    for (int bj = 0; bj < 2; ++bj)
#pragma unroll
                        for (int n = 0; n < 2; ++n) { const f32x4 v = acc[ai][bj][m][n]; const int col = col0 + 128 * bj + 16 * n;
                            v2u w; w.x = pk2(v[0], v[1]); w.y = pk2(v[2], v[3]); *(v2u*)(dstb + (size_t)row * 512 + col) = w;
                            if (fo) *(f32x4*)(fo + col) = v; }
                }
        }
    }
};

struct EpiGlu {
    static constexpr bool PERM = false, AFTER_DRAIN = false;
    const bf16* gb; bf16* mix; const float* bias;
    __device__ __forceinline__ void operator()(const f32x4 (&acc)[2][2][4][2], const Unit& u, int wr, int wc, int fr, int fq) const {
        const int row0 = u.pm * BM + wr * 64 + fr, col0 = u.pn * BM + wc * 32 + 4 * fq;
        f32x4 bv[2][2];
#pragma unroll
        for (int bj = 0; bj < 2; ++bj)
#pragma unroll
            for (int n = 0; n < 2; ++n) bv[bj][n] = *(const f32x4*)(bias + col0 + bj * HALF + n * 16);
#pragma unroll
        for (int ai = 0; ai < 2; ++ai)
#pragma unroll
            for (int m = 0; m < 4; ++m) { const int row = row0 + ai * HALF + m * 16;
#pragma unroll
                for (int bj = 0; bj < 2; ++bj)
#pragma unroll
                    for (int n = 0; n < 2; ++n) { const int col = col0 + bj * HALF + n * 16;
                        const f32x4 z = acc[ai][bj][m][n] + bv[bj][n];
                        const v2u gw = *(const v2u*)(gb + (size_t)row * 512 + col);
                        float gg[4] = { bf2f((unsigned short)(gw.x & 0xffffu)), bf2f((unsigned short)(gw.x >> 16)), bf2f((unsigned short)(gw.y & 0xffffu)), bf2f((unsigned short)(gw.y >> 16)) };
                        float o[4];
#pragma unroll
                        for (int e = 0; e < 4; ++e) o[e] = gg[e] * __builtin_amdgcn_rcpf(1.0f + __builtin_amdgcn_exp2f(-1.4426950408889634f * z[e]));
                        v2u w; w.x = pk2(o[0], o[1]); w.y = pk2(o[2], o[3]); *(v2u*)(mix + (size_t)row * DM + 512 + col) = w; }
            }
    }
};

struct EpiOut {
    static constexpr bool PERM = false, AFTER_DRAIN = false;
    const float *xp, *xs, *meta; float* x1; bf16* x1b; float* rowss;
    __device__ __forceinline__ void operator()(const f32x4 (&acc)[2][2][4][2], const Unit& u, int wr, int wc, int fr, int fq) const {
        const int row0 = u.pm * BM + wr * 64 + fr, col0 = u.pn * BM + wc * 32 + 4 * fq;
#pragma unroll
        for (int ai = 0; ai < 2; ++ai)
#pragma unroll
            for (int m = 0; m < 4; ++m) { const int row = row0 + ai * HALF + m * 16;
                const float* src = nullptr;
                if (row < MP) { const int b = row / LP, t = row - b * LP; src = t < NMETA ? meta + (size_t)t * DM : xp + ((size_t)b * SEQ + (t - NMETA)) * DM; }
                else if (row < MV) src = xs + (size_t)(row - MP) * DM;
                float ss = 0.f;
#pragma unroll
                for (int bj = 0; bj < 2; ++bj)
#pragma unroll
                    for (int n = 0; n < 2; ++n) { const int col = col0 + bj * HALF + n * 16;
                        f32x4 v = acc[ai][bj][m][n]; if (src) v += *(const f32x4*)(src + col);
                        ss += (v[0] * v[0] + v[1] * v[1]) + (v[2] * v[2] + v[3] * v[3]);
                        v2u w; w.x = pk2(v[0], v[1]); w.y = pk2(v[2], v[3]); *(v2u*)(x1b + (size_t)row * DM + col) = w; }
                ss += __shfl_xor(ss, 16); ss += __shfl_xor(ss, 32);
                if (fq == 0) atomicAdd(rowss + row, ss);
            }
    }
};

__device__ __forceinline__ float dpp_ror1(float v) { return __builtin_bit_cast(float, __builtin_amdgcn_update_dpp(0, __builtin_bit_cast(int, v), 0x121, 0xf, 0xf, false)); }
__device__ __forceinline__ float dpp_ror2(float v) { return __builtin_bit_cast(float, __builtin_amdgcn_update_dpp(0, __builtin_bit_cast(int, v), 0x122, 0xf, 0xf, false)); }
constexpr int MT2 = 68, MSTEP2 = 254;
struct EpiGateUp {
    static constexpr bool PERM = false, AFTER_DRAIN = false;
    const float* rowss; bf16* hb; float* out; const float *cw, *cb, *hist; LAS float* xch;
    __device__ __forceinline__ void operator()(const f32x4 (&acc)[2][2][4][2], const Unit& u, int wr, int wc, int fr, int fq) const {
        const int trow0 = wr * 64 + fr;
        const int grow0 = u.pm * MSTEP2 - 2 + trow0;
        const int colw = wc * 32 + 4 * fq;
        const int col0 = u.pn * 128 + colw;
#pragma unroll
        for (int ai = 0; ai < 2; ++ai) { int R = grow0 + ai * HALF + 48; R = R < 0 ? 0 : (R >= MPAD ? MPAD - 1 : R);
            const float rs = rsqrtf(rowss[R] * (1.0f / DM) + EPS);
            if (fr >= 14) {
#pragma unroll
                for (int n = 0; n < 2; ++n) *(LAS f32x4*)(xch + ((ai * 2 + wr) * 2 + (fr - 14)) * 128 + colw + 16 * n) = acc[ai][0][3][n] * rs; } }
        asm volatile("s_waitcnt lgkmcnt(0)" ::: "memory"); __builtin_amdgcn_s_barrier(); asm volatile("" ::: "memory");
        f32x4 w0[2], w1[2], w2[2], bb[2];
#pragma unroll
        for (int n = 0; n < 2; ++n) { w0[n] = *(const f32x4*)(cw + col0 + 16 * n); w1[n] = *(const f32x4*)(cw + FF + col0 + 16 * n); w2[n] = *(const f32x4*)(cw + 2 * FF + col0 + 16 * n); bb[n] = *(const f32x4*)(cb + col0 + 16 * n); }
#pragma unroll
        for (int ai = 0; ai < 2; ++ai) {
            f32x4 pr1[2], pr2[2];
            {   const bool hasprev = !(ai == 0 && wr == 0);
                const int pg = (wr == 1) ? (ai * 2) : ((ai - 1) * 2 + 1);
#pragma unroll
                for (int n = 0; n < 2; ++n) { f32x4 x62 = (f32x4){0.f, 0.f, 0.f, 0.f}, x63 = x62;
                    if (hasprev) { x62 = *(const LAS f32x4*)(xch + (pg * 2 + 0) * 128 + colw + 16 * n); x63 = *(const LAS f32x4*)(xch + (pg * 2 + 1) * 128 + colw + 16 * n); }
                    pr1[n] = x63; pr2[n] = (fr == 0) ? x62 : x63; } }
#pragma unroll
            for (int m = 0; m < 4; ++m) {
                const int trow = trow0 + ai * HALF + m * 16, R = grow0 + ai * HALF + m * 16;
                const int Rc = R < 0 ? 0 : (R >= MPAD ? MPAD - 1 : R);
                const float rs = rsqrtf(rowss[Rc] * (1.0f / DM) + EPS);
                int t = 2; const float* hs = nullptr; float* fo = nullptr;
                if (Rc < MP) { const int b = Rc / LP; t = Rc - b * LP; if (t >= LP - 2) fo = out + O_CP + (size_t)(b * 2 + (t - (LP - 2))) * FF; }
                else if (Rc < MV) { const int db = (Rc - MP) >> 2; t = (Rc - MP) & 3; hs = hist + (size_t)db * 2 * FF; if (t >= 2) fo = out + O_CS + (size_t)(db * 2 + (t - 2)) * FF; }
                const bool store = (trow >= 2) && (R < MPAD);
#pragma unroll
                for (int n = 0; n < 2; ++n) {
                    const f32x4 a0 = acc[ai][0][m][n] * rs, c = acc[ai][1][m][n] * rs;
                    f32x4 r1, r2;
#pragma unroll
                    for (int e = 0; e < 4; ++e) { r1[e] = dpp_ror1(a0[e]); r2[e] = dpp_ror2(a0[e]); }
                    f32x4 a1, a2;
#pragma unroll
                    for (int e = 0; e < 4; ++e) { a1[e] = (fr >= 1) ? r1[e] : pr1[n][e]; a2[e] = (fr >= 2) ? r2[e] : pr2[n][e]; }
                    pr1[n] = r1; pr2[n] = r2;
                    if (t < 2) {
                        const f32x4 z = (f32x4){0.f, 0.f, 0.f, 0.f};
                        if (t == 0) { a1 = hs ? *(const f32x4*)(hs + FF + col0 + 16 * n) : z; a2 = hs ? *(const f32x4*)(hs + col0 + 16 * n) : z; }
                        else a2 = hs ? *(const f32x4*)(hs + FF + col0 + 16 * n) : z;
                    }
                    if (store) {
                        const f32x4 cv = bb[n] + w0[n] * a2 + w1[n] * a1 + w2[n] * a0;
                        float o[4];
#pragma unroll
                        for (int e = 0; e < 4; ++e) o[e] = gelu_tanh(cv[e]) * c[e];
                        v2u w; w.x = pk2(o[0], o[1]); w.y = pk2(o[2], o[3]); *(v2u*)(hb + (size_t)R * FF + col0 + 16 * n) = w;
                        if (fo) *(f32x4*)(fo + col0 + 16 * n) = a0;
                    }
                }
            }
        }
    }
};

struct EpiDown {
    static constexpr bool PERM = false, AFTER_DRAIN = false;
    const bf16* x1b; float* out;
    __device__ __forceinline__ void operator()(const f32x4 (&acc)[2][2][4][2], const Unit& u, int wr, int wc, int fr, int fq) const {
        const int row0 = u.pm * BM + wr * 64 + fr, col0 = u.pn * BM + wc * 32 + 4 * fq;
#pragma unroll
        for (int ai = 0; ai < 2; ++ai)
#pragma unroll
            for (int m = 0; m < 4; ++m) { const int row = row0 + ai * HALF + m * 16;
                float* fo = nullptr;
                if (row < MP) { const int b = row / LP, t = row - b * LP; if (t >= NMETA) fo = out + O_YP + ((size_t)b * SEQ + (t - NMETA)) * DM; }
                else if (row < MV) fo = out + O_YS + (size_t)(row - MP) * DM;
                if (fo) {
#pragma unroll
                    for (int bj = 0; bj < 2; ++bj)
#pragma unroll
                        for (int n = 0; n < 2; ++n) { const int col = col0 + bj * HALF + n * 16;
                            *(f32x4*)(fo + col) = acc[ai][bj][m][n] + ld_bf4(x1b + (size_t)row * DM + col); }
                }
            }
    }
};

typedef LAS const char* lds_cptr;
__device__ __forceinline__ unsigned off_b(unsigned row, unsigned ch) { return 256u * row + 16u * (ch ^ (((row & 3u) << 2) | ((row >> 2) & 3u))); }
__device__ __forceinline__ s16x4 vtr(lds_cptr p) { return __builtin_bit_cast(s16x4, __builtin_amdgcn_ds_read_tr16_b64_v4i16((LAS s16x4*)p)); }
__device__ __forceinline__ void glds16(const void* gsrc, unsigned lds_dst) { unsigned keep;
    asm volatile("s_mov_b32 %0, m0\n\ts_mov_b32 m0, %2\n\ts_nop 0\n\tglobal_load_lds_dwordx4 %1, off\n\ts_mov_b32 m0, %0" : "=&s"(keep) : "v"(gsrc), "s"(lds_dst) : "memory"); }
__device__ __forceinline__ int crow(int r, int hi) { return (r & 3) + 8 * (r >> 2) + 4 * hi; }
#define MFMA32(a, b, c) __builtin_amdgcn_mfma_f32_32x32x16_bf16((a), (b), (c), 0, 0, 0)
#define MFMA16(a, b, c) __builtin_amdgcn_mfma_f32_16x16x32_bf16((a), (b), (c), 0, 0, 0)

constexpr int ATT_K = 0, ATT_V = 32768, ATT_WS = 65536, ATT_Q = 67584;
__device__ __forceinline__ void attn_unit(Frame& F, int b, int h, int qi) {
    int lane_ = F.lane; asm volatile("" : "+v"(lane_));
    const int lane = lane_, w = F.wave, r32 = lane & 31, hi = lane >> 5;
    const int rowb = b * LP;
    const int Q0 = NMETA + 256 * qi + 32 * w;
    const int NT = 4 * qi + 5;
    LAS unsigned char* lds = F.lds;
    { LAS unsigned char* Qw = lds + ATT_Q + 8192 * w + 16 * lane; const bf16* qp = F.QB + ((long)(rowb + Q0 + r32)) * 512 + h * 128 + hi * 8;
#pragma unroll
      for (int ks = 0; ks < 8; ++ks) *(LAS v4u*)(Qw + 1024 * ks) = *(const v4u*)(qp + ks * 16); }
    f32x16 o0[4], o1[4];
#pragma unroll
    for (int c = 0; c < 4; ++c) { o0[c] = (f32x16){}; o1[c] = (f32x16){}; }
    float l0 = 0.f, l1 = 0.f;
    const unsigned ldsb = (unsigned)(uintptr_t)lds;
    const char* kg = (const char*)(F.KB + (size_t)rowb * 512 + h * 128);
    const char* vg = (const char*)(F.VB + (size_t)rowb * 512 + h * 128);
#define ATT_STAGE(j, buf) do { const char* kt_ = kg + (size_t)(64 * (j)) * 1024; const char* vt_ = vg + (size_t)(64 * (j)) * 1024; unsigned ln_ = lane; asm volatile("" : "+v"(ln_)); \
        _Pragma("unroll") for (int i_ = 0; i_ < 2; ++i_) { const unsigned row_ = 4u * (w + 8 * i_) + (ln_ >> 4), ch_ = (ln_ & 15) ^ (((row_ & 3u) << 2) | ((row_ >> 2) & 3u)); \
        const unsigned vr_ = (row_ & ~12u) | ((row_ & 4u) << 1) | ((row_ & 8u) >> 1); \
        glds16(kt_ + (row_ * 1024u + ch_ * 16u), (unsigned)__builtin_amdgcn_readfirstlane(ldsb + ATT_K + (buf) * 16384 + (w + 8 * i_) * 1024)); \
        glds16(vt_ + (vr_ * 1024u + ch_ * 16u), (unsigned)__builtin_amdgcn_readfirstlane(ldsb + ATT_V + (buf) * 16384 + (w + 8 * i_) * 1024)); } } while (0)
    ATT_STAGE(0, 0); VM_WAIT(); __syncthreads();
    for (int j = 0; j < NT; ++j) {
        const int buf = j & 1;
        if (j + 1 < NT) ATT_STAGE(j + 1, buf ^ 1);
        if (64 * j <= Q0 + 31) {
            const LAS unsigned char* Kb = lds + ATT_K + buf * 16384; const LAS unsigned char* Vb = lds + ATT_V + buf * 16384;
            const bool needmask = (64 * j + 63 > Q0);
            unsigned ln = lane; asm volatile("" : "+v"(ln));
            const unsigned r32v = ln & 31u, hiv = ln >> 5, blk = (ln >> 4) & 1u, qq = (ln & 15u) >> 2, pp = ln & 3u;
            const unsigned kra = off_b(r32v, hiv);
            const unsigned vba = off_b(8 * hiv + qq, 2 * blk + (pp >> 1)) + 8 * (pp & 1), vbb = off_b(8 * hiv + 4 + qq, 2 * blk + (pp >> 1)) + 8 * (pp & 1);
            const LAS unsigned char* Qw = lds + ATT_Q + 8192 * w + 16 * ln;
            const int qpos = Q0 + (int)r32v;
            bf16x8 pk0[4], pk1[4];
#define PK8(X, B) __builtin_bit_cast(bf16x8, (v4u){ cvtpk(X[B], X[B + 1]), cvtpk(X[B + 2], X[B + 3]), cvtpk(X[B + 4], X[B + 5]), cvtpk(X[B + 6], X[B + 7]) })
#define ATT_QK(KS0, HALF_, PK, LACC) do { f32x16 sa; \
                if (needmask) { _Pragma("unroll") for (int r = 0; r < 16; ++r) sa[r] = (64 * j + 32 * (HALF_) + crow(r, (int)hiv) > qpos) ? -1.0e30f : 0.f; } else sa = (f32x16){}; \
                _Pragma("unroll") for (int ks = (KS0); ks < (KS0) + 4; ++ks) { const bf16x8 qv = *(const LAS bf16x8*)(Qw + 1024 * ks); \
                    const bf16x8 a0 = *(const LAS bf16x8*)(Kb + 8192 * (HALF_) + (kra ^ (32u * ks))); \
                    sa = MFMA32(a0, qv, sa); } \
                __builtin_amdgcn_sched_group_barrier(0x100, 4, 0); __builtin_amdgcn_sched_group_barrier(0x008, 1, 0); __builtin_amdgcn_sched_group_barrier(0x100, 2, 0); \
                __builtin_amdgcn_sched_group_barrier(0x008, 1, 0); __builtin_amdgcn_sched_group_barrier(0x100, 2, 0); __builtin_amdgcn_sched_group_barrier(0x008, 2, 0); \
                float ls_ = 0.f; \
                _Pragma("unroll") for (int r = 0; r < 16; ++r) { sa[r] = __builtin_amdgcn_exp2f(sa[r]); ls_ += sa[r]; } \
                LACC += ls_; PK[2 * (HALF_)] = PK8(sa, 0); PK[2 * (HALF_) + 1] = PK8(sa, 8); } while (0)
            ATT_QK(0, 0, pk0, l0); __builtin_amdgcn_sched_barrier(0);
            ATT_QK(0, 1, pk0, l0); __builtin_amdgcn_sched_barrier(0);
            ATT_QK(4, 0, pk1, l1); __builtin_amdgcn_sched_barrier(0);
            ATT_QK(4, 1, pk1, l1); __builtin_amdgcn_sched_barrier(0);
#undef ATT_QK
#undef PK8
#pragma unroll
            for (int c = 0; c < 4; ++c)
#pragma unroll
                for (int ks = 0; ks < 4; ++ks) {
                    const s16x4 lo = vtr((lds_cptr)(Vb + (vba ^ (64u * c)) + 4096 * ks)), hh = vtr((lds_cptr)(Vb + (vbb ^ (64u * c)) + 4096 * ks));
                    const bf16x8 vf = (bf16x8){ lo[0], lo[1], lo[2], lo[3], hh[0], hh[1], hh[2], hh[3] };
                    o0[c] = MFMA32(pk0[ks], vf, o0[c]); o1[c] = MFMA32(pk1[ks], vf, o1[c]);
                }
            __builtin_amdgcn_sched_group_barrier(0x100, 4, 0);
#pragma unroll
            for (int i = 0; i < 14; ++i) { __builtin_amdgcn_sched_group_barrier(0x008, 2, 0); __builtin_amdgcn_sched_group_barrier(0x100, 2, 0); }
            __builtin_amdgcn_sched_group_barrier(0x008, 4, 0);
            __builtin_amdgcn_sched_barrier(0);
        }
        VM_WAIT(); __syncthreads();
    }
#undef ATT_STAGE
    const float lam = F.PAR[PA_LAM];
    l0 += __shfl_xor(l0, 32); l1 += __shfl_xor(l1, 32);
    LAS float* wsf = (LAS float*)(lds + ATT_WS) + w * 64;
    if (hi == 0) { wsf[r32] = l0; wsf[32 + r32] = l1; }
    LDS_WAIT(); asm volatile("" ::: "memory");
    const float* subn = F.in[I_SUBN];
    float sn[4];
#pragma unroll
    for (int c = 0; c < 4; ++c) sn[c] = subn[32 * c + r32] * (1.0f - LAM_INIT);
#pragma unroll
    for (int r = 0; r < 16; ++r) {
        const int qr = crow(r, hi);
        const float i0 = 1.0f / wsf[qr], i1 = lam / wsf[32 + qr];
        float v[4]; float ss = 0.f;
#pragma unroll
        for (int c = 0; c < 4; ++c) { v[c] = o0[c][r] * i0 - o1[c][r] * i1; ss += v[c] * v[c]; }
        ss += __shfl_xor(ss, 1); ss += __shfl_xor(ss, 2); ss += __shfl_xor(ss, 4); ss += __shfl_xor(ss, 8); ss += __shfl_xor(ss, 16);
        const float rn = rsqrtf(ss * (1.0f / 128.0f) + EPS);
        const int pos = Q0 + qr;
        if (pos >= 0) { bf16* dst = F.MIX + (size_t)(rowb + pos) * DM + h * 128 + r32;
#pragma unroll
            for (int c = 0; c < 4; ++c) dst[32 * c] = (bf16)f2bf(v[c] * rn * sn[c]); }
    }
    LDS_WAIT();
}

constexpr int NSL = 4, PPG = NPG / NSL;
constexpr int DEC_RED = 0, DEC_P = 0, DEC_Q = 16384;
__device__ __forceinline__ bf16x8 cvt8(const f32x4 a, const f32x4 b) { return __builtin_bit_cast(bf16x8, (v4u){ cvtpk(a[0], a[1]), cvtpk(a[2], a[3]), cvtpk(b[0], b[1]), cvtpk(b[2], b[3]) }); }
__device__ __forceinline__ f32x4 ldnt4(const float* p) { return __builtin_nontemporal_load((const f32x4*)p); }
__device__ __forceinline__ void decode_unit(Frame& F, int db, int pg) {
    int lane_ = F.lane; asm volatile("" : "+v"(lane_));
    const int lane = lane_, w = F.wave, col = lane & 15, kg = lane >> 4;
    LAS unsigned char* lds = F.lds;
    if (w < 4) {
        const int h = w;
#pragma unroll
        for (int kb = 0; kb < 4; ++kb) { v4u q = (v4u){0u, 0u, 0u, 0u};
            if (col < 8 && (col >> 2) == (kb >> 1)) q = *(const v4u*)(F.QB + (size_t)(MP + db * 4 + (col & 3)) * 512 + h * 128 + kb * 32 + kg * 8);
            *(LAS v4u*)(lds + DEC_Q + ((h * 4 + kb) * 64 + lane) * 16) = q; }
    }
    __syncthreads();
    const int hb = (w >> 2) * 2, hl = lane >> 5;
    f32x4 O[8];
#pragma unroll
    for (int c = 0; c < 8; ++c) O[c] = (f32x4){0.f, 0.f, 0.f, 0.f};
    float lsum[2] = {0.f, 0.f};
    const int* pt = (const int*)F.in[I_PT] + db * NPG + pg * PPG;
    LAS float* Pw = (LAS float*)(lds + DEC_P + 1024 * w);
    const LAS unsigned char* Qf = lds + DEC_Q + (hb * 4 * 64 + lane) * 16;
    const size_t koff = (size_t)(32 * (w & 3) + col) * 512 + hb * 128 + kg * 8;
    const size_t voff = (size_t)(32 * (w & 3)) * 512 + hb * 128 + 4 * lane;
    f32x4 bA[16], bB[16];
#define LD_K(KP) do { _Pragma("unroll") for (int i = 0; i < 8; ++i) { bA[2 * i] = ldnt4((KP) + koff + i * 32); bA[2 * i + 1] = ldnt4((KP) + koff + i * 32 + 4); } } while (0)
#define LD_V(VP) do { _Pragma("unroll") for (int i = 0; i < 16; ++i) bB[i] = ldnt4((VP) + voff + (size_t)i * 512); } while (0)
    int page = __builtin_amdgcn_readfirstlane(pt[0]);
    LD_K(F.in[I_CK] + (size_t)page * PAGE * 512);
    LD_V(F.in[I_CV] + (size_t)page * PAGE * 512);
#define DEC_BODY(GI, LOADNEXT) do { \
        const int gn = (GI) + 1; \
        const int npage = __builtin_amdgcn_readfirstlane(pt[(LOADNEXT) ? (gn >> 1) : 0]); \
        const float* nkp = F.in[I_CK] + ((size_t)npage * PAGE + 16 * (gn & 1)) * 512; \
        const float* nvp = F.in[I_CV] + ((size_t)npage * PAGE + 16 * (gn & 1)) * 512; \
        f32x4 acc[2]; \
        _Pragma("unroll") for (int hh = 0; hh < 2; ++hh) { f32x4 ac = (f32x4){0.f, 0.f, 0.f, 0.f}; \
            _Pragma("unroll") for (int kb = 0; kb < 4; ++kb) { const bf16x8 a = cvt8(bA[2 * (hh * 4 + kb)], bA[2 * (hh * 4 + kb) + 1]); \
                const bf16x8 bq = *(const LAS bf16x8*)(Qf + (hh * 4 + kb) * 1024); ac = MFMA16(a, bq, ac); } \
            acc[hh] = ac; } \
        __builtin_amdgcn_sched_barrier(0); \
        if (LOADNEXT) LD_K(nkp); \
        __builtin_amdgcn_sched_barrier(0); \
        if (col < 8) { \
            _Pragma("unroll") for (int hh = 0; hh < 2; ++hh) \
                _Pragma("unroll") for (int e = 0; e < 4; ++e) { const float p = __builtin_amdgcn_exp2f(acc[hh][e]); lsum[hh] += p; Pw[((4 * kg + e) * 2 + hh) * 8 + col] = p; } \
        } \
        LDS_WAIT(); asm volatile("" ::: "memory"); \
        __builtin_amdgcn_sched_barrier(0); \
        _Pragma("unroll") for (int s_ = 0; s_ < 16; ++s_) { \
            const f32x4 pa = *(const LAS f32x4*)(Pw + (s_ * 2 + hl) * 8), pb = *(const LAS f32x4*)(Pw + (s_ * 2 + hl) * 8 + 4); \
            _Pragma("unroll") for (int c = 0; c < 4; ++c) { O[c] += bB[s_] * pa[c]; O[4 + c] += bB[s_] * pb[c]; } \
        } \
        __builtin_amdgcn_sched_barrier(0); \
        if (LOADNEXT) LD_V(nvp); \
        LDS_WAIT(); asm volatile("" ::: "memory"); \
        __builtin_amdgcn_sched_barrier(0); \
    } while (0)
#pragma unroll 1
    for (int gi = 0; gi < 2 * PPG - 1; ++gi) DEC_BODY(gi, true);
    DEC_BODY(2 * PPG - 1, false);
#undef DEC_BODY
#undef LD_K
#undef LD_V
    __syncthreads();
#pragma unroll
    for (int c = 0; c < 8; ++c) *(LAS f32x4*)(lds + DEC_RED + ((w * 8 + c) * 64 + lane) * 16) = O[c];
#pragma unroll
    for (int hh = 0; hh < 2; ++hh) { float l = lsum[hh]; l += __shfl_xor(l, 16); l += __shfl_xor(l, 32); if (lane < 8) ((LAS float*)(lds + 131072))[(w * 2 + hh) * 8 + lane] = l; }
    __syncthreads();
    float* slab = F.SLO + ((size_t)(db * NSL + pg)) * 4096;
#pragma unroll
    for (int k = 0; k < 2; ++k) { const int sc = 2 * w + k, set = sc >> 3, cc = sc & 7;
        f32x4 s = (f32x4){0.f, 0.f, 0.f, 0.f};
#pragma unroll
        for (int ww = 0; ww < 4; ++ww) s += *(const LAS f32x4*)(lds + DEC_RED + (((4 * set + ww) * 8 + cc) * 64 + lane) * 16);
        const int h = 2 * set + hl;
        *(f32x4*)(slab + (h * 8 + cc) * 128 + 4 * (lane & 31)) = s; }
    if (w == 0 && lane < 32) { const int h = lane >> 3, cc = lane & 7; float s = 0.f;
#pragma unroll
        for (int ww = 0; ww < 4; ++ww) s += ((const LAS float*)(lds + 131072))[((4 * (h >> 1) + ww) * 2 + (h & 1)) * 8 + cc];
        F.SLL[(size_t)(db * NSL + pg) * 32 + lane] = s; }
    __syncthreads();
}

__device__ __forceinline__ void decode_final(Frame& F, int db, int h) {
    int lane_ = F.lane; asm volatile("" : "+v"(lane_));
    const int lane = lane_;
    const float lam = F.PAR[PA_LAM];
    const float sn0 = F.in[I_SUBN][2 * lane] * (1.0f - LAM_INIT), sn1 = F.in[I_SUBN][2 * lane + 1] * (1.0f - LAM_INIT);
    const int rbase = MP + db * 4;
    float vn0[4], vn1[4];
#pragma unroll
    for (int j = 0; j < 4; ++j) { const unsigned vw = *(const unsigned*)(F.VB + (size_t)(rbase + j) * 512 + h * 128 + 2 * lane); vn0[j] = bf2f((unsigned short)(vw & 0xffffu)); vn1[j] = bf2f((unsigned short)(vw >> 16)); }
#pragma unroll
    for (int tq = 0; tq < 4; ++tq) {
        float o[2][2], l[2];
#pragma unroll
        for (int c = 0; c < 2; ++c) {
            const int cc = 4 * c + tq;
            float a0 = 0.f, a1 = 0.f, ls = 0.f;
#pragma unroll
            for (int pg = 0; pg < NSL; ++pg) { const f32x2 t = *(const f32x2*)(F.SLO + ((size_t)(db * NSL + pg) * 32 + h * 8 + cc) * 128 + 2 * lane); a0 += t.x; a1 += t.y; ls += F.SLL[(size_t)(db * NSL + pg) * 32 + h * 8 + cc]; }
            const float qv = bf2f(F.QB[(size_t)(rbase + tq) * 512 + h * 128 + c * 64 + lane]);
#pragma unroll
            for (int j = 0; j < 4; ++j) if (j <= tq) {
                const float kv = bf2f(F.KB[(size_t)(rbase + j) * 512 + h * 128 + c * 64 + lane]);
                const float p = __builtin_amdgcn_exp2f(wave_sum(qv * kv));
                ls += p; a0 += p * vn0[j]; a1 += p * vn1[j]; }
            o[c][0] = a0; o[c][1] = a1; l[c] = ls;
        }
        const float i0 = 1.0f / l[0], i1 = lam / l[1];
        const float y0 = o[0][0] * i0 - o[1][0] * i1, y1 = o[0][1] * i0 - o[1][1] * i1;
        const float rn = rsqrtf(wave_sum(y0 * y0 + y1 * y1) * (1.0f / 128.0f) + EPS);
        *(unsigned*)(F.MIX + (size_t)(rbase + tq) * DM + h * 128 + 2 * lane) = pk2(y0 * rn * sn0, y1 * rn * sn1);
    }
}

constexpr int SSM_LE = 131072, SSM_CF = 139264, SSM_HP = 136;
__device__ __forceinline__ void ssm_unit(Frame& F, int b, int g) {
    int lane_ = F.lane; asm volatile("" : "+v"(lane_));
    const int lane = lane_, w = F.wave, r32 = lane & 31, hi = lane >> 5;
    LAS unsigned char* lds = F.lds;
    LAS float* X = (LAS float*)(lds + 16384 * w);
    LAS unsigned short* Hb = (LAS unsigned short*)(lds + 16384 * w);
    LAS float* LE = (LAS float*)(lds + SSM_LE);
    const int rowb = b * LP;
    const float ar = F.PAR[PA_ABR + g * 64 + lane], ai = F.PAR[PA_ABI + g * 64 + lane];
    float a32r = ar, a32i = ai;
#pragma unroll
    for (int i = 0; i < 5; ++i) { const float nr = a32r * a32r - a32i * a32i, ni = 2.0f * a32r * a32i; a32r = nr; a32i = ni; }
    bf16x8 Bf[2][2];
#pragma unroll
    for (int ri = 0; ri < 2; ++ri)
#pragma unroll
        for (int nb = 0; nb < 2; ++nb) { const float* s = F.PAR + (ri ? PA_BBI : PA_BBR) + ((g * 64 + 32 * nb + r32) * 16 + 8 * hi);
            Bf[ri][nb] = cvt8(*(const f32x4*)s, *(const f32x4*)(s + 4)); }
    const int cfl = (r32 & 15) | (hi << 4);
    if (w == 0 && r32 < 16) {
#pragma unroll
        for (int s = 0; s < 8; ++s) { const float* src = (s < 4 ? F.in[I_CRE] : F.in[I_CIM]) + ((size_t)(g * 16 + r32) * 64 + 16 * (s & 3) + 8 * hi);
            f32x4 x0 = *(const f32x4*)src, x1 = *(const f32x4*)(src + 4); if (s >= 4) { x0 = -x0; x1 = -x1; }
            *(LAS bf16x8*)(lds + SSM_CF + (s * 32 + cfl) * 16) = cvt8(x0, x1); }
    }
    __syncthreads();
    const float dsk = (r32 < 16) ? F.in[I_DSK][g * 16 + r32] : 0.f;
    float cr = 0.f, ci = 0.f;
    for (int it = 0; it < 9; ++it) {
        const int ck = 8 * it + w, t0 = 32 * ck;
        const bool active = ck < 65;
        float hlr[32], hli[32];
        float er = 0.f, ei = 0.f;
        if (active) {
            const bf16x8 A = *(const bf16x8*)(F.UB + (size_t)(rowb + t0 + r32) * 512 + 16 * g + 8 * hi);
            const f32x16 z = (f32x16){};
            const f32x16 xr0 = MFMA32(A, Bf[0][0], z), xr1 = MFMA32(A, Bf[0][1], z), xi0 = MFMA32(A, Bf[1][0], z), xi1 = MFMA32(A, Bf[1][1], z);
#pragma unroll
            for (int r = 0; r < 16; ++r) { const int t = crow(r, hi);
                X[t * 64 + r32] = xr0[r]; X[t * 64 + 32 + r32] = xr1[r]; X[2048 + t * 64 + r32] = xi0[r]; X[2048 + t * 64 + 32 + r32] = xi1[r]; }
            LDS_WAIT(); asm volatile("" ::: "memory");
#pragma unroll
            for (int t = 0; t < 32; ++t) { const float xr = X[t * 64 + lane], xi = X[2048 + t * 64 + lane];
                const float nr = ar * er - ai * ei + xr, ni = ar * ei + ai * er + xi; er = nr; ei = ni; hlr[t] = nr; hli[t] = ni; }
        }
        LE[((it & 1) * 8 + w) * 128 + lane] = er; LE[((it & 1) * 8 + w) * 128 + 64 + lane] = ei;
        LDS_WAIT(); __builtin_amdgcn_s_barrier(); asm volatile("" ::: "memory");
        float cinr = 0.f, cini = 0.f;
#pragma unroll
        for (int j = 0; j < 8; ++j) {
            if (j == w) { cinr = cr; cini = ci; }
            const float lr = LE[((it & 1) * 8 + j) * 128 + lane], li = LE[((it & 1) * 8 + j) * 128 + 64 + lane];
            const float nr = a32r * cr - a32i * ci + lr, ni = a32r * ci + a32i * cr + li; cr = nr; ci = ni;
        }
        if (active) {
            float pr = ar, pi = ai;
#pragma unroll
            for (int t = 0; t < 32; ++t) {
                const float hr = hlr[t] + pr * cinr - pi * cini, hq = hli[t] + pr * cini + pi * cinr;
                Hb[t * SSM_HP + lane] = (unsigned short)f2bf(hr); Hb[t * SSM_HP + 64 + lane] = (unsigned short)f2bf(hq);
                if (ck == 64 && t == 15) { F.out[O_SRP + (size_t)(b * NG + g) * 64 + lane] = hr; F.out[O_SIP + (size_t)(b * NG + g) * 64 + lane] = hq; }
                const float npr = pr * ar - pi * ai, npi = pr * ai + pi * ar; pr = npr; pi = npi;
            }
            LDS_WAIT(); asm volatile("" ::: "memory");
            f32x16 y = (f32x16){};
#pragma unroll
            for (int s = 0; s < 8; ++s) { const bf16x8 Af = *(const LAS bf16x8*)((LAS unsigned char*)Hb + r32 * (SSM_HP * 2) + (16 * s + 8 * hi) * 2);
                bf16x8 cf = *(const LAS bf16x8*)(lds + SSM_CF + (s * 32 + cfl) * 16); if (r32 >= 16) cf = (bf16x8){0, 0, 0, 0, 0, 0, 0, 0};
                y = MFMA32(Af, cf, y); }
            if (r32 < 16) {
#pragma unroll
                for (int r = 0; r < 16; ++r) { const int pos = t0 + crow(r, hi);
                    if (pos < LP) { const float uu = bf2f(F.UB[(size_t)(rowb + pos) * 512 + 16 * g + r32]);
                        F.GB[(size_t)(rowb + pos) * 512 + 16 * g + r32] = (bf16)f2bf(gelu_tanh(y[r] + dsk * uu)); } }
            }
            LDS_WAIT(); asm volatile("" ::: "memory");
        }
    }
    __syncthreads();
}

__device__ __forceinline__ void ssm_sample_unit(Frame& F, int db, int g) {
    int lane_ = F.lane; asm volatile("" : "+v"(lane_));
    const int lane = lane_, w = F.wave;
    LAS float* S = (LAS float*)(F.lds + 4096 * w);
    const int gp = g * 64 + lane;
    const float ar = F.PAR[PA_ABR + gp], ai = F.PAR[PA_ABI + gp];
    float hr = F.in[I_SRE][(size_t)(db * NG + g) * 64 + lane], hq = F.in[I_SIM][(size_t)(db * NG + g) * 64 + lane];
    float br[16], bi[16];
#pragma unroll
    for (int c = 0; c < 16; ++c) { br[c] = F.PAR[PA_BBR + gp * 16 + c]; bi[c] = F.PAR[PA_BBI + gp * 16 + c]; }
    const int rbase = MP + db * 4;
#pragma unroll
    for (int t = 0; t < 4; ++t) {
        float xr = 0.f, xi = 0.f;
#pragma unroll
        for (int c = 0; c < 16; ++c) { const float uu = bf2f(F.UB[(size_t)(rbase + t) * 512 + 16 * g + c]); xr += br[c] * uu; xi += bi[c] * uu; }
        const float nr = ar * hr - ai * hq + xr, ni = ar * hq + ai * hr + xi; hr = nr; hq = ni;
        S[t * 128 + lane] = hr; S[t * 128 + 64 + lane] = hq;
    }
    F.out[O_SRS + (size_t)(db * NG + g) * 64 + lane] = hr; F.out[O_SIS + (size_t)(db * NG + g) * 64 + lane] = hq;
    LDS_WAIT(); asm volatile("" ::: "memory");
    const int t = lane >> 4, ch = lane & 15;
    const float* cre = F.in[I_CRE] + (size_t)(g * 16 + ch) * 64; const float* cim = F.in[I_CIM] + (size_t)(g * 16 + ch) * 64;
    float y = 0.f;
#pragma unroll 4
    for (int p = 0; p < 64; p += 4) { const f32x4 a = *(const f32x4*)(cre + p), c = *(const f32x4*)(cim + p);
        const f32x4 sr = *(const LAS f32x4*)(S + t * 128 + p), si = *(const LAS f32x4*)(S + t * 128 + 64 + p);
        y += (a[0] * sr[0] - c[0] * si[0]) + (a[1] * sr[1] - c[1] * si[1]) + (a[2] * sr[2] - c[2] * si[2]) + (a[3] * sr[3] - c[3] * si[3]); }
    const float uu = bf2f(F.UB[(size_t)(rbase + t) * 512 + 16 * g + ch]);
    F.GB[(size_t)(rbase + t) * 512 + 16 * g + ch] = (bf16)f2bf(gelu_tanh(y + F.in[I_DSK][g * 16 + ch] * uu));
    LDS_WAIT(); asm volatile("" ::: "memory");
}

struct Args { const void* in[N_IN]; float* out; unsigned char* ws; };
constexpr int NQ_MAIN = 4 * 288, NQ_SS = 64, NQ = NQ_MAIN + NQ_SS;

__global__ void __launch_bounds__(512, 2) hymba_fwd(Args args) {
    extern __shared__ __attribute__((aligned(16))) unsigned char lds_raw[];
    Frame F;
    F.lds = (LAS unsigned char*)lds_raw;
    F.MISC = (volatile LAS unsigned*)(F.lds + MISC_OFF);
    F.tid = threadIdx.x; F.lane = F.tid & 63; F.wave = __builtin_amdgcn_readfirstlane(F.tid >> 6);
    F.G = gridDim.x; { const int bx = blockIdx.x; F.vcu = (F.G % 8 == 0) ? (bx % 8) * (F.G / 8) + bx / 8 : bx; }
    unsigned char* ws = args.ws;
    F.ws = ws; F.out = args.out;
#pragma unroll
    for (int i = 0; i < N_IN; ++i) F.in[i] = (const float*)args.in[i];
    F.ctl = (gu32*)(ws + WS_CTL);
    F.WIN_t = (bf16*)(ws + WS_WIN); F.WGLU_t = (bf16*)(ws + WS_WGLU); F.WOUT_t = (bf16*)(ws + WS_WOUT); F.WGATE_t = (bf16*)(ws + WS_WGATE); F.WUP_t = (bf16*)(ws + WS_WUP); F.WDOWN_t = (bf16*)(ws + WS_WDOWN);
    F.XN = (bf16*)(ws + WS_XN); F.QB = (bf16*)(ws + WS_QB); F.KB = (bf16*)(ws + WS_KB); F.VB = (bf16*)(ws + WS_VB); F.UB = (bf16*)(ws + WS_UB);
    F.MIX = (bf16*)(ws + WS_MIX); F.GB = (bf16*)(ws + WS_G); F.AB = (bf16*)(ws + WS_A); F.HB = (bf16*)(ws + WS_H);
    F.X1 = (float*)(ws + WS_X1); F.PAR = (float*)(ws + WS_PAR); F.ROWSS = (float*)(ws + WS_CTL) + CW_ROWSS; F.SLO = (float*)(ws + WS_SLO); F.SLL = (float*)(ws + WS_SLL);
    for (int u = F.tid; u < (LDS_BYTES - MISC_OFF) / 4; u += 512) ((LAS unsigned*)(F.lds + MISC_OFF))[u] = 0u;
    __syncthreads();
#if defined(REP_BAR) && REP_BAR > 1
#define xcd_barrier(b) do { xcd_barrier(b); xcd_barrier(b); } while (0)
#endif
    XcdBarrier bar = xcd_barrier_post((unsigned*)(F.ctl + CW_BAR), F.MISC + 8);

    p0_prologue(F);
#if defined(REP_P0) && REP_P0 > 1
    __syncthreads(); p0_prologue(F);
#endif
    xcd_barrier(bar);

    {
        pg8::Gemm g{F.XN, F.WIN_t, MPAD, PWID, DM, DM, 256}; pg8::StaticOrder S; S.init(MPAD, PWID, F.G, (int)blockIdx.x);
        EpiProj E{F.QB, F.KB, F.VB, F.UB, F.out, F.in[I_QN], F.in[I_KN]};
        pg8::gemm_phase<EpiProj, pg8::StaticOrder, true, true>(F.lds, g, S, E);
#if defined(REP_P1) && REP_P1 > 1
        __syncthreads();
        pg8::gemm_phase<EpiProj, pg8::StaticOrder, true, true>(F.lds, g, S, E);
#endif
    }
    xcd_barrier(bar);

#define P2_QUEUE(QI, NUNITS, ...) do { for (;;) { \
        if (F.tid == 0) F.MISC[0] = __hip_atomic_fetch_add((unsigned*)(F.ctl + CW_QUEUE + 64 * (QI)), 1u, RLX_AGENT); \
        __syncthreads(); const int n = (int)F.MISC[0]; __syncthreads(); \
        if (n >= (NUNITS)) break; __VA_ARGS__; } } while (0)
#ifndef REP_SSM
#define REP_SSM 1
#endif
#ifndef REP_ATT
#define REP_ATT 1
#endif
#ifndef REP_DEC
#define REP_DEC 1
#endif
#define Q_SSM() P2_QUEUE(0, 256, ssm_unit(F, n >> 5, n & 31))
#define Q_ATT() P2_QUEUE(1, 288, { const int qi = 7 - n / 32, bh = n % 32; attn_unit(F, bh >> 2, bh & 3, qi); })
#define Q_DEC() P2_QUEUE(2, DB * NSL, decode_unit(F, n / NSL, n % NSL))
#define Q_WCV() P2_QUEUE(4, WCV_UNITS, wcv_unit(F, n))
#ifndef P2_MODE
#define P2_MODE 1
#endif
#if P2_MODE == 0
    Q_WCV(); Q_SSM(); Q_ATT(); Q_DEC();
#elif P2_MODE == 2
    Q_ATT(); Q_SSM(); Q_WCV(); Q_DEC();
#else
    if (F.vcu & 1) { Q_DEC(); } else { Q_WCV(); Q_SSM(); }
    Q_ATT();
    if (F.vcu & 1) { Q_SSM(); Q_WCV(); } else { Q_DEC(); }
#endif
    P2_QUEUE(3, 64, { _Pragma("unroll 1") for (int i = 0; i < 8; ++i) { const int uidx = n * 64 + F.wave * 8 + i; ssm_sample_unit(F, uidx >> 5, uidx & 31); } });
#undef Q_SSM
#undef Q_ATT
#undef Q_DEC
#undef Q_WCV
#undef P2_QUEUE
    xcd_barrier(bar);

    {
        pg8::Gemm g{F.GB, F.WGLU_t, MPAD, SW, SW, SW, 256}; pg8::StaticOrder S; S.init(MPAD, SW, F.G, (int)blockIdx.x);
        EpiGlu E{F.GB, F.MIX, F.in[I_BGLU]};
        pg8::gemm_phase<EpiGlu, pg8::StaticOrder, true, true>(F.lds, g, S, E);
#if defined(REP_P3) && REP_P3 > 1
        __syncthreads();
        pg8::gemm_phase<EpiGlu, pg8::StaticOrder, true, true>(F.lds, g, S, E);
#endif
        for (int uidx = (F.G - 1 - (int)blockIdx.x) * 8 + F.wave; uidx < DB * NH; uidx += F.G * 8) decode_final(F, uidx >> 2, uidx & 3);
    }
    xcd_barrier(bar);

    {
        pg8::Gemm g{F.MIX, F.WOUT_t, MPAD, DM, DM, DM, 256}; pg8::StaticOrder S; S.init(MPAD, DM, F.G, (int)blockIdx.x);
        EpiOut E{F.in[I_XP], F.in[I_XS], F.in[I_META], F.X1, F.XN, F.ROWSS};
        pg8::gemm_phase<EpiOut, pg8::StaticOrder, true, true>(F.lds, g, S, E);
#if defined(REP_P4) && REP_P4 > 1
        __syncthreads();
        { EpiOut E2{F.in[I_XP], F.in[I_XS], F.in[I_META], F.X1, F.XN, F.SLO}; pg8::gemm_phase<EpiOut, pg8::StaticOrder, true, true>(F.lds, g, S, E2); }
#endif
    }
    xcd_barrier(bar);

    {
        pg8::Gemm g{F.XN - 2 * DM, F.WGATE_t, MT2 * 256, 2 * FF, DM, DM, MSTEP2}; pg8::StaticOrder S; S.init(MT2 * 256, 2 * FF, F.G, (int)blockIdx.x);
        EpiGateUp E{F.ROWSS, F.HB, F.out, F.in[I_CW], F.in[I_CB], F.in[I_SCONV], (LAS float*)(F.lds + RING_BYTES)};
        pg8::gemm_phase<EpiGateUp, pg8::StaticOrder, true, true>(F.lds, g, S, E);
#if defined(REP_P5) && REP_P5 > 1
        __syncthreads();
        pg8::gemm_phase<EpiGateUp, pg8::StaticOrder, true, true>(F.lds, g, S, E);
#endif
    }
    xcd_barrier(bar);

    {
        pg8::Gemm g{F.HB, F.WDOWN_t, MPAD, DM, FF, FF, 256}; pg8::StaticOrder S; S.init(MPAD, DM, F.G, (int)blockIdx.x);
        EpiDown E{F.XN, F.out};
        pg8::gemm_phase<EpiDown, pg8::StaticOrder, true, true>(F.lds, g, S, E);
#if defined(REP_P7) && REP_P7 > 1
        __syncthreads();
        pg8::gemm_phase<EpiDown, pg8::StaticOrder, true, true>(F.lds, g, S, E);
#endif
    }
}

extern "C" void kernel_launch(void* const* d_in, const int* in_sizes, int n_in, void* d_out, int out_size, void* d_ws, size_t ws_size, hipStream_t stream) {
    static int grid = 0;
    if (grid == 0) {
        if (n_in != N_IN || (size_t)out_size != O_END || ws_size < WS_END) { fprintf(stderr, "kernel_launch: unexpected shapes (n_in %d, out %d, ws %zu); nothing launched\n", n_in, out_size, ws_size); grid = -1; return; }
        int dev = 0, cus = 0, per_cu = 0;
        if (hipGetDevice(&dev) != hipSuccess || hipDeviceGetAttribute(&cus, hipDeviceAttributeMultiprocessorCount, dev) != hipSuccess) { grid = -1; return; }
        if (hipFuncSetAttribute((const void*)hymba_fwd, hipFuncAttributeMaxDynamicSharedMemorySize, LDS_BYTES) != hipSuccess) { fprintf(stderr, "kernel_launch: hipFuncSetAttribute failed\n"); grid = -1; return; }
        if (hipOccupancyMaxActiveBlocksPerMultiprocessor(&per_cu, (const void*)hymba_fwd, 512, LDS_BYTES) != hipSuccess || per_cu < 1)
            fprintf(stderr, "kernel_launch: note: occupancy query reports %d workgroups per CU\n", per_cu);
        (void)hipGetLastError();
        grid = cus;
    }
    if (grid < 0) return;
    if (hipMemsetAsync((char*)d_ws + WS_CTL, 0, CTL_ZERO_BYTES, stream) != hipSuccess) return;
    Args a{};
    for (int i = 0; i < N_IN; ++i) a.in[i] = d_in[i];
    a.out = (float*)d_out; a.ws = (unsigned char*)d_ws;
    hipLaunchKernelGGL(hymba_fwd, dim3(grid), dim3(512), LDS_BYTES, stream, a);
}
```

```cpp
#include <hip/hip_runtime.h>
#include <hip/hip_bf16.h>
#include <cstdio>
#include <cstdint>
#include <cmath>
namespace pg8 {
#define PG8_LAS __attribute__((address_space(3)))
typedef unsigned short bf16_t;
typedef short bf16x8 __attribute__((ext_vector_type(8)));
typedef float f32x4 __attribute__((ext_vector_type(4)));
typedef unsigned u32x4 __attribute__((ext_vector_type(4)));
constexpr int BM = 256, BK = 64, HALF = 128, HTB = HALF * BK * 2  , STAGE_BYTES = 8 * HTB, NXCD = 8, WGM = 8;

__host__ __device__ __forceinline__ int lds_byte(int r, int c) { const int st = (r >> 4) * 2 + (c >> 5), rr = r & 15, cc = c & 31, ob = rr * 64 + cc * 2; return st * 1024 + (ob ^ (((ob >> 9) & 1) << 5)); }
__host__ __device__ __forceinline__ void stage_rc(int b, int& R, int& C) { const int st = b / 1024, sb = b % 1024, swz = sb ^ (((sb >> 9) & 1) << 5); R = (st >> 1) * 16 + swz / 64; C = (st & 1) * 32 + (swz % 64) / 2; }
__host__ __device__ __forceinline__ int perm32(int rho) { const int n = rho >> 4, i = rho & 15; return 8 * (i >> 2) + 4 * n + (i & 3); }

struct Unit { int pm, pn, arow, kt0, nkt; };
struct Gemm { const bf16_t* A; const bf16_t* Bt; int M, N, K, ld, mstep; };

struct StaticOrder {
    int nM, nN, nwg, G, c;
    __host__ __device__ void init(int M, int N, int G_, int c_) { nM = M / BM; nN = N / BM; nwg = nM * nN; G = G_; c = c_; }
    __host__ __device__ bool next(int i, Unit& u) const {
        const long L = (long)i * G + c; if (L >= nwg) return false;
        int wgid = (int)L; { const int q = nwg / NXCD, r = nwg % NXCD, xcd = wgid % NXCD, off = wgid / NXCD; wgid = (xcd < r ? xcd * (q + 1) : r * (q + 1) + (xcd - r) * q) + off; }
        const int nig = WGM * nN, gid = wgid / nig, fm = gid * WGM, gsz = (nM - fm) < WGM ? (nM - fm) : WGM;
        u.pm = fm + ((wgid % nig) % gsz); u.pn = (wgid % nig) / gsz; u.arow = -1; u.kt0 = 0; u.nkt = 0; return true;
    }
    __device__ __forceinline__ void a_ready(const Unit&) const {}
    __device__ __forceinline__ void done(const Unit&) const {}
};

__device__ __forceinline__ unsigned cvt_pk_bf16(float lo, float hi) { unsigned r; asm volatile("v_cvt_pk_bf16_f32 %0, %1, %2" : "=v"(r) : "v"(lo), "v"(hi)); return r; }
typedef float f32x2 __attribute__((ext_vector_type(2)));
__device__ __forceinline__ f32x2 gelu_pk(f32x2 v) {
    const f32x2 av = __builtin_elementwise_abs(v), d = av * 0.2316418882f + 1.0f;
    f32x2 t; t.x = __builtin_amdgcn_rcpf(d.x); t.y = __builtin_amdgcn_rcpf(d.y);
    f32x2 q = t * 0.5307027145f + (-0.7265760135f); q = q * t + 0.7107068705f; q = q * t + (-0.142248368f); q = q * t + 0.127414796f; q = q * t;
    const f32x2 s = (v * v) * (-0.72134752044f);
    f32x2 e; e.x = __builtin_amdgcn_exp2f(s.x); e.y = __builtin_amdgcn_exp2f(s.y);
    const f32x2 m = v * (q * e), r = v - m;
    f32x2 o; o.x = v.x < 0.f ? m.x : r.x; o.y = v.y < 0.f ? m.y : r.y; return o;
}

template <int ACT  > struct EpiBf16 {
    static constexpr bool PERM = true, AFTER_DRAIN = false; static_assert(ACT == 0 || ACT == 1, "EpiBf16: ACT is 0 (none) or 1 (gelu_pk)");
    bf16_t* O; int ldc; const float* bias; int split_cols; size_t split_stride; float scale0;
    __device__ __forceinline__ void operator()(const f32x4 (&acc)[2][2][4][2], const Unit& u, int wr, int wc, int fr, int fq) const {
        const int row0 = u.pm * BM + wr * 64 + fr; int colt = u.pn * BM; bf16_t* base = O;
        float sc = 1.f; if (split_cols) { const int t = colt / split_cols; base += (size_t)t * split_stride; colt -= t * split_cols; if (t == 0) sc = scale0; }
        const int col0 = colt + wc * 32 + 8 * fq, bcol0 = u.pn * BM + wc * 32 + 8 * fq;
        f32x4 bv[2][2];
#pragma unroll
        for (int bj = 0; bj < 2; ++bj)
#pragma unroll
            for (int n = 0; n < 2; ++n) bv[bj][n] = bias ? *(const f32x4*)(bias + bcol0 + bj * HALF + 4 * n) : (f32x4){0.f, 0.f, 0.f, 0.f};
#pragma unroll
        for (int ai = 0; ai < 2; ++ai)
#pragma unroll
            for (int m = 0; m < 4; ++m) { bf16_t* rowp = base + (size_t)(row0 + ai * HALF + m * 16) * ldc + col0;
#pragma unroll
                for (int bj = 0; bj < 2; ++bj) { f32x4 v0 = acc[ai][bj][m][0] + bv[bj][0], v1 = acc[ai][bj][m][1] + bv[bj][1];
                    if (ACT == 1) { f32x2 a = gelu_pk((f32x2){v0[0], v0[1]}), b = gelu_pk((f32x2){v0[2], v0[3]}), c = gelu_pk((f32x2){v1[0], v1[1]}), d = gelu_pk((f32x2){v1[2], v1[3]});
                        v0 = (f32x4){a.x, a.y, b.x, b.y}; v1 = (f32x4){c.x, c.y, d.x, d.y}; }
                    v0 = v0 * sc; v1 = v1 * sc; u32x4 w; w.x = cvt_pk_bf16(v0[0], v0[1]); w.y = cvt_pk_bf16(v0[2], v0[3]); w.z = cvt_pk_bf16(v1[0], v1[1]); w.w = cvt_pk_bf16(v1[2], v1[3]);
                    *(u32x4*)(rowp + bj * HALF) = w; } }
    }
};

template <class Epi, class Sched, bool ALIGN_EPI = false, bool SP2 = false>
__device__ __forceinline__ void gemm_phase(PG8_LAS unsigned char* lds, const Gemm g, const Sched& S, const Epi& E) {
    int tid_ = threadIdx.x; asm volatile("" : "+v"(tid_));
    const int tid = tid_, wid = __builtin_amdgcn_readfirstlane(tid >> 6), lane = tid & 63, wr = wid >> 2, wc = wid & 3, fr = lane & 15, fq = lane >> 4;
    const int K = g.ld, nt = g.K / BK;
    unsigned voffA[2], voffB[2];
#pragma unroll
    for (int i = 0; i < 2; ++i) { int R, C; stage_rc(tid * 16 + i * 8192, R, C); const int Rb = Epi::PERM ? ((R & ~31) + perm32(R & 31)) : R;
        voffA[i] = (unsigned)(R * K + C) * 2u; voffB[i] = (unsigned)(Rb * K + C) * 2u; }
    const size_t kstep = (size_t)(BK * 2);
    const size_t hstep = (size_t)HALF * K * 2;
    const size_t tstep = 2 * hstep, tstepA = (size_t)g.mstep * K * 2;
    const unsigned ldsw = (unsigned)wid * 1024u;
    const int aoff = lds_byte(wr * 64 + fr, fq * 8), boff = lds_byte(wc * 32 + fr, fq * 8);
#define PG8_SA(b, h) (((b) * 2 + (h)) * HTB)
#define PG8_SB(b, h) ((4 + (b) * 2 + (h)) * HTB)
#define PG8_STAGE(bufoff, gbase, voff) do { _Pragma("unroll") for (int _i = 0; _i < 2; ++_i) \
        __builtin_amdgcn_global_load_lds((const unsigned*)((const char*)(gbase) + (voff)[_i]), (PG8_LAS unsigned*)(lds + (bufoff) + ldsw + _i * 8192), 16, 0, 0); } while (0)
#define PG8_LDA(dst, b, h) do { _Pragma("unroll") for (int m = 0; m < 4; ++m) _Pragma("unroll") for (int k = 0; k < 2; ++k) dst[m][k] = *(const PG8_LAS bf16x8*)(lds + PG8_SA(b, h) + aoff + m * 2048 + k * 1024); } while (0)
#define PG8_LDB(dst, b, h) do { _Pragma("unroll") for (int n = 0; n < 2; ++n) _Pragma("unroll") for (int k = 0; k < 2; ++k) dst[n][k] = *(const PG8_LAS bf16x8*)(lds + PG8_SB(b, h) + boff + n * 2048 + k * 1024); } while (0)
#define PG8_MMA(ai, bj, At, Bt) do { __builtin_amdgcn_s_setprio(1); _Pragma("unroll") for (int m = 0; m < 4; ++m) _Pragma("unroll") for (int n = 0; n < 2; ++n) _Pragma("unroll") for (int k = 0; k < 2; ++k) \
        acc[ai][bj][m][n] = __builtin_amdgcn_mfma_f32_16x16x32_bf16(Bt[n][k], At[m][k], acc[ai][bj][m][n], 0, 0, 0); __builtin_amdgcn_s_setprio(0); } while (0)
#define PG8_WAIT_V(n) asm volatile("s_waitcnt vmcnt(" #n ")" ::: "memory")
#define PG8_WAIT_L(n) asm volatile("s_waitcnt lgkmcnt(" #n ")" ::: "memory")
#define PG8_BAR __builtin_amdgcn_s_barrier()
#define PG8_SCHED __builtin_amdgcn_sched_barrier(0)
    Unit cur, nxt; int ui = 0;
    if (!S.next(0, cur)) return;
    f32x4 acc[2][2][4][2];
#pragma unroll
    for (int a = 0; a < 2; ++a)
#pragma unroll
        for (int b = 0; b < 2; ++b)
#pragma unroll
            for (int m = 0; m < 4; ++m)
#pragma unroll
                for (int n = 0; n < 2; ++n) acc[a][b][m][n] = (f32x4){0.f, 0.f, 0.f, 0.f};
    bf16x8 At[4][2], B0[2][2], B1[2][2];
#define PG8_UA(u) ((const char*)g.A + ((u).arow >= 0 ? (size_t)(u).arow * K * 2 : (size_t)(u).pm * tstepA) + (size_t)(u).kt0 * kstep)
#define PG8_UB(u) ((const char*)g.Bt + (size_t)(u).pn * tstep + (size_t)(u).kt0 * kstep)
    const char* cA = PG8_UA(cur); const char* cB = PG8_UB(cur);
    int cnt_ = cur.nkt > 0 ? cur.nkt : nt;
    S.a_ready(cur);
    if constexpr (SP2) {
        PG8_STAGE(PG8_SB(0, 0), cB, voffB); PG8_STAGE(PG8_SB(0, 1), cB + hstep, voffB); PG8_STAGE(PG8_SA(0, 0), cA, voffA); PG8_STAGE(PG8_SA(0, 1), cA + hstep, voffA);
        if (wr == 1) PG8_BAR;
        PG8_WAIT_V(2); PG8_BAR;
        PG8_STAGE(PG8_SB(1, 0), cB + kstep, voffB); PG8_STAGE(PG8_SA(1, 0), cA + kstep, voffA); PG8_STAGE(PG8_SB(1, 1), cB + hstep + kstep, voffB);
        PG8_WAIT_V(6); PG8_BAR;
    } else {
        PG8_STAGE(PG8_SB(0, 0), cB, voffB); PG8_STAGE(PG8_SA(0, 0), cA, voffA); PG8_STAGE(PG8_SB(0, 1), cB + hstep, voffB); PG8_STAGE(PG8_SA(0, 1), cA + hstep, voffA);
        if (wr == 1) PG8_BAR;
        PG8_WAIT_V(4); PG8_BAR;
        PG8_STAGE(PG8_SB(1, 0), cB + kstep, voffB); PG8_STAGE(PG8_SA(1, 0), cA + kstep, voffA); PG8_STAGE(PG8_SB(1, 1), cB + hstep + kstep, voffB);
        PG8_WAIT_V(6); PG8_BAR;
    }
    for (;;) {
        const bool has_next = S.next(ui + 1, nxt);
        const char* nA = has_next ? PG8_UA(nxt) : cA; const char* nB = has_next ? PG8_UB(nxt) : cB;
        for (int t = 0; t < cnt_; t += 2) {
            const bool last = (t == cnt_ - 2);
            const char* a1 = cA + (size_t)(t + 1) * kstep;
            const char* a2 = last ? nA : cA + (size_t)(t + 2) * kstep; const char* b2 = last ? nB : cB + (size_t)(t + 2) * kstep;
            const char* a3 = a2 + kstep; const char* b3 = b2 + kstep;
            if (last && has_next) S.a_ready(nxt);
            if constexpr (SP2) {
            PG8_LDB(B0, 0, 0); PG8_LDB(B1, 0, 1); PG8_SCHED; PG8_LDA(At, 0, 0); PG8_STAGE(PG8_SA(1, 1), a1 + hstep, voffA);
            PG8_WAIT_V(8); PG8_WAIT_L(0); PG8_BAR; PG8_MMA(0, 0, At, B0); PG8_MMA(0, 1, At, B1); PG8_BAR; PG8_SCHED;
            PG8_LDA(At, 0, 1); PG8_STAGE(PG8_SB(0, 0), b2, voffB); PG8_STAGE(PG8_SB(0, 1), b2 + hstep, voffB); PG8_STAGE(PG8_SA(0, 0), a2, voffA);
            PG8_WAIT_V(8); PG8_WAIT_L(0); PG8_BAR; PG8_MMA(1, 0, At, B0); PG8_MMA(1, 1, At, B1); PG8_BAR; PG8_SCHED;
            PG8_LDB(B0, 1, 0); PG8_LDB(B1, 1, 1); PG8_SCHED; PG8_LDA(At, 1, 0); PG8_STAGE(PG8_SA(0, 1), a2 + hstep, voffA);
            PG8_WAIT_V(8); PG8_WAIT_L(0); PG8_BAR; PG8_MMA(0, 0, At, B0); PG8_MMA(0, 1, At, B1); PG8_BAR; PG8_SCHED;
            PG8_LDA(At, 1, 1); PG8_STAGE(PG8_SB(1, 0), b3, voffB); PG8_STAGE(PG8_SB(1, 1), b3 + hstep, voffB); PG8_STAGE(PG8_SA(1, 0), a3, voffA);
            PG8_WAIT_V(8); PG8_WAIT_L(0); PG8_BAR; PG8_MMA(1, 0, At, B0); PG8_MMA(1, 1, At, B1); PG8_BAR; PG8_SCHED;
            } else {
            PG8_LDB(B0, 0, 0); PG8_SCHED; PG8_LDA(At, 0, 0); PG8_STAGE(PG8_SA(1, 1), a1 + hstep, voffA);
            PG8_WAIT_L(8); PG8_BAR; PG8_WAIT_L(0); PG8_MMA(0, 0, At, B0); PG8_BAR; PG8_SCHED;
            PG8_LDB(B1, 0, 1); PG8_STAGE(PG8_SB(0, 0), b2, voffB);
            PG8_BAR; PG8_WAIT_L(0); PG8_MMA(0, 1, At, B1); PG8_BAR;
            PG8_LDA(At, 0, 1); PG8_STAGE(PG8_SA(0, 0), a2, voffA);
            PG8_BAR; PG8_WAIT_L(0); PG8_MMA(1, 0, At, B0); PG8_BAR; PG8_SCHED;
            PG8_STAGE(PG8_SB(0, 1), b2 + hstep, voffB);
            PG8_WAIT_V(6); PG8_BAR; PG8_MMA(1, 1, At, B1); PG8_BAR;
            PG8_LDB(B0, 1, 0); PG8_SCHED; PG8_LDA(At, 1, 0); PG8_STAGE(PG8_SA(0, 1), a2 + hstep, voffA);
            PG8_WAIT_L(8); PG8_BAR; PG8_WAIT_L(0); PG8_MMA(0, 0, At, B0); PG8_BAR; PG8_SCHED;
            PG8_LDB(B1, 1, 1); PG8_STAGE(PG8_SB(1, 0), b3, voffB);
            PG8_BAR; PG8_WAIT_L(0); PG8_MMA(0, 1, At, B1); PG8_BAR;
            PG8_LDA(At, 1, 1); PG8_STAGE(PG8_SA(1, 0), a3, voffA);
            PG8_BAR; PG8_WAIT_L(0); PG8_MMA(1, 0, At, B0); PG8_BAR; PG8_SCHED;
            PG8_STAGE(PG8_SB(1, 1), b3 + hstep, voffB);
            PG8_WAIT_V(6); PG8_BAR; PG8_MMA(1, 1, At, B1); PG8_BAR;
            }
        }
        if constexpr (ALIGN_EPI) { if (wr == 0) PG8_BAR; }
        if constexpr (!Epi::AFTER_DRAIN) { E(acc, cur, wr, wc, fr, fq); S.done(cur); }
        if (!has_next) break;
#pragma unroll
        for (int a = 0; a < 2; ++a)
#pragma unroll
            for (int b = 0; b < 2; ++b)
#pragma unroll
                for (int m = 0; m < 4; ++m)
#pragma unroll
                    for (int n = 0; n < 2; ++n) acc[a][b][m][n] = (f32x4){0.f, 0.f, 0.f, 0.f};
        cur = nxt; cA = nA; cB = nB; ++ui; cnt_ = cur.nkt > 0 ? cur.nkt : nt;
        if constexpr (ALIGN_EPI) { if (wr == 1) PG8_BAR; }
    }
    PG8_WAIT_V(0);
    if constexpr (!ALIGN_EPI) { if (wr == 0) PG8_BAR; }
    PG8_BAR;
    if constexpr (Epi::AFTER_DRAIN) { E.fused(acc, cur, wr, wc, fr, fq, lds, wid, lane); S.done(cur); }
#undef PG8_UA
#undef PG8_UB
#undef PG8_SA
#undef PG8_SB
#undef PG8_STAGE
#undef PG8_LDA
#undef PG8_LDB
#undef PG8_MMA
#undef PG8_WAIT_V
#undef PG8_WAIT_L
#undef PG8_BAR
#undef PG8_SCHED
}
}

constexpr int DM = 1024, NB = 8, SEQ = 2048, NMETA = 16, LP = SEQ + NMETA, DB = 128, TS = 4;
constexpr int MP = NB * LP, MS = DB * TS, MV = MP + MS, MPAD = 17152;
constexpr int NH = 4, HD = 128, QKD = 64, AW = 512, SW = 512, NG = 32, SG = 16, NST = 64, FF = 2816, PWID = 2048;
constexpr int NPG = 16, PAGE = 128;
constexpr float EPS = 1e-6f;
constexpr float QSCALE = 0.125f * 1.4426950408889634f;
constexpr float LAM_INIT = 0.2f;
constexpr size_t O_YP = 0, O_YS = O_YP + (size_t)NB * SEQ * DM, O_KP = O_YS + (size_t)MS * DM, O_VP = O_KP + (size_t)MP * 512,
                 O_KS = O_VP + (size_t)MP * 512, O_VS = O_KS + (size_t)MS * 512, O_SRP = O_VS + (size_t)MS * 512, O_SIP = O_SRP + NB * NG * NST,
                 O_SRS = O_SIP + NB * NG * NST, O_SIS = O_SRS + DB * NG * NST, O_CP = O_SIS + DB * NG * NST, O_CS = O_CP + (size_t)NB * 2 * FF,
                 O_END = O_CS + (size_t)DB * 2 * FF;
enum { I_XP = 0, I_XS, I_CK, I_CV, I_SRE, I_SIM, I_SCONV, I_PT, I_META, I_N1, I_WIN, I_QN, I_KN, I_LQ, I_LK, I_SUBN, I_ARE, I_AIM, I_LDT, I_BRE, I_BIM,
       I_CRE, I_CIM, I_DSK, I_WGLU, I_BGLU, I_WOUT, I_N2, I_WGATE, I_WUP, I_CW, I_CB, I_WDOWN, N_IN };

constexpr size_t MiB = 1u << 20;
constexpr size_t WS_CTL = 0, CTL_ZERO_BYTES = 160 * 1024;
constexpr size_t WS_PAR = 1 * MiB;
constexpr size_t WS_WIN = 2 * MiB, WS_WGLU = 6 * MiB, WS_WOUT = 7 * MiB, WS_WGATE = 9 * MiB, WS_WUP = 15 * MiB, WS_WDOWN = 21 * MiB;
constexpr size_t WS_XN = 32 * MiB;
constexpr size_t WS_QB = 66 * MiB, WS_KB = 83 * MiB, WS_VB = 100 * MiB, WS_UB = 117 * MiB;
constexpr size_t WS_MIX = 134 * MiB;
constexpr size_t WS_G = 168 * MiB;
constexpr size_t WS_X1 = 185 * MiB;
constexpr size_t WS_A = 252 * MiB;
constexpr size_t WS_H = 345 * MiB;
constexpr size_t WS_SLO = 438 * MiB, WS_SLL = 455 * MiB, WS_EH = 456 * MiB, WS_END = 458 * MiB;
constexpr int CW_BAR = 4096;
constexpr int CW_QUEUE = 8192;
constexpr int CW_ROWSS = 16384;
static_assert((CW_ROWSS + MPAD) * 4 <= (int)CTL_ZERO_BYTES, "ctl");
constexpr int PA_ABR = 0, PA_ABI = 2048, PA_BBR = 4096, PA_BBI = 4096 + 32768, PA_LAM = 4096 + 65536;

constexpr int RING_BYTES = 131072;
constexpr int LDS_BYTES = 147456;
constexpr int MISC_OFF = LDS_BYTES - 512;

#define GAS __attribute__((address_space(1)))
#define LAS __attribute__((address_space(3)))
typedef unsigned short bf16;
typedef unsigned v4u __attribute__((ext_vector_type(4)));
typedef unsigned v2u __attribute__((ext_vector_type(2)));
typedef float f32x4 __attribute__((ext_vector_type(4)));
typedef float f32x2 __attribute__((ext_vector_type(2)));
typedef float f32x16 __attribute__((ext_vector_type(16)));
typedef short bf16x8 __attribute__((ext_vector_type(8)));
typedef short s16x4 __attribute__((ext_vector_type(4)));
typedef GAS unsigned gu32;
#define RLX_AGENT __ATOMIC_RELAXED, __HIP_MEMORY_SCOPE_AGENT
#define LDS_WAIT() asm volatile("s_waitcnt lgkmcnt(0)" ::: "memory")
#define VM_WAIT() asm volatile("s_waitcnt vmcnt(0)" ::: "memory")
__device__ __forceinline__ unsigned f2bf(float f) { unsigned u = __builtin_bit_cast(unsigned, f); return (u + 0x7fffu + ((u >> 16) & 1u)) >> 16; }
__device__ __forceinline__ unsigned pk2(float lo, float hi) { unsigned r; asm("v_cvt_pk_bf16_f32 %0, %1, %2" : "=v"(r) : "v"(lo), "v"(hi)); return r; }
__device__ __forceinline__ float bf2f(unsigned short b) { return __builtin_bit_cast(float, (unsigned)b << 16); }
__device__ __forceinline__ f32x4 ld_bf4(const bf16* p) { const v2u w = *(const v2u*)p; return (f32x4){ bf2f((unsigned short)(w.x & 0xffffu)), bf2f((unsigned short)(w.x >> 16)), bf2f((unsigned short)(w.y & 0xffffu)), bf2f((unsigned short)(w.y >> 16)) }; }
__device__ __forceinline__ unsigned cvtpk(float lo, float hi) { unsigned r; asm volatile("v_cvt_pk_bf16_f32 %0, %1, %2" : "=v"(r) : "v"(lo), "v"(hi)); return r; }
__device__ __forceinline__ float gelu_tanh(float x) {
    const float z = x * (1.0f + 0.044715f * x * x);
    const float e = __builtin_amdgcn_exp2f(z * (-2.0f * 0.7978845608028654f * 1.4426950408889634f));
    return x * __builtin_amdgcn_rcpf(1.0f + e);
}
__device__ __forceinline__ float wave_sum(float v) {
#pragma unroll
    for (int o = 1; o < 64; o <<= 1) v += __shfl_xor(v, o);
    return v;
}

#define XB_TMO      128
#define XB_XCNT(j)  (256  + 64 * (j))
#define XB_XSUB(j)  (1280 + 64 * (j))
#define XB_XGEN(j)  (2304 + 64 * (j))
#define XB_TOP      3328
#define XB_TOPGEN   3392
#define XCD_BAR_WORDS 3456
#define XB_SPIN_CAP (1u << 18)
__device__ __forceinline__ unsigned xb_ld(unsigned* p)              { return __hip_atomic_load(p, __ATOMIC_RELAXED, __HIP_MEMORY_SCOPE_AGENT); }
__device__ __forceinline__ unsigned xb_add(unsigned* p, unsigned v) { return __hip_atomic_fetch_add(p, v, __ATOMIC_RELAXED, __HIP_MEMORY_SCOPE_AGENT); }
__device__ __forceinline__ unsigned xb_xcc_id() { return (unsigned)__builtin_amdgcn_s_getreg((3 << 11) | 20) & 0xFu; }
#define XB_SPIN(cond, bar) do { unsigned _sp = 0; while (cond) { __builtin_amdgcn_s_sleep(1); \
    if ((++_sp & 255u) == 0u) { if (xb_ld(&(bar)[XB_TMO])) break; if (_sp > XB_SPIN_CAP) { atomicAdd(&(bar)[XB_TMO], 1u); break; } } } } while (0)
struct XcdBarrier { unsigned* bar; unsigned x; volatile LAS unsigned* st; };
__device__ __forceinline__ XcdBarrier xcd_barrier_post(unsigned* bar, volatile LAS unsigned* st) {
    XcdBarrier b; b.bar = bar; b.x = xb_xcc_id(); b.st = st;
    if (threadIdx.x == 0) (void)xb_add(&bar[XB_XCNT(b.x)], 1u);
    return b;
}
__device__ __forceinline__ void xcd_barrier_complete(unsigned* bar, unsigned x, unsigned& nloc, unsigned& nx) {
    const unsigned G = gridDim.x * gridDim.y * gridDim.z;
    unsigned sum, cnt, mine, sp = 0u;
    for (;;) {
        sum = 0u; cnt = 0u; mine = 0u;
#pragma unroll
        for (unsigned j = 0; j < 16; ++j) { const unsigned c = xb_ld(&bar[XB_XCNT(j)]); sum += c; cnt += (c > 0u) ? 1u : 0u; mine = (j == x) ? c : mine; }
        if (sum == G) break;
        __builtin_amdgcn_s_sleep(1);
        if ((++sp & 255u) == 0u) { if (xb_ld(&bar[XB_TMO])) break; if (sp > XB_SPIN_CAP) { atomicAdd(&bar[XB_TMO], 1u); break; } }
    }
    nloc = mine > 0u ? mine : 1u; nx = cnt > 0u ? cnt : 1u;
}
__device__ __forceinline__ void xcd_barrier(const XcdBarrier& b) {
    asm volatile("s_waitcnt vmcnt(0)" ::: "memory");
    __syncthreads();
    if (threadIdx.x == 0) {
        unsigned* bar = b.bar;
        __builtin_amdgcn_s_waitcnt(0);
        unsigned nloc = b.st[0], nx = b.st[1];
        if (nloc == 0u) { xcd_barrier_complete(bar, b.x, nloc, nx); b.st[0] = nloc; b.st[1] = nx; }
        const unsigned old = xb_add(&bar[XB_XSUB(b.x)], 1u);
        const unsigned gen = old / nloc;
        if (old + 1u == (gen + 1u) * nloc) {
            __builtin_amdgcn_fence(__ATOMIC_RELEASE, "agent");
            asm volatile("s_waitcnt vmcnt(0)" ::: "memory");
            const unsigned og = xb_add(&bar[XB_TOP], 1u);
            const unsigned tg = og / nx;
            if (og + 1u == (tg + 1u) * nx) xb_add(&bar[XB_TOPGEN], 1u);
            else XB_SPIN(xb_ld(&bar[XB_TOPGEN]) == tg, bar);
            __builtin_amdgcn_fence(__ATOMIC_ACQUIRE, "agent");
            xb_add(&bar[XB_XGEN(b.x)], 1u);
            asm volatile("s_waitcnt vmcnt(0)" ::: "memory");
        } else {
            XB_SPIN(xb_ld(&bar[XB_XGEN(b.x)]) == gen, bar);
            __builtin_amdgcn_fence(__ATOMIC_ACQUIRE, "agent");
            asm volatile("s_waitcnt vmcnt(0)" ::: "memory");
        }
    }
    __syncthreads();
}

struct Frame {
    LAS unsigned char* lds;
    volatile LAS unsigned* MISC;
    gu32* ctl;
    int tid, lane, wave, vcu, G;
    const float* in[N_IN];
    float* out;
    unsigned char* ws;
    bf16 *WIN_t, *WGLU_t, *WOUT_t, *WGATE_t, *WUP_t, *WDOWN_t;
    bf16 *XN, *QB, *KB, *VB, *UB, *MIX, *GB, *AB, *HB;
    float *X1, *PAR, *ROWSS, *SLO, *SLL;
};

__device__ __forceinline__ const float* xin_row(const Frame& F, int m) {
    if (m < MP) { const int b = m / LP, t = m - b * LP; return t < NMETA ? F.in[I_META] + (size_t)t * DM : F.in[I_XP] + ((size_t)b * SEQ + (t - NMETA)) * DM; }
    if (m < MV) return F.in[I_XS] + (size_t)(m - MP) * DM;
    return nullptr;
}

__device__ __forceinline__ void p0_tr_item(const float* W, int K, int N, bf16* WT, LAS float* scr, int item, int lane, const float* kscale, int mode) {
    const int nblk = N / 32, kb = item / nblk, nb = item % nblk, k0 = 64 * kb, n0 = 32 * nb;
#pragma unroll 8
    for (int i = 0; i < 32; ++i) { const int kk = 2 * i + (lane >> 5); float v = W[(size_t)(k0 + kk) * N + n0 + (lane & 31)]; if (kscale) v *= kscale[k0 + kk]; scr[kk * 33 + (lane & 31)] = v; }
    LDS_WAIT(); asm volatile("" ::: "memory");
    int prow0 = n0;
    if (mode == 1 && n0 < 1024) { const int pn = n0 >> 8, lb = (n0 & 255) >> 5, wc = lb >> 1, bj = lb & 1; prow0 = 256 * pn + 128 * bj + 32 * wc; }
    if (mode >= 2) prow0 = 256 * (n0 >> 7) + (n0 & 127) + (mode == 3 ? 128 : 0);
    const int c = lane & 7;
#pragma unroll
    for (int j = 0; j < 4; ++j) { const int n = (lane >> 3) + 8 * j; const LAS float* s = scr + (8 * c) * 33 + n;
        v4u o; o.x = pk2(s[0 * 33], s[1 * 33]); o.y = pk2(s[2 * 33], s[3 * 33]); o.z = pk2(s[4 * 33], s[5 * 33]); o.w = pk2(s[6 * 33], s[7 * 33]);
        *(GAS v4u*)(WT + (size_t)(prow0 + n) * K + k0 + 8 * c) = o; }
    LDS_WAIT(); asm volatile("" ::: "memory");
}
__device__ __forceinline__ void p0_prologue(Frame& F) {
    LAS float* scr = (LAS float*)(F.lds + F.wave * 16384);
    int lane_ = F.lane; asm volatile("" : "+v"(lane_));
    const int gw = F.vcu * 8 + F.wave, NGW = F.G * 8, lane = lane_;
    constexpr int I_1 = (DM / 64) * (PWID / 32);
    for (int it = gw; it < I_1; it += NGW) p0_tr_item(F.in[I_WIN], DM, PWID, F.WIN_t, scr, it, lane, nullptr, 1);
    {
        const GAS f32x4* g1 = (const GAS f32x4*)F.in[I_N1] + lane;
        f32x4 gv[4];
#pragma unroll
        for (int j = 0; j < 4; ++j) gv[j] = g1[64 * j];
        f32x4 v[4], nx[4];
        const float* src = (gw < MPAD) ? xin_row(F, gw) : nullptr;
#pragma unroll
        for (int j = 0; j < 4; ++j) v[j] = src ? ((const GAS f32x4*)src + lane)[64 * j] : (f32x4){0.f, 0.f, 0.f, 0.f};
#pragma unroll 1
        for (int m = gw; m < MPAD; m += NGW) {
            const int mn = m + NGW;
            const float* nsrc = (mn < MPAD) ? xin_row(F, mn) : nullptr;
#pragma unroll
            for (int j = 0; j < 4; ++j) nx[j] = nsrc ? ((const GAS f32x4*)nsrc + lane)[64 * j] : (f32x4){0.f, 0.f, 0.f, 0.f};
            float s = 0.f;
#pragma unroll
            for (int j = 0; j < 4; ++j) s += (v[j].x * v[j].x + v[j].y * v[j].y) + (v[j].z * v[j].z + v[j].w * v[j].w);
            const float r = rsqrtf(wave_sum(s) * (1.f / DM) + EPS);
            GAS unsigned long long* o8 = (GAS unsigned long long*)(F.XN + (size_t)m * DM) + lane;
#pragma unroll
            for (int j = 0; j < 4; ++j) { const f32x4 y = (v[j] * r) * gv[j]; o8[64 * j] = (unsigned long long)pk2(y.x, y.y) | ((unsigned long long)pk2(y.z, y.w) << 32); }
#pragma unroll
            for (int j = 0; j < 4; ++j) v[j] = nx[j];
        }
    }
    if (gw >= NGW - 512) {
        const int idx = (gw - (NGW - 512)) * 64 + lane, gp = idx >> 4, c = idx & 15, g = gp >> 6;
        const float dt = expf(F.in[I_LDT][g]);
        const float ar = F.in[I_ARE][gp], ai = F.in[I_AIM][gp];
        const float mag = expf(ar * dt), abr = mag * cosf(ai * dt), abi = mag * sinf(ai * dt);
        const float den = ar * ar + ai * ai, nr = abr - 1.0f, ni = abi;
        const float gr = (nr * ar + ni * ai) / den, gi = (ni * ar - nr * ai) / den;
        if (c == 0) { F.PAR[PA_ABR + gp] = abr; F.PAR[PA_ABI + gp] = abi; }
        const float br = F.in[I_BRE][gp * 16 + c], bi = F.in[I_BIM][gp * 16 + c];
        F.PAR[PA_BBR + gp * 16 + c] = gr * br - gi * bi; F.PAR[PA_BBI + gp * 16 + c] = gr * bi + gi * br;
    }
    {
        bf16* EH = (bf16*)(F.ws + WS_EH);
        const float* cw = F.in[I_CW]; const float* hist = F.in[I_SCONV];
        for (int e = gw * 64 + lane; e < DB * (FF / 4); e += NGW * 64) {
            const int db = e / (FF / 4), c = (e - db * (FF / 4)) * 4;
            const f32x4 h0 = *(const f32x4*)(hist + (size_t)db * 2 * FF + c), h1 = *(const f32x4*)(hist + (size_t)db * 2 * FF + FF + c);
            const f32x4 w0 = *(const f32x4*)(cw + c), w1 = *(const f32x4*)(cw + FF + c);
            const f32x4 e0 = w0 * h0 + w1 * h1, e1 = w0 * h1;
            v2u a; a.x = pk2(e0[0], e0[1]); a.y = pk2(e0[2], e0[3]); *(v2u*)(EH + (size_t)db * 2 * FF + c) = a;
            v2u b; b.x = pk2(e1[0], e1[1]); b.y = pk2(e1[2], e1[3]); *(v2u*)(EH + (size_t)db * 2 * FF + FF + c) = b;
        }
    }
    if (gw == 0) {
        const float s0 = wave_sum(F.in[I_LQ][lane] * F.in[I_LK][lane]), s1 = wave_sum(F.in[I_LQ][64 + lane] * F.in[I_LK][64 + lane]);
        if (lane == 0) F.PAR[PA_LAM] = expf(s0) - expf(s1) + LAM_INIT;
    }
}

constexpr int WCV_I2 = (SW / 64) * (SW / 32), WCV_I3 = (DM / 64) * (DM / 32), WCV_I4 = (DM / 64) * (FF / 32), WCV_I6 = (FF / 64) * (DM / 32);
constexpr int WCV_ITEMS = WCV_I2 + WCV_I3 + 2 * WCV_I4 + WCV_I6, WCV_UNITS = (WCV_ITEMS + 7) / 8;
__device__ __forceinline__ void wcv_item(Frame& F, int r) {
    int lane_ = F.lane; asm volatile("" : "+v"(lane_));
    const int lane = lane_;
    LAS float* scr = (LAS float*)(F.lds + F.wave * 16384);
    if (r < WCV_I2) { p0_tr_item(F.in[I_WGLU], SW, SW, F.WGLU_t, scr, r, lane, nullptr, 0); return; } r -= WCV_I2;
    if (r < WCV_I3) { p0_tr_item(F.in[I_WOUT], DM, DM, F.WOUT_t, scr, r, lane, nullptr, 0); return; } r -= WCV_I3;
    if (r < WCV_I4) { p0_tr_item(F.in[I_WGATE], DM, FF, F.WGATE_t, scr, r, lane, F.in[I_N2], 2); return; } r -= WCV_I4;
    if (r < WCV_I4) { p0_tr_item(F.in[I_WUP], DM, FF, F.WGATE_t, scr, r, lane, F.in[I_N2], 3); return; } r -= WCV_I4;
    p0_tr_item(F.in[I_WDOWN], FF, DM, F.WDOWN_t, scr, r, lane, nullptr, 0);
}

using pg8::Unit; using pg8::HALF; using pg8::BM;

constexpr int PT_KSPL = 4, PT_PK = 4, PT_NPART = 24 * PT_KSPL;
struct ProjOrder {
    pg8::StaticOrder so; int c;
    __device__ void init(int G, int c_) { so.init(64 * 256, PWID, G, c_); c = c_; }
    __device__ bool next(int i, Unit& u) const {
        int j = i;
        if (c < PT_NPART) {
            if (j == 0) { const int q = c / PT_KSPL, ks = c - q * PT_KSPL, tt = q >> 3; u.pm = 64 + tt; u.pn = q & 7; u.arow = tt == 0 ? 0 : MP + 256 * (tt - 1); u.kt0 = PT_PK * ks; u.nkt = PT_PK; return true; }
            --j; }
        if (!so.next(j, u)) return false;
        u.arow = LP * (u.pm >> 3) + NMETA + 256 * (u.pm & 7);
        return true;
    }
    __device__ __forceinline__ void a_ready(const Unit&) const {}
    __device__ __forceinline__ void done(const Unit&) const {}
};
struct EpiProj {
    static constexpr bool PERM = false, AFTER_DRAIN = false;
    bf16 *qb, *kb, *vb, *ub; float* out; const float *qn, *kn; float* slab;
    __device__ __forceinline__ void operator()(const f32x4 (&acc)[2][2][4][2], const Unit& u, int wr, int wc, int fr_, int fq_) const {
        int fr = fr_, fq = fq_; asm volatile("" : "+v"(fr), "+v"(fq));
        if (u.nkt > 0) {
            float* sl = slab + (size_t)((((u.pm - 64) * 8 + u.pn) * PT_KSPL) + u.kt0 / PT_PK) * 65536;
            const int lrow0 = wr * 64 + fr, lcol0 = wc * 32 + 4 * fq;
#pragma unroll
            for (int ai = 0; ai < 2; ++ai)
#pragma unroll
                for (int m = 0; m < 4; ++m)
#pragma unroll
                    for (int bj = 0; bj < 2; ++bj)
#pragma unroll
                        for (int n = 0; n < 2; ++n) *(f32x4*)(sl + (size_t)(lrow0 + ai * HALF + m * 16) * 256 + lcol0 + bj * HALF + n * 16) = acc[ai][bj][m][n];
            return;
        }
        const int tt = u.pn >> 1, half = u.pn & 1;
        const int row0 = u.arow + wr * 64 + fr;
        if (tt < 2) {
            const float* gsrc = (tt == 0 ? qn : kn) + (wc & 1) * 64 + 4 * fq;
            const float sc = (tt == 0) ? QSCALE : 1.0f;
            f32x4 gv[2][2];
#pragma unroll
            for (int bj = 0; bj < 2; ++bj)
#pragma unroll
                for (int n = 0; n < 2; ++n) gv[bj][n] = *(const f32x4*)(gsrc + 32 * bj + 16 * n) * sc;
            bf16* dstb = (tt == 0) ? qb : kb;
            const int colL = 256 * half + 64 * wc + 4 * fq;
#pragma unroll
            for (int ai = 0; ai < 2; ++ai)
#pragma unroll
                for (int m = 0; m < 4; ++m) {
                    float ss = 0.f;
#pragma unroll
                    for (int bj = 0; bj < 2; ++bj)
#pragma unroll
                        for (int n = 0; n < 2; ++n) { const f32x4 x = acc[ai][bj][m][n]; ss += (x[0] * x[0] + x[1] * x[1]) + (x[2] * x[2] + x[3] * x[3]); }
                    ss += __shfl_xor(ss, 16); ss += __shfl_xor(ss, 32);
                    const float r = rsqrtf(ss * (1.0f / 64.0f) + EPS);
                    const int row = row0 + ai * HALF + m * 16;
                    float* fo = (tt == 1) ? out + O_KP + (size_t)row * 512 : nullptr;
#pragma unroll
                    for (int bj = 0; bj < 2; ++bj)
#pragma unroll
                        for (int n = 0; n < 2; ++n) { const f32x4 v = (acc[ai][bj][m][n] * r) * gv[bj][n]; const int col = colL + 32 * bj + 16 * n;
                            v2u w; w.x = pk2(v[0], v[1]); w.y = pk2(v[2], v[3]); *(v2u*)(dstb + (size_t)row * 512 + col) = w;
                            if (fo) *(f32x4*)(fo + col) = v; }
                }
        } else {
            bf16* dstb = (tt == 2) ? vb : ub;
            const int col0 = 256 * half + 32 * wc + 4 * fq;
#pragma unroll
            for (int ai = 0; ai < 2; ++ai)
#pragma unroll
                for (int m = 0; m < 4; ++m) {
                    const int row = row0 + ai * HALF + m * 16;
                    float* fo = (tt == 2) ? out + O_VP + (size_t)row * 512 : nullptr;
#pragma unroll
                    for (int bj = 0; bj < 2; ++bj)
#pragma unroll
                        for (int n = 0; n < 2; ++n) { const f32x4 v = acc[ai][bj][m][n]; const int col = col0 + 128 * bj + 16 * n;
                            v2u w; w.x = pk2(v[0], v[1]); w.y = pk2(v[2], v[3]); *(v2u*)(dstb + (size_t)row * 512 + col) = w;
                            if (fo) *(f32x4*)(fo + col) = v; }
                }
        }
    }
};
__device__ __forceinline__ void proj_tail_reduce(Frame& F, const float* slab) {
    int lane_ = F.lane; asm volatile("" : "+v"(lane_));
    const int lane = lane_;
    const int gw = (int)blockIdx.x * 8 + F.wave, NGW = F.G * 8;
    for (int it = gw; it < (NMETA + MS) * 8; it += NGW) {
        const int rr = it >> 3, pn = it & 7, tt = pn >> 1, half = pn & 1;
        const bool meta = rr < NMETA;
        const int tl = meta ? 0 : 1 + ((rr - NMETA) >> 8), lr = meta ? rr : ((rr - NMETA) & 255);
        const int L = 4 * lane;
        const int phys = (tt < 2) ? 128 * ((L >> 5) & 1) + 32 * (L >> 6) + (L & 31) : L;
        const float* sl = slab + (size_t)((tl * 8 + pn) * PT_KSPL) * 65536 + (size_t)lr * 256 + phys;
        f32x4 v = *(const f32x4*)sl;
#pragma unroll
        for (int k = 1; k < PT_KSPL; ++k) v += *(const f32x4*)(sl + (size_t)k * 65536);
        if (tt < 2) {
            float ss = (v[0] * v[0] + v[1] * v[1]) + (v[2] * v[2] + v[3] * v[3]);
            ss += __shfl_xor(ss, 1); ss += __shfl_xor(ss, 2); ss += __shfl_xor(ss, 4); ss += __shfl_xor(ss, 8);
            const float r = rsqrtf(ss * (1.0f / 64.0f) + EPS);
            const f32x4 g = *(const f32x4*)((tt == 0 ? F.in[I_QN] : F.in[I_KN]) + (L & 127));
            v = (v * r) * g; if (tt == 0) v = v * QSCALE;
        }
        const int col = 256 * half + L;
        bf16* dstb = tt == 0 ? F.QB : tt == 1 ? F.KB : tt == 2 ? F.VB : F.UB;
        v2u w; w.x = pk2(v[0], v[1]); w.y = pk2(v[2], v[3]);
        const int nrep = meta ? NB : 1;
        for (int b = 0; b < nrep; ++b) {
            const int row = meta ? b * LP + rr : MP + (rr - NMETA);
            *(v2u*)(dstb + (size_t)row * 512 + col) = w;
            if (tt == 1 || tt == 2) { float* fo = meta ? F.out + (tt == 1 ? O_KP : O_VP) + (size_t)row * 512 : F.out + (tt == 1 ? O_KS : O_VS) + (size_t)(rr - NMETA) * 512; *(f32x4*)(fo + col) = v; }
        }
    }
}

struct EpiGlu {
    static constexpr bool PERM = false, AFTER_DRAIN = false;
    const bf16* gb; bf16* mix; const float* bias;
    __device__ __forceinline__ void operator()(const f32x4 (&acc)[2][2][4][2], const Unit& u, int wr, int wc, int fr, int fq) const {
        const int row0 = u.pm * BM + wr * 64 + fr, col0 = u.pn * BM + wc * 32 + 4 * fq;
        f32x4 bv[2][2];
#pragma unroll
        for (int bj = 0; bj < 2; ++bj)
#pragma unroll
            for (int n = 0; n < 2; ++n) bv[bj][n] = *(const f32x4*)(bias + col0 + bj * HALF + n * 16);
#pragma unroll
        for (int ai = 0; ai < 2; ++ai)
#pragma unroll
            for (int m = 0; m < 4; ++m) { const int row = row0 + ai * HALF + m * 16;
#pragma unroll
                for (int bj = 0; bj < 2; ++bj)
#pragma unroll
                    for (int n = 0; n < 2; ++n) { const int col = col0 + bj * HALF + n * 16;
                        const f32x4 z = acc[ai][bj][m][n] + bv[bj][n];
                        const v2u gw = *(const v2u*)(gb + (size_t)row * 512 + col);
                        float gg[4] = { bf2f((unsigned short)(gw.x & 0xffffu)), bf2f((unsigned short)(gw.x >> 16)), bf2f((unsigned short)(gw.y & 0xffffu)), bf2f((unsigned short)(gw.y >> 16)) };
                        float o[4];
#pragma unroll
                        for (int e = 0; e < 4; ++e) o[e] = gg[e] * __builtin_amdgcn_rcpf(1.0f + __builtin_amdgcn_exp2f(-1.4426950408889634f * z[e]));
                        v2u w; w.x = pk2(o[0], o[1]); w.y = pk2(o[2], o[3]); *(v2u*)(mix + (size_t)row * DM + 512 + col) = w; }
            }
    }
};

constexpr int OT_KSPL = 4, OT_PK = 4, OT_NPART = 12 * OT_KSPL;
struct OutOrder {
    pg8::StaticOrder so; int c;
    __device__ void init(int G, int c_) { so.init(64 * 256, DM, G, c_); c = c_; }
    __device__ bool next(int i, Unit& u) const {
        int j = i;
        if (c < OT_NPART) {
            if (j == 0) { const int q = c / OT_KSPL, ks = c - q * OT_KSPL, tt = q >> 2; u.pm = 64 + tt; u.pn = q & 3; u.arow = tt == 0 ? 0 : MP + 256 * (tt - 1); u.kt0 = OT_PK * ks; u.nkt = OT_PK; return true; }
            --j; }
        if (!so.next(j, u)) return false;
        u.arow = LP * (u.pm >> 3) + NMETA + 256 * (u.pm & 7);
        return true;
    }
    __device__ __forceinline__ void a_ready(const Unit&) const {}
    __device__ __forceinline__ void done(const Unit&) const {}
};
struct EpiOut {
    static constexpr bool PERM = false, AFTER_DRAIN = false;
    const float* xp; bf16* x1b; float* rowss; float* slab;
    __device__ __forceinline__ void operator()(const f32x4 (&acc)[2][2][4][2], const Unit& u, int wr, int wc, int fr_, int fq_) const {
        int fr = fr_, fq = fq_; asm volatile("" : "+v"(fr), "+v"(fq));
        const int lrow0 = wr * 64 + fr, lcol0 = wc * 32 + 4 * fq;
        if (u.nkt > 0) {
            float* sl = slab + (size_t)((((u.pm - 64) * 4 + u.pn) * OT_KSPL) + u.kt0 / OT_PK) * 65536;
#pragma unroll
            for (int ai = 0; ai < 2; ++ai)
#pragma unroll
                for (int m = 0; m < 4; ++m)
#pragma unroll
                    for (int bj = 0; bj < 2; ++bj)
#pragma unroll
                        for (int n = 0; n < 2; ++n) *(f32x4*)(sl + (size_t)(lrow0 + ai * HALF + m * 16) * 256 + lcol0 + bj * HALF + n * 16) = acc[ai][bj][m][n];
            return;
        }
        const int col0 = u.pn * BM + lcol0;
        const float* xs_ = xp + ((size_t)(u.pm >> 3) * SEQ + 256 * (u.pm & 7)) * DM;
#pragma unroll
        for (int ai = 0; ai < 2; ++ai)
#pragma unroll
            for (int m = 0; m < 4; ++m) { const int lr = lrow0 + ai * HALF + m * 16, row = u.arow + lr;
                float ss = 0.f;
#pragma unroll
                for (int bj = 0; bj < 2; ++bj)
#pragma unroll
                    for (int n = 0; n < 2; ++n) { const int col = col0 + bj * HALF + n * 16;
                        const f32x4 v = acc[ai][bj][m][n] + *(const f32x4*)(xs_ + (size_t)lr * DM + col);
                        ss += (v[0] * v[0] + v[1] * v[1]) + (v[2] * v[2] + v[3] * v[3]);
                        v2u w; w.x = pk2(v[0], v[1]); w.y = pk2(v[2], v[3]); *(v2u*)(x1b + (size_t)row * DM + col) = w; }
                ss += __shfl_xor(ss, 16); ss += __shfl_xor(ss, 32);
                if (fq == 0) atomicAdd(rowss + row, ss);
            }
    }
};
__device__ __forceinline__ void out_tail_reduce(Frame& F, const float* slab) {
    int lane_ = F.lane; asm volatile("" : "+v"(lane_));
    const int lane = lane_;
    const int gw = (int)blockIdx.x * 8 + F.wave, NGW = F.G * 8;
    for (int rr = gw; rr < NMETA + MS; rr += NGW) {
        const bool meta = rr < NMETA;
        const int tt = meta ? 0 : 1 + ((rr - NMETA) >> 8), lr = meta ? rr : ((rr - NMETA) & 255);
        const float* xsrc = meta ? F.in[I_META] + (size_t)rr * DM : F.in[I_XS] + (size_t)(rr - NMETA) * DM;
        f32x4 v[4]; float ss = 0.f;
#pragma unroll
        for (int j = 0; j < 4; ++j) { const int c = 256 * j + 4 * lane;
            f32x4 s = *(const f32x4*)(xsrc + c);
            const float* sl = slab + (size_t)((tt * 4 + j) * OT_KSPL) * 65536 + (size_t)lr * 256 + 4 * lane;
#pragma unroll
            for (int k = 0; k < OT_KSPL; ++k) s += *(const f32x4*)(sl + (size_t)k * 65536);
            v[j] = s; ss += (s[0] * s[0] + s[1] * s[1]) + (s[2] * s[2] + s[3] * s[3]); }
        ss = wave_sum(ss);
        const int nrep = meta ? NB : 1;
        for (int b = 0; b < nrep; ++b) { const int row = meta ? b * LP + rr : MP + (rr - NMETA);
#pragma unroll
            for (int j = 0; j < 4; ++j) { v2u w; w.x = pk2(v[j][0], v[j][1]); w.y = pk2(v[j][2], v[j][3]); *(v2u*)(F.XN + (size_t)row * DM + 256 * j + 4 * lane) = w; }
            if (lane == 0) F.ROWSS[row] = ss; }
    }
}

__device__ __forceinline__ float dpp_ror1(float v) { return __builtin_bit_cast(float, __builtin_amdgcn_mov_dpp(__builtin_bit_cast(int, v), 0x121, 0xf, 0xf, false)); }
__device__ __forceinline__ float dpp_ror2(float v) { return __builtin_bit_cast(float, __builtin_amdgcn_mov_dpp(__builtin_bit_cast(int, v), 0x122, 0xf, 0xf, false)); }
__device__ __forceinline__ f32x2 gelu_mul_pk(f32x2 x, f32x2 c) {
    const f32x2 x2 = x * x, t = x2 * 0.044715f + 1.0f, z = (x * t) * (-2.0f * 0.7978845608028654f * 1.4426950408889634f);
    f32x2 e; e.x = __builtin_amdgcn_exp2f(z.x); e.y = __builtin_amdgcn_exp2f(z.y);
    const f32x2 d = e + 1.0f; f32x2 r; r.x = __builtin_amdgcn_rcpf(d.x); r.y = __builtin_amdgcn_rcpf(d.y);
    return (x * r) * c;
}
constexpr int MT2 = 68, MSTEP2 = 254;
struct EpiGateUp {
    static constexpr bool PERM = false, AFTER_DRAIN = false;
    const float* rowss; bf16* hb; float* out; const float *cw, *cb; const bf16* ehist; LAS float* xch;
    __device__ __forceinline__ void operator()(const f32x4 (&acc)[2][2][4][2], const Unit& u, int wr, int wc, int fr, int fq) const {
#ifdef PROBE_EPI
        LAS unsigned long long* pst = (LAS unsigned long long*)(xch + 2048); int pcnt = (int)pst[15];
        if (blockIdx.x == 0 && wr == 0 && wc == 0 && fr == 0 && fq == 0 && pcnt < 6) { pst[pcnt] = __builtin_amdgcn_s_memrealtime(); pst[15] = pcnt + 1; }
#endif
        const int trow0 = wr * 64 + fr;
        const int grow0 = u.pm * MSTEP2 - 2 + trow0;
        const int colw = wc * 32 + 4 * fq;
        const int col0 = u.pn * 128 + colw;
#pragma unroll
        for (int ai = 0; ai < 2; ++ai) { int R = grow0 + ai * HALF + 48; R = R < 0 ? 0 : (R >= MPAD ? MPAD - 1 : R);
            const float rs = rsqrtf(rowss[R] * (1.0f / DM) + EPS);
            if (fr >= 14) {
#pragma unroll
                for (int n = 0; n < 2; ++n) *(LAS f32x4*)(xch + ((ai * 2 + wr) * 2 + (fr - 14)) * 128 + colw + 16 * n) = acc[ai][0][3][n] * rs; } }
        asm volatile("s_waitcnt lgkmcnt(0)" ::: "memory"); __builtin_amdgcn_s_barrier(); asm volatile("" ::: "memory");
        f32x4 w0[2], w1[2], w2[2], bb[2];
#pragma unroll
        for (int n = 0; n < 2; ++n) { w0[n] = *(const f32x4*)(cw + col0 + 16 * n); w1[n] = *(const f32x4*)(cw + FF + col0 + 16 * n); w2[n] = *(const f32x4*)(cw + 2 * FF + col0 + 16 * n); bb[n] = *(const f32x4*)(cb + col0 + 16 * n); }
#pragma unroll
        for (int ai = 0; ai < 2; ++ai) {
            v2u eh[4][2];
#pragma unroll
            for (int m = 0; m < 4; ++m) { const int R = grow0 + ai * HALF + m * 16; const bool smp = (R >= MP) && (R < MV) && (((R - MP) & 3) < 2);
                const bf16* ep = ehist + ((size_t)(smp ? (R - MP) >> 2 : 0) * 2 + (smp ? (R - MP) & 1 : 0)) * FF + col0;
#pragma unroll
                for (int n = 0; n < 2; ++n) eh[m][n] = smp ? *(const v2u*)(ep + 16 * n) : (v2u){0u, 0u}; }
            f32x4 pr1[2], pr2[2];
            {   const bool hasprev = !(ai == 0 && wr == 0);
                const int pg = (wr == 1) ? (ai * 2) : ((ai - 1) * 2 + 1);
#pragma unroll
                for (int n = 0; n < 2; ++n) { f32x4 x62 = (f32x4){0.f, 0.f, 0.f, 0.f}, x63 = x62;
                    if (hasprev) { x62 = *(const LAS f32x4*)(xch + (pg * 2 + 0) * 128 + colw + 16 * n); x63 = *(const LAS f32x4*)(xch + (pg * 2 + 1) * 128 + colw + 16 * n); }
                    pr1[n] = x63; pr2[n] = (fr == 0) ? x62 : x63; } }
#pragma unroll
            for (int m = 0; m < 4; ++m) {
                const int trow = trow0 + ai * HALF + m * 16, R = grow0 + ai * HALF + m * 16;
                const int Rc = R < 0 ? 0 : (R >= MPAD ? MPAD - 1 : R);
                const float rs = rsqrtf(rowss[Rc] * (1.0f / DM) + EPS);
                int t = 2; float* fo = nullptr;
                if (Rc < MP) { const int b = Rc / LP; t = Rc - b * LP; if (t >= LP - 2) fo = out + O_CP + (size_t)(b * 2 + (t - (LP - 2))) * FF; }
                else if (Rc < MV) { const int db = (Rc - MP) >> 2; t = (Rc - MP) & 3; if (t >= 2) fo = out + O_CS + (size_t)(db * 2 + (t - 2)) * FF; }
                const bool store = (trow >= 2) && (R < MPAD);
                const float k1 = (t == 0) ? 0.f : 1.f, k2 = (t < 2) ? 0.f : 1.f;
                bf16* hrow = hb + (size_t)(store ? R : 0) * FF + col0;
#pragma unroll
                for (int n = 0; n < 2; ++n) {
                    const f32x4 a0 = acc[ai][0][m][n] * rs, c = acc[ai][1][m][n] * rs;
                    f32x4 r1, r2;
#pragma unroll
                    for (int e = 0; e < 4; ++e) { r1[e] = dpp_ror1(a0[e]); r2[e] = dpp_ror2(a0[e]); }
                    f32x4 a1, a2;
#pragma unroll
                    for (int e = 0; e < 4; ++e) { a1[e] = (fr >= 1) ? r1[e] : pr1[n][e]; a2[e] = (fr >= 2) ? r2[e] : pr2[n][e]; }
                    pr1[n] = r1; pr2[n] = r2;
                    const v2u ew = eh[m][n];
                    const f32x2 w0a = (f32x2){w0[n][0], w0[n][1]} * k2, w0b = (f32x2){w0[n][2], w0[n][3]} * k2, w1a = (f32x2){w1[n][0], w1[n][1]} * k1, w1b = (f32x2){w1[n][2], w1[n][3]} * k1;
                    f32x2 cva = (f32x2){bb[n][0], bb[n][1]} + (f32x2){ __builtin_bit_cast(float, ew.x << 16), __builtin_bit_cast(float, ew.x & 0xffff0000u) };
                    f32x2 cvb = (f32x2){bb[n][2], bb[n][3]} + (f32x2){ __builtin_bit_cast(float, ew.y << 16), __builtin_bit_cast(float, ew.y & 0xffff0000u) };
                    cva = w0a * (f32x2){a2[0], a2[1]} + cva; cvb = w0b * (f32x2){a2[2], a2[3]} + cvb;
                    cva = w1a * (f32x2){a1[0], a1[1]} + cva; cvb = w1b * (f32x2){a1[2], a1[3]} + cvb;
                    cva = (f32x2){w2[n][0], w2[n][1]} * (f32x2){a0[0], a0[1]} + cva; cvb = (f32x2){w2[n][2], w2[n][3]} * (f32x2){a0[2], a0[3]} + cvb;
                    const f32x2 oa = gelu_mul_pk(cva, (f32x2){c[0], c[1]}), ob = gelu_mul_pk(cvb, (f32x2){c[2], c[3]});
                    v2u w; w.x = pk2(oa.x, oa.y); w.y = pk2(ob.x, ob.y);
                    if (store) *(v2u*)(hrow + 16 * n) = w;
                    if (store && fo) *(f32x4*)(fo + col0 + 16 * n) = a0;
                }
            }
        }
#ifdef PROBE_EPI
        { int pcnt2 = (int)pst[15]; if (blockIdx.x == 0 && wr == 0 && wc == 0 && fr == 0 && fq == 0 && pcnt2 < 6) { asm volatile("s_waitcnt vmcnt(0) lgkmcnt(0)" ::: "memory"); pst[pcnt2] = __builtin_amdgcn_s_memrealtime(); pst[15] = pcnt2 + 1; } }
#endif
    }
};

constexpr int DT_KSPL = 11, DT_PK = 4, DT_NPART = 8 * DT_KSPL;
struct DownOrder {
    pg8::StaticOrder so; int c;
    __device__ void init(int G, int c_) { so.init(64 * 256, DM, G, c_); c = c_; }
    __device__ bool next(int i, Unit& u) const {
        int j = i;
        if (c < DT_NPART) {
            if (j == 0) { const int q = c / DT_KSPL, ks = c - q * DT_KSPL; u.pm = 64 + (q >> 2); u.pn = q & 3; u.arow = MP + 256 * (q >> 2); u.kt0 = DT_PK * ks; u.nkt = DT_PK; return true; }
            --j; }
        if (!so.next(j, u)) return false;
        u.arow = LP * (u.pm >> 3) + NMETA + 256 * (u.pm & 7);
        return true;
    }
    __device__ __forceinline__ void a_ready(const Unit&) const {}
    __device__ __forceinline__ void done(const Unit&) const {}
};
struct EpiDown {
    static constexpr bool PERM = false, AFTER_DRAIN = false;
    const bf16* x1b; float* out; float* slab;
    __device__ __forceinline__ void operator()(const f32x4 (&acc)[2][2][4][2], const Unit& u, int wr, int wc, int fr_, int fq_) const {
        int fr = fr_, fq = fq_; asm volatile("" : "+v"(fr), "+v"(fq));
        const int lrow0 = wr * 64 + fr, lcol0 = wc * 32 + 4 * fq;
        if (u.nkt > 0) {
            float* sl = slab + (size_t)((((u.pm - 64) * 4 + u.pn) * DT_KSPL) + u.kt0 / DT_PK) * 65536;
#pragma unroll
            for (int ai = 0; ai < 2; ++ai)
#pragma unroll
                for (int m = 0; m < 4; ++m)
#pragma unroll
                    for (int bj = 0; bj < 2; ++bj)
#pragma unroll
                        for (int n = 0; n < 2; ++n) *(f32x4*)(sl + (size_t)(lrow0 + ai * HALF + m * 16) * 256 + lcol0 + bj * HALF + n * 16) = acc[ai][bj][m][n];
            return;
        }
        const int col0 = u.pn * BM + lcol0;
        float* yo = out + O_YP + ((size_t)(u.pm >> 3) * SEQ + 256 * (u.pm & 7)) * DM;
#pragma unroll
        for (int ai = 0; ai < 2; ++ai)
#pragma unroll
            for (int m = 0; m < 4; ++m) { const int lr = lrow0 + ai * HALF + m * 16;
#pragma unroll
                for (int bj = 0; bj < 2; ++bj)
#pragma unroll
                    for (int n = 0; n < 2; ++n) { const int col = col0 + bj * HALF + n * 16;
                        *(f32x4*)(yo + (size_t)lr * DM + col) = acc[ai][bj][m][n] + ld_bf4(x1b + (size_t)(u.arow + lr) * DM + col); }
            }
    }
};
__device__ __forceinline__ void down_tail_reduce(Frame& F, const float* slab) {
    const int gt = (int)blockIdx.x * 512 + F.tid, NT = F.G * 512;
    for (int e = gt; e < MS * DM / 4; e += NT) {
        const int r = e >> 8, c = (e & 255) * 4;
        const float* sl = slab + (size_t)(((r >> 8) * 4 + (c >> 8)) * DT_KSPL) * 65536 + (size_t)(r & 255) * 256 + (c & 255);
        f32x4 s = ld_bf4(F.XN + (size_t)(MP + r) * DM + c);
#pragma unroll
        for (int k = 0; k < DT_KSPL; ++k) s += *(const f32x4*)(sl + (size_t)k * 65536);
        *(f32x4*)(F.out + O_YS + (size_t)r * DM + c) = s;
    }
}

typedef LAS const char* lds_cptr;
__device__ __forceinline__ unsigned off_b(unsigned row, unsigned ch) { return 256u * row + 16u * (ch ^ (((row & 3u) << 2) | ((row >> 2) & 3u))); }
__device__ __forceinline__ s16x4 vtr(lds_cptr p) { return __builtin_bit_cast(s16x4, __builtin_amdgcn_ds_read_tr16_b64_v4i16((LAS s16x4*)p)); }
__device__ __forceinline__ void glds16(const void* gsrc, unsigned lds_dst) { unsigned keep;
    asm volatile("s_mov_b32 %0, m0\n\ts_mov_b32 m0, %2\n\ts_nop 0\n\tglobal_load_lds_dwordx4 %1, off\n\ts_mov_b32 m0, %0" : "=&s"(keep) : "v"(gsrc), "s"(lds_dst) : "memory"); }
__device__ __forceinline__ int crow(int r, int hi) { return (r & 3) + 8 * (r >> 2) + 4 * hi; }
#define MFMA32(a, b, c) __builtin_amdgcn_mfma_f32_32x32x16_bf16((a), (b), (c), 0, 0, 0)
#define MFMA16(a, b, c) __builtin_amdgcn_mfma_f32_16x16x32_bf16((a), (b), (c), 0, 0, 0)

constexpr int ATT_K = 0, ATT_V = 32768, ATT_WS = 65536, ATT_Q = 67584;
__device__ __forceinline__ void attn_unit(Frame& F, int b, int h, int qi) {
    int lane_ = F.lane; asm volatile("" : "+v"(lane_));
    const int lane = lane_, w = F.wave, r32 = lane & 31, hi = lane >> 5;
    const int rowb = b * LP;
    const int Q0 = NMETA + 256 * qi + 32 * w;
    const int NT = 4 * qi + 5;
    LAS unsigned char* lds = F.lds;
    { LAS unsigned char* Qw = lds + ATT_Q + 8192 * w + 16 * lane; const bf16* qp = F.QB + ((long)(rowb + Q0 + r32)) * 512 + h * 128 + hi * 8;
#pragma unroll
      for (int ks = 0; ks < 8; ++ks) *(LAS v4u*)(Qw + 1024 * ks) = *(const v4u*)(qp + ks * 16); }
    f32x16 o0[4], o1[4];
#pragma unroll
    for (int c = 0; c < 4; ++c) { o0[c] = (f32x16){}; o1[c] = (f32x16){}; }
    float l0 = 0.f, l1 = 0.f;
    const unsigned ldsb = (unsigned)(uintptr_t)lds;
    const char* kg = (const char*)(F.KB + (size_t)rowb * 512 + h * 128);
    const char* vg = (const char*)(F.VB + (size_t)rowb * 512 + h * 128);
#define ATT_STAGE(j, buf) do { const char* kt_ = kg + (size_t)(64 * (j)) * 1024; const char* vt_ = vg + (size_t)(64 * (j)) * 1024; unsigned ln_ = lane; asm volatile("" : "+v"(ln_)); \
        _Pragma("unroll") for (int i_ = 0; i_ < 2; ++i_) { const unsigned row_ = 4u * (w + 8 * i_) + (ln_ >> 4), ch_ = (ln_ & 15) ^ (((row_ & 3u) << 2) | ((row_ >> 2) & 3u)); \
        const unsigned vr_ = (row_ & ~12u) | ((row_ & 4u) << 1) | ((row_ & 8u) >> 1); \
        glds16(kt_ + (row_ * 1024u + ch_ * 16u), (unsigned)__builtin_amdgcn_readfirstlane(ldsb + ATT_K + (buf) * 16384 + (w + 8 * i_) * 1024)); \
        glds16(vt_ + (vr_ * 1024u + ch_ * 16u), (unsigned)__builtin_amdgcn_readfirstlane(ldsb + ATT_V + (buf) * 16384 + (w + 8 * i_) * 1024)); } } while (0)
    ATT_STAGE(0, 0); VM_WAIT(); __syncthreads();
    for (int j = 0; j < NT; ++j) {
        const int buf = j & 1;
        if (j + 1 < NT) ATT_STAGE(j + 1, buf ^ 1);
        if (64 * j <= Q0 + 31) {
            const LAS unsigned char* Kb = lds + ATT_K + buf * 16384; const LAS unsigned char* Vb = lds + ATT_V + buf * 16384;
            const bool needmask = (64 * j + 63 > Q0);
            unsigned ln = lane; asm volatile("" : "+v"(ln));
            const unsigned r32v = ln & 31u, hiv = ln >> 5, blk = (ln >> 4) & 1u, qq = (ln & 15u) >> 2, pp = ln & 3u;
            const unsigned kra = off_b(r32v, hiv);
            const unsigned vba = off_b(8 * hiv + qq, 2 * blk + (pp >> 1)) + 8 * (pp & 1), vbb = off_b(8 * hiv + 4 + qq, 2 * blk + (pp >> 1)) + 8 * (pp & 1);
            const LAS unsigned char* Qw = lds + ATT_Q + 8192 * w + 16 * ln;
            const int qpos = Q0 + (int)r32v;
            bf16x8 pk0[4], pk1[4];
#define PK8(X, B) __builtin_bit_cast(bf16x8, (v4u){ cvtpk(X[B], X[B + 1]), cvtpk(X[B + 2], X[B + 3]), cvtpk(X[B + 4], X[B + 5]), cvtpk(X[B + 6], X[B + 7]) })
#define ATT_QK(KS0, HALF_, PK, LACC) do { f32x16 sa; \
                if (needmask) { _Pragma("unroll") for (int r = 0; r < 16; ++r) sa[r] = (64 * j + 32 * (HALF_) + crow(r, (int)hiv) > qpos) ? -1.0e30f : 0.f; } else sa = (f32x16){}; \
                _Pragma("unroll") for (int ks = (KS0); ks < (KS0) + 4; ++ks) { const bf16x8 qv = *(const LAS bf16x8*)(Qw + 1024 * ks); \
                    const bf16x8 a0 = *(const LAS bf16x8*)(Kb + 8192 * (HALF_) + (kra ^ (32u * ks))); \
                    sa = MFMA32(a0, qv, sa); } \
                __builtin_amdgcn_sched_group_barrier(0x100, 4, 0); __builtin_amdgcn_sched_group_barrier(0x008, 1, 0); __builtin_amdgcn_sched_group_barrier(0x100, 2, 0); \
                __builtin_amdgcn_sched_group_barrier(0x008, 1, 0); __builtin_amdgcn_sched_group_barrier(0x100, 2, 0); __builtin_amdgcn_sched_group_barrier(0x008, 2, 0); \
                float ls_ = 0.f; \
                _Pragma("unroll") for (int r = 0; r < 16; ++r) { sa[r] = __builtin_amdgcn_exp2f(sa[r]); ls_ += sa[r]; } \
                LACC += ls_; PK[2 * (HALF_)] = PK8(sa, 0); PK[2 * (HALF_) + 1] = PK8(sa, 8); } while (0)
            ATT_QK(0, 0, pk0, l0); __builtin_amdgcn_sched_barrier(0);
            ATT_QK(0, 1, pk0, l0); __builtin_amdgcn_sched_barrier(0);
            ATT_QK(4, 0, pk1, l1); __builtin_amdgcn_sched_barrier(0);
            ATT_QK(4, 1, pk1, l1); __builtin_amdgcn_sched_barrier(0);
#undef ATT_QK
#undef PK8
#pragma unroll
            for (int c = 0; c < 4; ++c)
#pragma unroll
                for (int ks = 0; ks < 4; ++ks) {
                    const s16x4 lo = vtr((lds_cptr)(Vb + (vba ^ (64u * c)) + 4096 * ks)), hh = vtr((lds_cptr)(Vb + (vbb ^ (64u * c)) + 4096 * ks));
                    const bf16x8 vf = (bf16x8){ lo[0], lo[1], lo[2], lo[3], hh[0], hh[1], hh[2], hh[3] };
                    o0[c] = MFMA32(pk0[ks], vf, o0[c]); o1[c] = MFMA32(pk1[ks], vf, o1[c]);
                }
            __builtin_amdgcn_sched_group_barrier(0x100, 4, 0);
#pragma unroll
            for (int i = 0; i < 14; ++i) { __builtin_amdgcn_sched_group_barrier(0x008, 2, 0); __builtin_amdgcn_sched_group_barrier(0x100, 2, 0); }
            __builtin_amdgcn_sched_group_barrier(0x008, 4, 0);
            __builtin_amdgcn_sched_barrier(0);
        }
        VM_WAIT(); __syncthreads();
    }
#undef ATT_STAGE
    const float lam = F.PAR[PA_LAM];
    l0 += __shfl_xor(l0, 32); l1 += __shfl_xor(l1, 32);
    LAS float* wsf = (LAS float*)(lds + ATT_WS) + w * 64;
    if (hi == 0) { wsf[r32] = l0; wsf[32 + r32] = l1; }
    LDS_WAIT(); asm volatile("" ::: "memory");
    const float* subn = F.in[I_SUBN];
    float sn[4];
#pragma unroll
    for (int c = 0; c < 4; ++c) sn[c] = subn[32 * c + r32] * (1.0f - LAM_INIT);
#pragma unroll
    for (int r = 0; r < 16; ++r) {
        const int qr = crow(r, hi);
        const float i0 = 1.0f / wsf[qr], i1 = lam / wsf[32 + qr];
        float v[4]; float ss = 0.f;
#pragma unroll
        for (int c = 0; c < 4; ++c) { v[c] = o0[c][r] * i0 - o1[c][r] * i1; ss += v[c] * v[c]; }
        ss += __shfl_xor(ss, 1); ss += __shfl_xor(ss, 2); ss += __shfl_xor(ss, 4); ss += __shfl_xor(ss, 8); ss += __shfl_xor(ss, 16);
        const float rn = rsqrtf(ss * (1.0f / 128.0f) + EPS);
        const int pos = Q0 + qr;
        if (pos >= 0) { bf16* dst = F.MIX + (size_t)(rowb + pos) * DM + h * 128 + r32;
#pragma unroll
            for (int c = 0; c < 4; ++c) dst[32 * c] = (bf16)f2bf(v[c] * rn * sn[c]); }
    }
    LDS_WAIT();
}

constexpr int NSL = 8, PPG = NPG / NSL;
constexpr int DEC_RED = 0, DEC_P = 0, DEC_Q = 16384;
__device__ __forceinline__ bf16x8 cvt8(const f32x4 a, const f32x4 b) { return __builtin_bit_cast(bf16x8, (v4u){ cvtpk(a[0], a[1]), cvtpk(a[2], a[3]), cvtpk(b[0], b[1]), cvtpk(b[2], b[3]) }); }
__device__ __forceinline__ f32x4 ldnt4(const float* p) { return __builtin_nontemporal_load((const f32x4*)p); }
__device__ __forceinline__ void decode_unit(Frame& F, int db, int pg) {
    int lane_ = F.lane; asm volatile("" : "+v"(lane_));
    const int lane = lane_, w = F.wave, col = lane & 15, kg = lane >> 4;
    LAS unsigned char* lds = F.lds;
    if (w < 4) {
        const int h = w;
#pragma unroll
        for (int kb = 0; kb < 4; ++kb) { v4u q = (v4u){0u, 0u, 0u, 0u};
            if (col < 8 && (col >> 2) == (kb >> 1)) q = *(const v4u*)(F.QB + (size_t)(MP + db * 4 + (col & 3)) * 512 + h * 128 + kb * 32 + kg * 8);
            *(LAS v4u*)(lds + DEC_Q + ((h * 4 + kb) * 64 + lane) * 16) = q; }
    }
    __syncthreads();
    const int hb = (w >> 2) * 2, hl = lane >> 5;
    f32x4 O[8];
#pragma unroll
    for (int c = 0; c < 8; ++c) O[c] = (f32x4){0.f, 0.f, 0.f, 0.f};
    float lsum[2] = {0.f, 0.f};
    const int* pt = (const int*)F.in[I_PT] + db * NPG + pg * PPG;
    LAS float* Pw = (LAS float*)(lds + DEC_P + 1024 * w);
    const LAS unsigned char* Qf = lds + DEC_Q + (hb * 4 * 64 + lane) * 16;
    LAS unsigned char* Kt = lds + 32768 + 8448 * w;
    const size_t koff = (size_t)(32 * (w & 3)) * 512 + hb * 128 + 4 * lane;
    const size_t voff = (size_t)(32 * (w & 3)) * 512 + hb * 128 + 4 * lane;
    f32x4 bA[16], bB[16];
#define LD_K(KP) do { _Pragma("unroll") for (int i = 0; i < 16; ++i) bA[i] = ldnt4((KP) + koff + (size_t)i * 512); } while (0)
#define LD_V(VP) do { _Pragma("unroll") for (int i = 0; i < 16; ++i) bB[i] = ldnt4((VP) + voff + (size_t)i * 512); } while (0)
    int pgid[PPG];
#pragma unroll
    for (int i = 0; i < PPG; ++i) pgid[i] = __builtin_amdgcn_readfirstlane(pt[i]);
    const int page = pgid[0];
    LD_K(F.in[I_CK] + (size_t)page * PAGE * 512);
    LD_V(F.in[I_CV] + (size_t)page * PAGE * 512);
#define DEC_BODY(GI, LOADNEXT) do { \
        const int gn = (GI) + 1; \
        const int npage = pgid[(LOADNEXT) ? (gn >> 1) : 0]; \
        const float* nkp = F.in[I_CK] + ((size_t)npage * PAGE + 16 * (gn & 1)) * 512; \
        const float* nvp = F.in[I_CV] + ((size_t)npage * PAGE + 16 * (gn & 1)) * 512; \
        f32x4 acc[2]; \
          \
        _Pragma("unroll") for (int s_ = 0; s_ < 16; ++s_) { const f32x4 kv = bA[s_]; \
            if (LOADNEXT) bA[s_] = ldnt4(nkp + koff + (size_t)s_ * 512); \
            *(LAS v2u*)(Kt + s_ * 528 + 8 * lane) = (v2u){ cvtpk(kv[0], kv[1]), cvtpk(kv[2], kv[3]) }; } \
        LDS_WAIT(); asm volatile("" ::: "memory"); \
        _Pragma("unroll") for (int hh = 0; hh < 2; ++hh) { f32x4 ac = (f32x4){0.f, 0.f, 0.f, 0.f}; \
            _Pragma("unroll") for (int kb = 0; kb < 4; ++kb) { const int i_ = hh * 4 + kb; \
                const bf16x8 a = *(const LAS bf16x8*)(Kt + col * 528 + (hh * 128 + kb * 32 + kg * 8) * 2); \
                const bf16x8 bq = *(const LAS bf16x8*)(Qf + i_ * 1024); ac = MFMA16(a, bq, ac); } \
            acc[hh] = ac; } \
        __builtin_amdgcn_sched_barrier(0); \
        if (col < 8) { \
            _Pragma("unroll") for (int hh = 0; hh < 2; ++hh) \
                _Pragma("unroll") for (int e = 0; e < 4; ++e) { const float p = __builtin_amdgcn_exp2f(acc[hh][e]); lsum[hh] += p; Pw[((4 * kg + e) * 2 + hh) * 8 + col] = p; } \
        } \
        LDS_WAIT(); asm volatile("" ::: "memory"); \
        __builtin_amdgcn_sched_barrier(0); \
        _Pragma("unroll") for (int s_ = 0; s_ < 16; ++s_) { \
            const f32x4 pa = *(const LAS f32x4*)(Pw + (s_ * 2 + hl) * 8), pb = *(const LAS f32x4*)(Pw + (s_ * 2 + hl) * 8 + 4); \
            const f32x4 vv = bB[s_]; \
            if (LOADNEXT) bB[s_] = ldnt4(nvp + voff + (size_t)s_ * 512); \
            _Pragma("unroll") for (int c = 0; c < 4; ++c) { O[c] += vv * pa[c]; O[4 + c] += vv * pb[c]; } \
        } \
        LDS_WAIT(); asm volatile("" ::: "memory"); \
        __builtin_amdgcn_sched_barrier(0); \
    } while (0)
    int ngi = 2 * PPG - 1; asm volatile("" : "+s"(ngi));
#pragma unroll 1
    for (int gi = 0; gi < ngi; ++gi) DEC_BODY(gi, true);
    DEC_BODY(2 * PPG - 1, false);
#undef DEC_BODY
#undef LD_K
#undef LD_V
    __syncthreads();
#pragma unroll
    for (int c = 0; c < 8; ++c) *(LAS f32x4*)(lds + DEC_RED + ((w * 8 + c) * 64 + lane) * 16) = O[c];
#pragma unroll
    for (int hh = 0; hh < 2; ++hh) { float l = lsum[hh]; l += __shfl_xor(l, 16); l += __shfl_xor(l, 32); if (lane < 8) ((LAS float*)(lds + 131072))[(w * 2 + hh) * 8 + lane] = l; }
    __syncthreads();
    float* slab = F.SLO + ((size_t)(db * NSL + pg)) * 4096;
#pragma unroll
    for (int k = 0; k < 2; ++k) { const int sc = 2 * w + k, set = sc >> 3, cc = sc & 7;
        f32x4 s = (f32x4){0.f, 0.f, 0.f, 0.f};
#pragma unroll
        for (int ww = 0; ww < 4; ++ww) s += *(const LAS f32x4*)(lds + DEC_RED + (((4 * set + ww) * 8 + cc) * 64 + lane) * 16);
        const int h = 2 * set + hl;
        *(f32x4*)(slab + (h * 8 + cc) * 128 + 4 * (lane & 31)) = s; }
    if (w == 0 && lane < 32) { const int h = lane >> 3, cc = lane & 7; float s = 0.f;
#pragma unroll
        for (int ww = 0; ww < 4; ++ww) s += ((const LAS float*)(lds + 131072))[((4 * (h >> 1) + ww) * 2 + (h & 1)) * 8 + cc];
        F.SLL[(size_t)(db * NSL + pg) * 32 + lane] = s; }
    __syncthreads();
}

__device__ __forceinline__ void decode_final(Frame& F, int db, int h, int tq) {
    int lane_ = F.lane; asm volatile("" : "+v"(lane_));
    const int lane = lane_;
    const float lam = F.PAR[PA_LAM];
    const int rbase = MP + db * 4;
    f32x2 sl[2][NSL]; float ll[2][NSL];
#pragma unroll
    for (int c = 0; c < 2; ++c)
#pragma unroll
        for (int pg = 0; pg < NSL; ++pg) { const int cc = 4 * c + tq;
            sl[c][pg] = *(const f32x2*)(F.SLO + ((size_t)(db * NSL + pg) * 32 + h * 8 + cc) * 128 + 2 * lane); ll[c][pg] = F.SLL[(size_t)(db * NSL + pg) * 32 + h * 8 + cc]; }
    float qv[2], kv[2][4], vn0[4], vn1[4];
#pragma unroll
    for (int c = 0; c < 2; ++c) { qv[c] = bf2f(F.QB[(size_t)(rbase + tq) * 512 + h * 128 + c * 64 + lane]);
#pragma unroll
        for (int j = 0; j < 4; ++j) kv[c][j] = bf2f(F.KB[(size_t)(rbase + (j <= tq ? j : tq)) * 512 + h * 128 + c * 64 + lane]); }
#pragma unroll
    for (int j = 0; j < 4; ++j) { const unsigned vw = *(const unsigned*)(F.VB + (size_t)(rbase + (j <= tq ? j : tq)) * 512 + h * 128 + 2 * lane); vn0[j] = bf2f((unsigned short)(vw & 0xffffu)); vn1[j] = bf2f((unsigned short)(vw >> 16)); }
    const float sn0 = F.in[I_SUBN][2 * lane] * (1.0f - LAM_INIT), sn1 = F.in[I_SUBN][2 * lane + 1] * (1.0f - LAM_INIT);
    float o[2][2], l[2];
#pragma unroll
    for (int c = 0; c < 2; ++c) { float a0 = 0.f, a1 = 0.f, ls = 0.f;
#pragma unroll
        for (int pg = 0; pg < NSL; ++pg) { a0 += sl[c][pg].x; a1 += sl[c][pg].y; ls += ll[c][pg]; }
#pragma unroll
        for (int j = 0; j < 4; ++j) { const float p = (j <= tq) ? __builtin_amdgcn_exp2f(wave_sum(qv[c] * kv[c][j])) : 0.f;
            ls += p; a0 += p * vn0[j]; a1 += p * vn1[j]; }
        o[c][0] = a0; o[c][1] = a1; l[c] = ls; }
    const float i0 = 1.0f / l[0], i1 = lam / l[1];
    const float y0 = o[0][0] * i0 - o[1][0] * i1, y1 = o[0][1] * i0 - o[1][1] * i1;
    const float rn = rsqrtf(wave_sum(y0 * y0 + y1 * y1) * (1.0f / 128.0f) + EPS);
    *(unsigned*)(F.MIX + (size_t)(rbase + tq) * DM + h * 128 + 2 * lane) = pk2(y0 * rn * sn0, y1 * rn * sn1);
}

constexpr int SSM_LE = 131072, SSM_CF = 139264, SSM_HP = 136;
__device__ __forceinline__ void ssm_unit(Frame& F, int b, int g) {
    int lane_ = F.lane; asm volatile("" : "+v"(lane_));
    const int lane = lane_, w = F.wave, r32 = lane & 31, hi = lane >> 5;
    LAS unsigned char* lds = F.lds;
    LAS float* X = (LAS float*)(lds + 16384 * w);
    LAS unsigned short* Hb = (LAS unsigned short*)(lds + 16384 * w);
    LAS float* LE = (LAS float*)(lds + SSM_LE);
    const int rowb = b * LP;
    const float ar = F.PAR[PA_ABR + g * 64 + lane], ai = F.PAR[PA_ABI + g * 64 + lane];
    float a32r = ar, a32i = ai;
#pragma unroll
    for (int i = 0; i < 5; ++i) { const float nr = a32r * a32r - a32i * a32i, ni = 2.0f * a32r * a32i; a32r = nr; a32i = ni; }
    bf16x8 Bf[2][2];
#pragma unroll
    for (int ri = 0; ri < 2; ++ri)
#pragma unroll
        for (int nb = 0; nb < 2; ++nb) { const float* s = F.PAR + (ri ? PA_BBI : PA_BBR) + ((g * 64 + 32 * nb + r32) * 16 + 8 * hi);
            Bf[ri][nb] = cvt8(*(const f32x4*)s, *(const f32x4*)(s + 4)); }
    const int cfl = (r32 & 15) | (hi << 4);
    if (w == 0 && r32 < 16) {
#pragma unroll
        for (int s = 0; s < 8; ++s) { const float* src = (s < 4 ? F.in[I_CRE] : F.in[I_CIM]) + ((size_t)(g * 16 + r32) * 64 + 16 * (s & 3) + 8 * hi);
            f32x4 x0 = *(const f32x4*)src, x1 = *(const f32x4*)(src + 4); if (s >= 4) { x0 = -x0; x1 = -x1; }
            *(LAS bf16x8*)(lds + SSM_CF + (s * 32 + cfl) * 16) = cvt8(x0, x1); }
    }
    __syncthreads();
    const float dsk = (r32 < 16) ? F.in[I_DSK][g * 16 + r32] : 0.f;
    float cr = 0.f, ci = 0.f;
    const bf16* ubase = F.UB + (size_t)(rowb + r32) * 512 + 16 * g + 8 * hi;
    bf16x8 Anext = *(const bf16x8*)(ubase + (size_t)(32 * w) * 512);
    LAS unsigned short* Ut = (LAS unsigned short*)(lds + 16384 * w + 9216);
    LAS unsigned short* Gt = (LAS unsigned short*)(lds + 16384 * w + 10240);
    for (int it = 0; it < 9; ++it) {
        const int ck = 8 * it + w, t0 = 32 * ck;
        const bool active = ck < 65;
        const bf16x8 A = Anext;
        { int ckn = ck + 8; ckn = ckn > 64 ? 64 : ckn; Anext = *(const bf16x8*)(ubase + (size_t)(32 * ckn) * 512); }
        float hlr[32], hli[32];
        float er = 0.f, ei = 0.f;
        if (active) {
            const f32x16 z = (f32x16){};
            const f32x16 xr0 = MFMA32(A, Bf[0][0], z), xr1 = MFMA32(A, Bf[0][1], z), xi0 = MFMA32(A, Bf[1][0], z), xi1 = MFMA32(A, Bf[1][1], z);
#pragma unroll
            for (int r = 0; r < 16; ++r) { const int t = crow(r, hi);
                X[t * 64 + r32] = xr0[r]; X[t * 64 + 32 + r32] = xr1[r]; X[2048 + t * 64 + r32] = xi0[r]; X[2048 + t * 64 + 32 + r32] = xi1[r]; }
            LDS_WAIT(); asm volatile("" ::: "memory");
#pragma unroll
            for (int t = 0; t < 32; ++t) { const float xr = X[t * 64 + lane], xi = X[2048 + t * 64 + lane];
                const float nr = ar * er - ai * ei + xr, ni = ar * ei + ai * er + xi; er = nr; ei = ni; hlr[t] = nr; hli[t] = ni; }
        }
        LE[((it & 1) * 8 + w) * 128 + lane] = er; LE[((it & 1) * 8 + w) * 128 + 64 + lane] = ei;
        LDS_WAIT(); __builtin_amdgcn_s_barrier(); asm volatile("" ::: "memory");
        float cinr = 0.f, cini = 0.f;
#pragma unroll
        for (int j = 0; j < 8; ++j) {
            if (j == w) { cinr = cr; cini = ci; }
            const float lr = LE[((it & 1) * 8 + j) * 128 + lane], li = LE[((it & 1) * 8 + j) * 128 + 64 + lane];
            const float nr = a32r * cr - a32i * ci + lr, ni = a32r * ci + a32i * cr + li; cr = nr; ci = ni;
        }
        if (active) {
            float pr = ar, pi = ai;
#pragma unroll
            for (int t = 0; t < 32; ++t) {
                const float hr = hlr[t] + pr * cinr - pi * cini, hq = hli[t] + pr * cini + pi * cinr;
                Hb[t * SSM_HP + lane] = (unsigned short)f2bf(hr); Hb[t * SSM_HP + 64 + lane] = (unsigned short)f2bf(hq);
                if (ck == 64 && t == 15) { F.out[O_SRP + (size_t)(b * NG + g) * 64 + lane] = hr; F.out[O_SIP + (size_t)(b * NG + g) * 64 + lane] = hq; }
                const float npr = pr * ar - pi * ai, npi = pr * ai + pi * ar; pr = npr; pi = npi;
            }
            *(LAS bf16x8*)((LAS unsigned char*)Ut + r32 * 32 + hi * 16) = A;
            LDS_WAIT(); asm volatile("" ::: "memory");
            f32x16 y = (f32x16){};
#pragma unroll
            for (int s = 0; s < 8; ++s) { const bf16x8 Af = *(const LAS bf16x8*)((LAS unsigned char*)Hb + r32 * (SSM_HP * 2) + (16 * s + 8 * hi) * 2);
                bf16x8 cf = *(const LAS bf16x8*)(lds + SSM_CF + (s * 32 + cfl) * 16); if (r32 >= 16) cf = (bf16x8){0, 0, 0, 0, 0, 0, 0, 0};
                y = MFMA32(Af, cf, y); }
            if (r32 < 16) {
#pragma unroll
                for (int r = 0; r < 16; ++r) { const int t = crow(r, hi);
                    Gt[t * 16 + r32] = (unsigned short)f2bf(gelu_tanh(y[r] + dsk * bf2f(Ut[t * 16 + r32]))); }
            }
            LDS_WAIT(); asm volatile("" ::: "memory");
            { const int t = lane >> 1, hf = lane & 1, pos = t0 + t;
              if (pos < LP) *(v4u*)(F.GB + (size_t)(rowb + pos) * 512 + 16 * g + 8 * hf) = *(const LAS v4u*)((LAS unsigned char*)Gt + t * 32 + hf * 16); }
            LDS_WAIT(); asm volatile("" ::: "memory");
        }
    }
    __syncthreads();
}

__device__ __forceinline__ void ssm_sample_unit(Frame& F, int db, int g) {
    int lane_ = F.lane; asm volatile("" : "+v"(lane_));
    const int lane = lane_, w = F.wave;
    LAS float* S = (LAS float*)(F.lds + 4096 * w);
    const int gp = g * 64 + lane;
    const float ar = F.PAR[PA_ABR + gp], ai = F.PAR[PA_ABI + gp];
    float hr = F.in[I_SRE][(size_t)(db * NG + g) * 64 + lane], hq = F.in[I_SIM][(size_t)(db * NG + g) * 64 + lane];
    float br[16], bi[16];
#pragma unroll
    for (int c = 0; c < 16; ++c) { br[c] = F.PAR[PA_BBR + gp * 16 + c]; bi[c] = F.PAR[PA_BBI + gp * 16 + c]; }
    const int rbase = MP + db * 4;
#pragma unroll
    for (int t = 0; t < 4; ++t) {
        const v4u u0 = *(const v4u*)(F.UB + (size_t)(rbase + t) * 512 + 16 * g), u1 = *(const v4u*)(F.UB + (size_t)(rbase + t) * 512 + 16 * g + 8);
        const unsigned uw[8] = { u0.x, u0.y, u0.z, u0.w, u1.x, u1.y, u1.z, u1.w };
        float xr = 0.f, xi = 0.f;
#pragma unroll
        for (int c = 0; c < 16; ++c) { const float uu = bf2f((unsigned short)((c & 1) ? (uw[c >> 1] >> 16) : (uw[c >> 1] & 0xffffu))); xr += br[c] * uu; xi += bi[c] * uu; }
        const float nr = ar * hr - ai * hq + xr, ni = ar * hq + ai * hr + xi; hr = nr; hq = ni;
        S[t * 128 + lane] = hr; S[t * 128 + 64 + lane] = hq;
    }
    F.out[O_SRS + (size_t)(db * NG + g) * 64 + lane] = hr; F.out[O_SIS + (size_t)(db * NG + g) * 64 + lane] = hq;
    LDS_WAIT(); asm volatile("" ::: "memory");
    const int t = lane >> 4, ch = lane & 15;
    const float* cre = F.in[I_CRE] + (size_t)(g * 16 + ch) * 64; const float* cim = F.in[I_CIM] + (size_t)(g * 16 + ch) * 64;
    float y = 0.f;
#pragma unroll 4
    for (int p = 0; p < 64; p += 4) { const f32x4 a = *(const f32x4*)(cre + p), c = *(const f32x4*)(cim + p);
        const f32x4 sr = *(const LAS f32x4*)(S + t * 128 + p), si = *(const LAS f32x4*)(S + t * 128 + 64 + p);
        y += (a[0] * sr[0] - c[0] * si[0]) + (a[1] * sr[1] - c[1] * si[1]) + (a[2] * sr[2] - c[2] * si[2]) + (a[3] * sr[3] - c[3] * si[3]); }
    const float uu = bf2f(F.UB[(size_t)(rbase + t) * 512 + 16 * g + ch]);
    F.GB[(size_t)(rbase + t) * 512 + 16 * g + ch] = (bf16)f2bf(gelu_tanh(y + F.in[I_DSK][g * 16 + ch] * uu));
    LDS_WAIT(); asm volatile("" ::: "memory");
}

struct Args { const void* in[N_IN]; float* out; unsigned char* ws; };
constexpr int NQ_MAIN = 4 * 288, NQ_SS = 64, NQ = NQ_MAIN + NQ_SS;

__global__ void __launch_bounds__(512, 2) hymba_fwd(Args args) {
    extern __shared__ __attribute__((aligned(16))) unsigned char lds_raw[];
    Frame F;
    F.lds = (LAS unsigned char*)lds_raw;
    F.MISC = (volatile LAS unsigned*)(F.lds + MISC_OFF);
    F.tid = threadIdx.x; F.lane = F.tid & 63; F.wave = __builtin_amdgcn_readfirstlane(F.tid >> 6);
    F.G = gridDim.x; { const int bx = blockIdx.x; F.vcu = (F.G % 8 == 0) ? (bx % 8) * (F.G / 8) + bx / 8 : bx; }
    unsigned char* ws = args.ws;
    F.ws = ws; F.out = args.out;
#pragma unroll
    for (int i = 0; i < N_IN; ++i) F.in[i] = (const float*)args.in[i];
    F.ctl = (gu32*)(ws + WS_CTL);
    F.WIN_t = (bf16*)(ws + WS_WIN); F.WGLU_t = (bf16*)(ws + WS_WGLU); F.WOUT_t = (bf16*)(ws + WS_WOUT); F.WGATE_t = (bf16*)(ws + WS_WGATE); F.WUP_t = (bf16*)(ws + WS_WUP); F.WDOWN_t = (bf16*)(ws + WS_WDOWN);
    F.XN = (bf16*)(ws + WS_XN); F.QB = (bf16*)(ws + WS_QB); F.KB = (bf16*)(ws + WS_KB); F.VB = (bf16*)(ws + WS_VB); F.UB = (bf16*)(ws + WS_UB);
    F.MIX = (bf16*)(ws + WS_MIX); F.GB = (bf16*)(ws + WS_G); F.AB = (bf16*)(ws + WS_A); F.HB = (bf16*)(ws + WS_H);
    F.X1 = (float*)(ws + WS_X1); F.PAR = (float*)(ws + WS_PAR); F.ROWSS = (float*)(ws + WS_CTL) + CW_ROWSS; F.SLO = (float*)(ws + WS_SLO); F.SLL = (float*)(ws + WS_SLL);
    for (int u = F.tid; u < (LDS_BYTES - MISC_OFF) / 4; u += 512) ((LAS unsigned*)(F.lds + MISC_OFF))[u] = 0u;
    __syncthreads();
#if defined(REP_BAR) && REP_BAR > 1
#define xcd_barrier(b) do { xcd_barrier(b); xcd_barrier(b); } while (0)
#endif
    XcdBarrier bar = xcd_barrier_post((unsigned*)(F.ctl + CW_BAR), F.MISC + 8);

#ifdef PROBE_PH
    unsigned long long ts_a = 0, ts_b = 0; int ts_n = 0;
#define STAMP() do { const unsigned long long t_ = __builtin_amdgcn_s_memrealtime(); if (ts_n == PROBE_PH) ts_a = t_; if (ts_n == PROBE_PH + 1) ts_b = t_; ++ts_n; } while (0)
#else
#define STAMP() do {} while (0)
#endif
#ifdef PROBE_X
    unsigned long long tx_a = 0, tx_b = 0;
#define STAMPX(i) do { if ((i) == PROBE_X) tx_a = __builtin_amdgcn_s_memrealtime(); if ((i) == PROBE_X + 1) tx_b = __builtin_amdgcn_s_memrealtime(); } while (0)
#else
#define STAMPX(i) do {} while (0)
#endif
    STAMP();
    STAMPX(10);
    p0_prologue(F);
    STAMPX(11);
#if defined(REP_P0) && REP_P0 > 1
    __syncthreads(); p0_prologue(F);
#endif
    xcd_barrier(bar); STAMP();

    {
        pg8::Gemm g{F.XN, F.WIN_t, MPAD, PWID, DM, DM, 256}; ProjOrder S; S.init(F.G, (int)blockIdx.x);
        EpiProj E{F.QB, F.KB, F.VB, F.UB, F.out, F.in[I_QN], F.in[I_KN], (float*)(F.ws + WS_A)};
        pg8::gemm_phase<EpiProj, ProjOrder, true, true>(F.lds, g, S, E);
    }
    xcd_barrier(bar); STAMP();
    proj_tail_reduce(F, (const float*)(F.ws + WS_A));
    xcd_barrier(bar); STAMP();

    STAMPX(0);
    int qpar = 0;
#define P2_QUEUE(QI, NUNITS, ...) do { for (;;) { \
        if (F.tid == 0) F.MISC[qpar] = __hip_atomic_fetch_add((unsigned*)(F.ctl + CW_QUEUE + 64 * (QI)), 1u, RLX_AGENT); \
        __syncthreads(); const int n = (int)F.MISC[qpar]; qpar ^= 1; \
        if (n >= (NUNITS)) break; __VA_ARGS__; } } while (0)
#define Q_SSM() P2_QUEUE(0, 256, ssm_unit(F, n >> 5, n & 31))
#define Q_ATT() P2_QUEUE(1, 288, { const int qi = 7 - n / 32, bh = n % 32; attn_unit(F, bh >> 2, bh & 3, qi); })
#define Q_DEC() P2_QUEUE(2, DB * NSL, decode_unit(F, n / NSL, n % NSL))
#define Q_WCV() P2_QUEUE(4, (WCV_ITEMS + 7) / 8, { const int r_ = n * 8 + F.wave; if (r_ < WCV_ITEMS) wcv_item(F, r_); })
#define Q_SSMS() P2_QUEUE(3, DB * NG / 8, ssm_sample_unit(F, (n * 8 + F.wave) >> 5, (n * 8 + F.wave) & 31))
#ifndef P2_MODE
#define P2_MODE 1
#endif
#if P2_MODE == 0
    Q_SSM(); Q_ATT(); Q_DEC(); Q_WCV(); Q_SSMS();
#elif P2_MODE == 2
    Q_ATT(); Q_SSM(); Q_DEC(); Q_WCV(); Q_SSMS();
#else
#ifndef DEC_FIRST_16
#define DEC_FIRST_16 9
#endif
    const bool decfirst = (F.vcu & 15) < DEC_FIRST_16;
    if (decfirst) { Q_DEC(); STAMPX(1); Q_SSM(); STAMPX(2); Q_ATT(); }
    else { Q_ATT(); STAMPX(1); Q_SSM(); STAMPX(2); Q_DEC(); }
    STAMPX(3);
    Q_WCV(); Q_SSMS();
#endif
#undef Q_SSM
#undef Q_ATT
#undef Q_DEC
#undef Q_WCV
#undef Q_SSMS
#undef P2_QUEUE
    xcd_barrier(bar); STAMP();

    {
        pg8::Gemm g{F.GB, F.WGLU_t, MPAD, SW, SW, SW, 256}; pg8::StaticOrder S; S.init(MPAD, SW, F.G, (int)blockIdx.x);
        EpiGlu E{F.GB, F.MIX, F.in[I_BGLU]};
        pg8::gemm_phase<EpiGlu, pg8::StaticOrder, true, true>(F.lds, g, S, E);
#if defined(REP_P3) && REP_P3 > 1
        __syncthreads();
        pg8::gemm_phase<EpiGlu, pg8::StaticOrder, true, true>(F.lds, g, S, E);
#endif
        { const int nglu = (MPAD / 256) * (SW / 256);
          const int nidle = F.G > nglu ? F.G - nglu : F.G, ib = F.G > nglu ? (int)blockIdx.x - nglu : (int)blockIdx.x;
          if (ib >= 0)
#pragma unroll 1
            for (int uidx = ib * 8 + F.wave; uidx < DB * NH * TS; uidx += nidle * 8) decode_final(F, uidx >> 4, (uidx >> 2) & 3, uidx & 3); }
    }
    xcd_barrier(bar); STAMP();

    {
        pg8::Gemm g{F.MIX, F.WOUT_t, MPAD, DM, DM, DM, 256}; OutOrder S; S.init(F.G, (int)blockIdx.x);
        EpiOut E{F.in[I_XP], F.XN, F.ROWSS, (float*)(F.ws + WS_A)};
        pg8::gemm_phase<EpiOut, OutOrder, true, true>(F.lds, g, S, E);
    }
    xcd_barrier(bar); STAMP();
    out_tail_reduce(F, (const float*)(F.ws + WS_A));
    xcd_barrier(bar); STAMP();

    {
#ifdef PROBE_EPI
        if (F.tid < 32) ((LAS unsigned long long*)((LAS float*)(F.lds + RING_BYTES) + 2048))[F.tid] = 0ull;
        __syncthreads();
#endif
        pg8::Gemm g{F.XN - 2 * DM, F.WGATE_t, MT2 * 256, 2 * FF, DM, DM, MSTEP2}; pg8::StaticOrder S; S.init(MT2 * 256, 2 * FF, F.G, (int)blockIdx.x);
        EpiGateUp E{F.ROWSS, F.HB, F.out, F.in[I_CW], F.in[I_CB], (const bf16*)(F.ws + WS_EH), (LAS float*)(F.lds + RING_BYTES)};
        STAMPX(20);
        pg8::gemm_phase<EpiGateUp, pg8::StaticOrder, true, true>(F.lds, g, S, E);
        STAMPX(21);
#if defined(REP_P5) && REP_P5 > 1
        __syncthreads();
        pg8::gemm_phase<EpiGateUp, pg8::StaticOrder, true, true>(F.lds, g, S, E);
#endif
    }
    xcd_barrier(bar); STAMP();

    {
        pg8::Gemm g{F.HB, F.WDOWN_t, MPAD, DM, FF, FF, 256}; DownOrder S; S.init(F.G, (int)blockIdx.x);
        EpiDown E{F.XN, F.out, (float*)(F.ws + WS_A)};
        pg8::gemm_phase<EpiDown, DownOrder, true, true>(F.lds, g, S, E);
    }
    xcd_barrier(bar); STAMP();
    down_tail_reduce(F, (const float*)(F.ws + WS_A));
#ifdef PROBE_EPI
    if (blockIdx.x == 0 && F.tid == 0) { const LAS unsigned long long* pst = (const LAS unsigned long long*)((LAS float*)(F.lds + RING_BYTES) + 2048); const unsigned long long t0 = __builtin_amdgcn_s_memrealtime(), want = (pst[PROBE_EPI + 1] - pst[PROBE_EPI]) * PROBE_AMP; while (__builtin_amdgcn_s_memrealtime() - t0 < want) __builtin_amdgcn_s_sleep(8); }
#endif
#ifdef PROBE_X
    if (blockIdx.x == PROBE_BLK && F.tid == 0) { const unsigned long long t0 = __builtin_amdgcn_s_memrealtime(), want = (tx_b - tx_a) * PROBE_AMP; while (__builtin_amdgcn_s_memrealtime() - t0 < want) __builtin_amdgcn_s_sleep(8); }
#endif
#ifdef PROBE_PH
    xcd_barrier(bar); STAMP(); STAMP();
    if (blockIdx.x == 0 && F.tid == 0) { const unsigned long long t0 = __builtin_amdgcn_s_memrealtime(), want = (ts_b - ts_a) * PROBE_AMP; while (__builtin_amdgcn_s_memrealtime() - t0 < want) __builtin_amdgcn_s_sleep(8); }
#endif
}

extern "C" void kernel_launch(void* const* d_in, const int* in_sizes, int n_in, void* d_out, int out_size, void* d_ws, size_t ws_size, hipStream_t stream) {
    static int grid = 0;
    if (grid == 0) {
        if (n_in != N_IN || (size_t)out_size != O_END || ws_size < WS_END) { fprintf(stderr, "kernel_launch: unexpected shapes (n_in %d, out %d, ws %zu); nothing launched\n", n_in, out_size, ws_size); grid = -1; return; }
        int dev = 0, cus = 0, per_cu = 0;
        if (hipGetDevice(&dev) != hipSuccess || hipDeviceGetAttribute(&cus, hipDeviceAttributeMultiprocessorCount, dev) != hipSuccess) { grid = -1; return; }
        if (hipFuncSetAttribute((const void*)hymba_fwd, hipFuncAttributeMaxDynamicSharedMemorySize, LDS_BYTES) != hipSuccess) { fprintf(stderr, "kernel_launch: hipFuncSetAttribute failed\n"); grid = -1; return; }
        if (hipOccupancyMaxActiveBlocksPerMultiprocessor(&per_cu, (const void*)hymba_fwd, 512, LDS_BYTES) != hipSuccess || per_cu < 1)
            fprintf(stderr, "kernel_launch: note: occupancy query reports %d workgroups per CU\n", per_cu);
        (void)hipGetLastError();
        grid = cus;
    }
    if (grid < 0) return;
    if (hipMemsetAsync((char*)d_ws + WS_CTL, 0, CTL_ZERO_BYTES, stream) != hipSuccess) return;
    Args a{};
    for (int i = 0; i < N_IN; ++i) a.in[i] = d_in[i];
    a.out = (float*)d_out; a.ws = (unsigned char*)d_ws;
    hipLaunchKernelGGL(hymba_fwd, dim3(grid), dim3(512), LDS_BYTES, stream, a);
}
```

```cpp
#include <hip/hip_runtime.h>
#include <hip/hip_bf16.h>
#include <cstdio>
#include <cstdint>
#include <cmath>
namespace pg8 {
#define PG8_LAS __attribute__((address_space(3)))
typedef unsigned short bf16_t;
typedef short bf16x8 __attribute__((ext_vector_type(8)));
typedef float f32x4 __attribute__((ext_vector_type(4)));
typedef unsigned u32x4 __attribute__((ext_vector_type(4)));
constexpr int BM = 256, BK = 64, HALF = 128, HTB = HALF * BK * 2  , STAGE_BYTES = 8 * HTB, NXCD = 8, WGM = 8;

__host__ __device__ __forceinline__ int lds_byte(int r, int c) { const int st = (r >> 4) * 2 + (c >> 5), rr = r & 15, cc = c & 31, ob = rr * 64 + cc * 2; return st * 1024 + (ob ^ (((ob >> 9) & 1) << 5)); }
__host__ __device__ __forceinline__ void stage_rc(int b, int& R, int& C) { const int st = b / 1024, sb = b % 1024, swz = sb ^ (((sb >> 9) & 1) << 5); R = (st >> 1) * 16 + swz / 64; C = (st & 1) * 32 + (swz % 64) / 2; }
__host__ __device__ __forceinline__ int perm32(int rho) { const int n = rho >> 4, i = rho & 15; return 8 * (i >> 2) + 4 * n + (i & 3); }

struct Unit { int pm, pn, arow, kt0, nkt; };
struct Gemm { const bf16_t* A; const bf16_t* Bt; int M, N, K, ld, mstep; };

struct StaticOrder {
    int nM, nN, nwg, G, c;
    __host__ __device__ void init(int M, int N, int G_, int c_) { nM = M / BM; nN = N / BM; nwg = nM * nN; G = G_; c = c_; }
    __host__ __device__ bool next(int i, Unit& u) const {
        const long L = (long)i * G + c; if (L >= nwg) return false;
        int wgid = (int)L; { const int q = nwg / NXCD, r = nwg % NXCD, xcd = wgid % NXCD, off = wgid / NXCD; wgid = (xcd < r ? xcd * (q + 1) : r * (q + 1) + (xcd - r) * q) + off; }
        const int nig = WGM * nN, gid = wgid / nig, fm = gid * WGM, gsz = (nM - fm) < WGM ? (nM - fm) : WGM;
        u.pm = fm + ((wgid % nig) % gsz); u.pn = (wgid % nig) / gsz; u.arow = -1; u.kt0 = 0; u.nkt = 0; return true;
    }
    __device__ __forceinline__ void a_ready(const Unit&) const {}
    __device__ __forceinline__ void done(const Unit&) const {}
};

__device__ __forceinline__ unsigned cvt_pk_bf16(float lo, float hi) { unsigned r; asm volatile("v_cvt_pk_bf16_f32 %0, %1, %2" : "=v"(r) : "v"(lo), "v"(hi)); return r; }
typedef float f32x2 __attribute__((ext_vector_type(2)));
__device__ __forceinline__ f32x2 gelu_pk(f32x2 v) {
    const f32x2 av = __builtin_elementwise_abs(v), d = av * 0.2316418882f + 1.0f;
    f32x2 t; t.x = __builtin_amdgcn_rcpf(d.x); t.y = __builtin_amdgcn_rcpf(d.y);
    f32x2 q = t * 0.5307027145f + (-0.7265760135f); q = q * t + 0.7107068705f; q = q * t + (-0.142248368f); q = q * t + 0.127414796f; q = q * t;
    const f32x2 s = (v * v) * (-0.72134752044f);
    f32x2 e; e.x = __builtin_amdgcn_exp2f(s.x); e.y = __builtin_amdgcn_exp2f(s.y);
    const f32x2 m = v * (q * e), r = v - m;
    f32x2 o; o.x = v.x < 0.f ? m.x : r.x; o.y = v.y < 0.f ? m.y : r.y; return o;
}

template <int ACT  > struct EpiBf16 {
    static constexpr bool PERM = true, AFTER_DRAIN = false; static_assert(ACT == 0 || ACT == 1, "EpiBf16: ACT is 0 (none) or 1 (gelu_pk)");
    bf16_t* O; int ldc; const float* bias; int split_cols; size_t split_stride; float scale0;
    __device__ __forceinline__ void operator()(const f32x4 (&acc)[2][2][4][2], const Unit& u, int wr, int wc, int fr, int fq) const {
        const int row0 = u.pm * BM + wr * 64 + fr; int colt = u.pn * BM; bf16_t* base = O;
        float sc = 1.f; if (split_cols) { const int t = colt / split_cols; base += (size_t)t * split_stride; colt -= t * split_cols; if (t == 0) sc = scale0; }
        const int col0 = colt + wc * 32 + 8 * fq, bcol0 = u.pn * BM + wc * 32 + 8 * fq;
        f32x4 bv[2][2];
#pragma unroll
        for (int bj = 0; bj < 2; ++bj)
#pragma unroll
            for (int n = 0; n < 2; ++n) bv[bj][n] = bias ? *(const f32x4*)(bias + bcol0 + bj * HALF + 4 * n) : (f32x4){0.f, 0.f, 0.f, 0.f};
#pragma unroll
        for (int ai = 0; ai < 2; ++ai)
#pragma unroll
            for (int m = 0; m < 4; ++m) { bf16_t* rowp = base + (size_t)(row0 + ai * HALF + m * 16) * ldc + col0;
#pragma unroll
                for (int bj = 0; bj < 2; ++bj) { f32x4 v0 = acc[ai][bj][m][0] + bv[bj][0], v1 = acc[ai][bj][m][1] + bv[bj][1];
                    if (ACT == 1) { f32x2 a = gelu_pk((f32x2){v0[0], v0[1]}), b = gelu_pk((f32x2){v0[2], v0[3]}), c = gelu_pk((f32x2){v1[0], v1[1]}), d = gelu_pk((f32x2){v1[2], v1[3]});
                        v0 = (f32x4){a.x, a.y, b.x, b.y}; v1 = (f32x4){c.x, c.y, d.x, d.y}; }
                    v0 = v0 * sc; v1 = v1 * sc; u32x4 w; w.x = cvt_pk_bf16(v0[0], v0[1]); w.y = cvt_pk_bf16(v0[2], v0[3]); w.z = cvt_pk_bf16(v1[0], v1[1]); w.w = cvt_pk_bf16(v1[2], v1[3]);
                    *(u32x4*)(rowp + bj * HALF) = w; } }
    }
};

template <class Epi, class Sched, bool ALIGN_EPI = false, bool SP2 = false>
__device__ __forceinline__ void gemm_phase(PG8_LAS unsigned char* lds, const Gemm g, const Sched& S, const Epi& E) {
    int tid_ = threadIdx.x; asm volatile("" : "+v"(tid_));
    const int tid = tid_, wid = __builtin_amdgcn_readfirstlane(tid >> 6), lane = tid & 63, wr = wid >> 2, wc = wid & 3, fr = lane & 15, fq = lane >> 4;
    const int K = g.ld, nt = g.K / BK;
    unsigned voffA[2], voffB[2];
#pragma unroll
    for (int i = 0; i < 2; ++i) { int R, C; stage_rc(tid * 16 + i * 8192, R, C); const int Rb = Epi::PERM ? ((R & ~31) + perm32(R & 31)) : R;
        voffA[i] = (unsigned)(R * K + C) * 2u; voffB[i] = (unsigned)(Rb * K + C) * 2u; }
    const size_t kstep = (size_t)(BK * 2);
    const size_t hstep = (size_t)HALF * K * 2;
    const size_t tstep = 2 * hstep, tstepA = (size_t)g.mstep * K * 2;
    const unsigned ldsw = (unsigned)wid * 1024u;
    const int aoff = lds_byte(wr * 64 + fr, fq * 8), boff = lds_byte(wc * 32 + fr, fq * 8);
#define PG8_SA(b, h) (((b) * 2 + (h)) * HTB)
#define PG8_SB(b, h) ((4 + (b) * 2 + (h)) * HTB)
#define PG8_STAGE(bufoff, gbase, voff) do { _Pragma("unroll") for (int _i = 0; _i < 2; ++_i) \
        __builtin_amdgcn_global_load_lds((const unsigned*)((const char*)(gbase) + (voff)[_i]), (PG8_LAS unsigned*)(lds + (bufoff) + ldsw + _i * 8192), 16, 0, 0); } while (0)
#define PG8_LDA(dst, b, h) do { _Pragma("unroll") for (int m = 0; m < 4; ++m) _Pragma("unroll") for (int k = 0; k < 2; ++k) dst[m][k] = *(const PG8_LAS bf16x8*)(lds + PG8_SA(b, h) + aoff + m * 2048 + k * 1024); } while (0)
#define PG8_LDB(dst, b, h) do { _Pragma("unroll") for (int n = 0; n < 2; ++n) _Pragma("unroll") for (int k = 0; k < 2; ++k) dst[n][k] = *(const PG8_LAS bf16x8*)(lds + PG8_SB(b, h) + boff + n * 2048 + k * 1024); } while (0)
#define PG8_MMA(ai, bj, At, Bt) do { __builtin_amdgcn_s_setprio(1); _Pragma("unroll") for (int m = 0; m < 4; ++m) _Pragma("unroll") for (int n = 0; n < 2; ++n) _Pragma("unroll") for (int k = 0; k < 2; ++k) \
        acc[ai][bj][m][n] = __builtin_amdgcn_mfma_f32_16x16x32_bf16(Bt[n][k], At[m][k], acc[ai][bj][m][n], 0, 0, 0); __builtin_amdgcn_s_setprio(0); } while (0)
#define PG8_WAIT_V(n) asm volatile("s_waitcnt vmcnt(" #n ")" ::: "memory")
#define PG8_WAIT_L(n) asm volatile("s_waitcnt lgkmcnt(" #n ")" ::: "memory")
#define PG8_BAR __builtin_amdgcn_s_barrier()
#define PG8_SCHED __builtin_amdgcn_sched_barrier(0)
    Unit cur, nxt; int ui = 0;
    if (!S.next(0, cur)) return;
    f32x4 acc[2][2][4][2];
#pragma unroll
    for (int a = 0; a < 2; ++a)
#pragma unroll
        for (int b = 0; b < 2; ++b)
#pragma unroll
            for (int m = 0; m < 4; ++m)
#pragma unroll
                for (int n = 0; n < 2; ++n) acc[a][b][m][n] = (f32x4){0.f, 0.f, 0.f, 0.f};
    bf16x8 At[4][2], B0[2][2], B1[2][2];
#define PG8_UA(u) ((const char*)g.A + ((u).arow >= 0 ? (size_t)(u).arow * K * 2 : (size_t)(u).pm * tstepA) + (size_t)(u).kt0 * kstep)
#define PG8_UB(u) ((const char*)g.Bt + (size_t)(u).pn * tstep + (size_t)(u).kt0 * kstep)
    const char* cA = PG8_UA(cur); const char* cB = PG8_UB(cur);
    int cnt_ = cur.nkt > 0 ? cur.nkt : nt;
    S.a_ready(cur);
    if constexpr (SP2) {
        PG8_STAGE(PG8_SB(0, 0), cB, voffB); PG8_STAGE(PG8_SB(0, 1), cB + hstep, voffB); PG8_STAGE(PG8_SA(0, 0), cA, voffA); PG8_STAGE(PG8_SA(0, 1), cA + hstep, voffA);
        if (wr == 1) PG8_BAR;
        PG8_WAIT_V(2); PG8_BAR;
        PG8_STAGE(PG8_SB(1, 0), cB + kstep, voffB); PG8_STAGE(PG8_SA(1, 0), cA + kstep, voffA); PG8_STAGE(PG8_SB(1, 1), cB + hstep + kstep, voffB);
        PG8_WAIT_V(6); PG8_BAR;
    } else {
        PG8_STAGE(PG8_SB(0, 0), cB, voffB); PG8_STAGE(PG8_SA(0, 0), cA, voffA); PG8_STAGE(PG8_SB(0, 1), cB + hstep, voffB); PG8_STAGE(PG8_SA(0, 1), cA + hstep, voffA);
        if (wr == 1) PG8_BAR;
        PG8_WAIT_V(4); PG8_BAR;
        PG8_STAGE(PG8_SB(1, 0), cB + kstep, voffB); PG8_STAGE(PG8_SA(1, 0), cA + kstep, voffA); PG8_STAGE(PG8_SB(1, 1), cB + hstep + kstep, voffB);
        PG8_WAIT_V(6); PG8_BAR;
    }
    for (;;) {
        const bool has_next = S.next(ui + 1, nxt);
        const char* nA = has_next ? PG8_UA(nxt) : cA; const char* nB = has_next ? PG8_UB(nxt) : cB;
        for (int t = 0; t < cnt_; t += 2) {
            const bool last = (t == cnt_ - 2);
            const char* a1 = cA + (size_t)(t + 1) * kstep;
            const char* a2 = last ? nA : cA + (size_t)(t + 2) * kstep; const char* b2 = last ? nB : cB + (size_t)(t + 2) * kstep;
            const char* a3 = a2 + kstep; const char* b3 = b2 + kstep;
            if (last && has_next) S.a_ready(nxt);
            if constexpr (SP2) {
            PG8_LDB(B0, 0, 0); PG8_LDB(B1, 0, 1); PG8_SCHED; PG8_LDA(At, 0, 0); PG8_STAGE(PG8_SA(1, 1), a1 + hstep, voffA);
            PG8_WAIT_V(8); PG8_WAIT_L(0); PG8_BAR; PG8_MMA(0, 0, At, B0); PG8_MMA(0, 1, At, B1); PG8_BAR; PG8_SCHED;
            PG8_LDA(At, 0, 1); PG8_STAGE(PG8_SB(0, 0), b2, voffB); PG8_STAGE(PG8_SB(0, 1), b2 + hstep, voffB); PG8_STAGE(PG8_SA(0, 0), a2, voffA);
            PG8_WAIT_V(8); PG8_WAIT_L(0); PG8_BAR; PG8_MMA(1, 0, At, B0); PG8_MMA(1, 1, At, B1); PG8_BAR; PG8_SCHED;
            PG8_LDB(B0, 1, 0); PG8_LDB(B1, 1, 1); PG8_SCHED; PG8_LDA(At, 1, 0); PG8_STAGE(PG8_SA(0, 1), a2 + hstep, voffA);
            PG8_WAIT_V(8); PG8_WAIT_L(0); PG8_BAR; PG8_MMA(0, 0, At, B0); PG8_MMA(0, 1, At, B1); PG8_BAR; PG8_SCHED;
            PG8_LDA(At, 1, 1); PG8_STAGE(PG8_SB(1, 0), b3, voffB); PG8_STAGE(PG8_SB(1, 1), b3 + hstep, voffB); PG8_STAGE(PG8_SA(1, 0), a3, voffA);
            PG8_WAIT_V(8); PG8_WAIT_L(0); PG8_BAR; PG8_MMA(1, 0, At, B0); PG8_MMA(1, 1, At, B1); PG8_BAR; PG8_SCHED;
            } else {
            PG8_LDB(B0, 0, 0); PG8_SCHED; PG8_LDA(At, 0, 0); PG8_STAGE(PG8_SA(1, 1), a1 + hstep, voffA);
            PG8_WAIT_L(8); PG8_BAR; PG8_WAIT_L(0); PG8_MMA(0, 0, At, B0); PG8_BAR; PG8_SCHED;
            PG8_LDB(B1, 0, 1); PG8_STAGE(PG8_SB(0, 0), b2, voffB);
            PG8_BAR; PG8_WAIT_L(0); PG8_MMA(0, 1, At, B1); PG8_BAR;
            PG8_LDA(At, 0, 1); PG8_STAGE(PG8_SA(0, 0), a2, voffA);
            PG8_BAR; PG8_WAIT_L(0); PG8_MMA(1, 0, At, B0); PG8_BAR; PG8_SCHED;
            PG8_STAGE(PG8_SB(0, 1), b2 + hstep, voffB);
            PG8_WAIT_V(6); PG8_BAR; PG8_MMA(1, 1, At, B1); PG8_BAR;
            PG8_LDB(B0, 1, 0); PG8_SCHED; PG8_LDA(At, 1, 0); PG8_STAGE(PG8_SA(0, 1), a2 + hstep, voffA);
            PG8_WAIT_L(8); PG8_BAR; PG8_WAIT_L(0); PG8_MMA(0, 0, At, B0); PG8_BAR; PG8_SCHED;
            PG8_LDB(B1, 1, 1); PG8_STAGE(PG8_SB(1, 0), b3, voffB);
            PG8_BAR; PG8_WAIT_L(0); PG8_MMA(0, 1, At, B1); PG8_BAR;
            PG8_LDA(At, 1, 1); PG8_STAGE(PG8_SA(1, 0), a3, voffA);
            PG8_BAR; PG8_WAIT_L(0); PG8_MMA(1, 0, At, B0); PG8_BAR; PG8_SCHED;
            PG8_STAGE(PG8_SB(1, 1), b3 + hstep, voffB);
            PG8_WAIT_V(6); PG8_BAR; PG8_MMA(1, 1, At, B1); PG8_BAR;
            }
        }
        if constexpr (ALIGN_EPI) { if (wr == 0) PG8_BAR; }
        if constexpr (!Epi::AFTER_DRAIN) { E(acc, cur, wr, wc, fr, fq); S.done(cur); }
        if (!has_next) break;
#pragma unroll
        for (int a = 0; a < 2; ++a)
#pragma unroll
            for (int b = 0; b < 2; ++b)
#pragma unroll
                for (int m = 0; m < 4; ++m)
#pragma unroll
                    for (int n = 0; n < 2; ++n) acc[a][b][m][n] = (f32x4){0.f, 0.f, 0.f, 0.f};
        cur = nxt; cA = nA; cB = nB; ++ui; cnt_ = cur.nkt > 0 ? cur.nkt : nt;
        if constexpr (ALIGN_EPI) { if (wr == 1) PG8_BAR; }
    }
    PG8_WAIT_V(0);
    if constexpr (!ALIGN_EPI) { if (wr == 0) PG8_BAR; }
    PG8_BAR;
    if constexpr (Epi::AFTER_DRAIN) { E.fused(acc, cur, wr, wc, fr, fq, lds, wid, lane); S.done(cur); }
#undef PG8_UA
#undef PG8_UB
#undef PG8_SA
#undef PG8_SB
#undef PG8_STAGE
#undef PG8_LDA
#undef PG8_LDB
#undef PG8_MMA
#undef PG8_WAIT_V
#undef PG8_WAIT_L
#undef PG8_BAR
#undef PG8_SCHED
}
}

constexpr int DM = 1024, NB = 8, SEQ = 2048, NMETA = 16, LP = SEQ + NMETA, DB = 128, TS = 4;
constexpr int MP = NB * LP, MS = DB * TS, MV = MP + MS, MPAD = 17152;
constexpr int NH = 4, HD = 128, QKD = 64, AW = 512, SW = 512, NG = 32, SG = 16, NST = 64, FF = 2816, PWID = 2048;
constexpr int NPG = 16, PAGE = 128;
constexpr float EPS = 1e-6f;
constexpr float QSCALE = 0.125f * 1.4426950408889634f;
constexpr float LAM_INIT = 0.2f;
constexpr size_t O_YP = 0, O_YS = O_YP + (size_t)NB * SEQ * DM, O_KP = O_YS + (size_t)MS * DM, O_VP = O_KP + (size_t)MP * 512,
                 O_KS = O_VP + (size_t)MP * 512, O_VS = O_KS + (size_t)MS * 512, O_SRP = O_VS + (size_t)MS * 512, O_SIP = O_SRP + NB * NG * NST,
                 O_SRS = O_SIP + NB * NG * NST, O_SIS = O_SRS + DB * NG * NST, O_CP = O_SIS + DB * NG * NST, O_CS = O_CP + (size_t)NB * 2 * FF,
                 O_END = O_CS + (size_t)DB * 2 * FF;
enum { I_XP = 0, I_XS, I_CK, I_CV, I_SRE, I_SIM, I_SCONV, I_PT, I_META, I_N1, I_WIN, I_QN, I_KN, I_LQ, I_LK, I_SUBN, I_ARE, I_AIM, I_LDT, I_BRE, I_BIM,
       I_CRE, I_CIM, I_DSK, I_WGLU, I_BGLU, I_WOUT, I_N2, I_WGATE, I_WUP, I_CW, I_CB, I_WDOWN, N_IN };

constexpr size_t MiB = 1u << 20;
constexpr size_t WS_CTL = 0, CTL_ZERO_BYTES = 160 * 1024;
constexpr size_t WS_PAR = 1 * MiB;
constexpr size_t WS_WIN = 2 * MiB, WS_WGLU = 6 * MiB, WS_WOUT = 7 * MiB, WS_WGATE = 9 * MiB, WS_WUP = 15 * MiB, WS_WDOWN = 21 * MiB;
constexpr size_t WS_XN = 32 * MiB;
constexpr size_t WS_QB = 66 * MiB, WS_KB = 83 * MiB, WS_VB = 100 * MiB, WS_UB = 117 * MiB;
constexpr size_t WS_MIX = 134 * MiB;
constexpr size_t WS_G = 168 * MiB;
constexpr size_t WS_X1 = 185 * MiB;
constexpr size_t WS_A = 252 * MiB;
constexpr size_t WS_H = 345 * MiB;
constexpr size_t WS_SLO = 438 * MiB, WS_SLL = 471 * MiB, WS_EH = 472 * MiB, WS_END = 474 * MiB;
constexpr int CW_BAR = 4096;
constexpr int CW_QUEUE = 8192;
constexpr int CW_ROWSS = 16384;
static_assert((CW_ROWSS + MPAD) * 4 <= (int)CTL_ZERO_BYTES, "ctl");
constexpr int PA_ABR = 0, PA_ABI = 2048, PA_BBR = 4096, PA_BBI = 4096 + 32768, PA_LAM = 4096 + 65536;

constexpr int RING_BYTES = 131072;
constexpr int LDS_BYTES = 147456;
constexpr int MISC_OFF = LDS_BYTES - 512;

#define GAS __attribute__((address_space(1)))
#define LAS __attribute__((address_space(3)))
typedef unsigned short bf16;
typedef unsigned v4u __attribute__((ext_vector_type(4)));
typedef unsigned v2u __attribute__((ext_vector_type(2)));
typedef float f32x4 __attribute__((ext_vector_type(4)));
typedef float f32x2 __attribute__((ext_vector_type(2)));
typedef float f32x16 __attribute__((ext_vector_type(16)));
typedef short bf16x8 __attribute__((ext_vector_type(8)));
typedef short s16x4 __attribute__((ext_vector_type(4)));
typedef GAS unsigned gu32;
#define RLX_AGENT __ATOMIC_RELAXED, __HIP_MEMORY_SCOPE_AGENT
#define LDS_WAIT() asm volatile("s_waitcnt lgkmcnt(0)" ::: "memory")
#define VM_WAIT() asm volatile("s_waitcnt vmcnt(0)" ::: "memory")
__device__ __forceinline__ unsigned f2bf(float f) { unsigned u = __builtin_bit_cast(unsigned, f); return (u + 0x7fffu + ((u >> 16) & 1u)) >> 16; }
__device__ __forceinline__ unsigned pk2(float lo, float hi) { unsigned r; asm("v_cvt_pk_bf16_f32 %0, %1, %2" : "=v"(r) : "v"(lo), "v"(hi)); return r; }
__device__ __forceinline__ float bf2f(unsigned short b) { return __builtin_bit_cast(float, (unsigned)b << 16); }
__device__ __forceinline__ f32x4 ld_bf4(const bf16* p) { const v2u w = *(const v2u*)p; return (f32x4){ bf2f((unsigned short)(w.x & 0xffffu)), bf2f((unsigned short)(w.x >> 16)), bf2f((unsigned short)(w.y & 0xffffu)), bf2f((unsigned short)(w.y >> 16)) }; }
__device__ __forceinline__ unsigned cvtpk(float lo, float hi) { unsigned r; asm volatile("v_cvt_pk_bf16_f32 %0, %1, %2" : "=v"(r) : "v"(lo), "v"(hi)); return r; }
__device__ __forceinline__ float gelu_tanh(float x) {
    const float z = x * (1.0f + 0.044715f * x * x);
    const float e = __builtin_amdgcn_exp2f(z * (-2.0f * 0.7978845608028654f * 1.4426950408889634f));
    return x * __builtin_amdgcn_rcpf(1.0f + e);
}
__device__ __forceinline__ float wave_sum(float v) {
#pragma unroll
    for (int o = 1; o < 64; o <<= 1) v += __shfl_xor(v, o);
    return v;
}

#define XB_TMO      128
#define XB_XCNT(j)  (256  + 64 * (j))
#define XB_XSUB(j)  (1280 + 64 * (j))
#define XB_XGEN(j)  (2304 + 64 * (j))
#define XB_TOP      3328
#define XB_TOPGEN   3392
#define XCD_BAR_WORDS 3456
#define XB_SPIN_CAP (1u << 18)
__device__ __forceinline__ unsigned xb_ld(unsigned* p)              { return __hip_atomic_load(p, __ATOMIC_RELAXED, __HIP_MEMORY_SCOPE_AGENT); }
__device__ __forceinline__ unsigned xb_add(unsigned* p, unsigned v) { return __hip_atomic_fetch_add(p, v, __ATOMIC_RELAXED, __HIP_MEMORY_SCOPE_AGENT); }
__device__ __forceinline__ unsigned xb_xcc_id() { return (unsigned)__builtin_amdgcn_s_getreg((3 << 11) | 20) & 0xFu; }
#define XB_SPIN(cond, bar) do { unsigned _sp = 0; while (cond) { __builtin_amdgcn_s_sleep(1); \
    if ((++_sp & 255u) == 0u) { if (xb_ld(&(bar)[XB_TMO])) break; if (_sp > XB_SPIN_CAP) { atomicAdd(&(bar)[XB_TMO], 1u); break; } } } } while (0)
struct XcdBarrier { unsigned* bar; unsigned x; volatile LAS unsigned* st; };
__device__ __forceinline__ XcdBarrier xcd_barrier_post(unsigned* bar, volatile LAS unsigned* st) {
    XcdBarrier b; b.bar = bar; b.x = xb_xcc_id(); b.st = st;
    if (threadIdx.x == 0) (void)xb_add(&bar[XB_XCNT(b.x)], 1u);
    return b;
}
__device__ __forceinline__ void xcd_barrier_complete(unsigned* bar, unsigned x, unsigned& nloc, unsigned& nx) {
    const unsigned G = gridDim.x * gridDim.y * gridDim.z;
    unsigned sum, cnt, mine, sp = 0u;
    for (;;) {
        sum = 0u; cnt = 0u; mine = 0u;
#pragma unroll
        for (unsigned j = 0; j < 16; ++j) { const unsigned c = xb_ld(&bar[XB_XCNT(j)]); sum += c; cnt += (c > 0u) ? 1u : 0u; mine = (j == x) ? c : mine; }
        if (sum == G) break;
        __builtin_amdgcn_s_sleep(1);
        if ((++sp & 255u) == 0u) { if (xb_ld(&bar[XB_TMO])) break; if (sp > XB_SPIN_CAP) { atomicAdd(&bar[XB_TMO], 1u); break; } }
    }
    nloc = mine > 0u ? mine : 1u; nx = cnt > 0u ? cnt : 1u;
}
__device__ __forceinline__ void xcd_barrier(const XcdBarrier& b) {
    asm volatile("s_waitcnt vmcnt(0)" ::: "memory");
    __syncthreads();
    if (threadIdx.x == 0) {
        unsigned* bar = b.bar;
        __builtin_amdgcn_s_waitcnt(0);
        unsigned nloc = b.st[0], nx = b.st[1];
        if (nloc == 0u) { xcd_barrier_complete(bar, b.x, nloc, nx); b.st[0] = nloc; b.st[1] = nx; }
        const unsigned old = xb_add(&bar[XB_XSUB(b.x)], 1u);
        const unsigned gen = old / nloc;
        if (old + 1u == (gen + 1u) * nloc) {
            __builtin_amdgcn_fence(__ATOMIC_RELEASE, "agent");
            asm volatile("s_waitcnt vmcnt(0)" ::: "memory");
            const unsigned og = xb_add(&bar[XB_TOP], 1u);
            const unsigned tg = og / nx;
            if (og + 1u == (tg + 1u) * nx) xb_add(&bar[XB_TOPGEN], 1u);
            else XB_SPIN(xb_ld(&bar[XB_TOPGEN]) == tg, bar);
            __builtin_amdgcn_fence(__ATOMIC_ACQUIRE, "agent");
            xb_add(&bar[XB_XGEN(b.x)], 1u);
            asm volatile("s_waitcnt vmcnt(0)" ::: "memory");
        } else {
            XB_SPIN(xb_ld(&bar[XB_XGEN(b.x)]) == gen, bar);
            __builtin_amdgcn_fence(__ATOMIC_ACQUIRE, "agent");
            asm volatile("s_waitcnt vmcnt(0)" ::: "memory");
        }
    }
    __syncthreads();
}

struct Frame {
    LAS unsigned char* lds;
    volatile LAS unsigned* MISC;
    gu32* ctl;
    int tid, lane, wave, vcu, G;
    const float* in[N_IN];
    float* out;
    unsigned char* ws;
    bf16 *WIN_t, *WGLU_t, *WOUT_t, *WGATE_t, *WUP_t, *WDOWN_t;
    bf16 *XN, *QB, *KB, *VB, *UB, *MIX, *GB, *AB, *HB;
    float *X1, *PAR, *ROWSS, *SLO, *SLL;
};

__device__ __forceinline__ const float* xin_row(const Frame& F, int m) {
    if (m < MP) { const int b = m / LP, t = m - b * LP; return t < NMETA ? F.in[I_META] + (size_t)t * DM : F.in[I_XP] + ((size_t)b * SEQ + (t - NMETA)) * DM; }
    if (m < MV) return F.in[I_XS] + (size_t)(m - MP) * DM;
    return nullptr;
}

__device__ __forceinline__ void p0_tr_item(const float* W, int K, int N, bf16* WT, LAS float* scr, int item, int lane, const float* kscale, int mode) {
    const int nblk = N / 64, kb = item / nblk, nb = item % nblk, k0 = 64 * kb, n0 = 64 * nb;
    const int lr = lane >> 4, lc = (lane & 15) * 4;
    const int sn = lane >> 3, sc = lane & 7;
    f32x4 vv[2][8];
#pragma unroll
    for (int half = 0; half < 2; ++half)
#pragma unroll
        for (int i = 0; i < 8; ++i) { const int kk = 32 * half + 4 * i + lr; vv[half][i] = *(const f32x4*)(W + (size_t)(k0 + kk) * N + n0 + lc); }
#pragma unroll
    for (int half = 0; half < 2; ++half) {
#pragma unroll
        for (int i = 0; i < 8; ++i) { f32x4 v = vv[half][i]; if (kscale) v = v * kscale[k0 + 32 * half + 4 * i + lr]; *(LAS f32x4*)(scr + (4 * i + lr) * 68 + lc) = v; }
        LDS_WAIT(); asm volatile("" ::: "memory");
#pragma unroll
        for (int j = 0; j < 8; ++j) { const int n = sn + 8 * j, L = n0 + n;
            int prow = L;
            if (mode == 1 && L < 1024) prow = (L & ~255) + 128 * ((L >> 5) & 1) + 32 * ((L >> 6) & 3) + (L & 31);
            if (mode >= 2) prow = 256 * (L >> 7) + (L & 127) + (mode == 3 ? 128 : 0);
            if (sc < 4) { const LAS float* p = scr + (8 * sc) * 68 + n;
                v4u o; o.x = pk2(p[0 * 68], p[1 * 68]); o.y = pk2(p[2 * 68], p[3 * 68]); o.z = pk2(p[4 * 68], p[5 * 68]); o.w = pk2(p[6 * 68], p[7 * 68]);
                *(GAS v4u*)(WT + (size_t)prow * K + k0 + 32 * half + 8 * sc) = o; } }
        LDS_WAIT(); asm volatile("" ::: "memory");
    }
}
__device__ __forceinline__ void p0_prologue(Frame& F) {
    LAS float* scr = (LAS float*)(F.lds + F.wave * 16384);
    int lane_ = F.lane; asm volatile("" : "+v"(lane_));
    const int gw = F.vcu * 8 + F.wave, NGW = F.G * 8, lane = lane_;
    constexpr int I_1 = (DM / 64) * (PWID / 64);
    { const int spread = NGW >= 4 * I_1 ? 4 : 1;
      if (gw % spread == 0) for (int it = gw / spread; it < I_1; it += NGW / spread) p0_tr_item(F.in[I_WIN], DM, PWID, F.WIN_t, scr, it, lane, nullptr, 1); }
    {
        const GAS f32x4* g1 = (const GAS f32x4*)F.in[I_N1] + lane;
        f32x4 gv[4];
#pragma unroll
        for (int j = 0; j < 4; ++j) gv[j] = g1[64 * j];
        f32x4 v[4], nx[4];
        const float* src = (gw < MPAD) ? xin_row(F, gw) : nullptr;
#pragma unroll
        for (int j = 0; j < 4; ++j) v[j] = src ? ((const GAS f32x4*)src + lane)[64 * j] : (f32x4){0.f, 0.f, 0.f, 0.f};
#pragma unroll 1
        for (int m = gw; m < MPAD; m += NGW) {
            const int mn = m + NGW;
            const float* nsrc = (mn < MPAD) ? xin_row(F, mn) : nullptr;
#pragma unroll
            for (int j = 0; j < 4; ++j) nx[j] = nsrc ? ((const GAS f32x4*)nsrc + lane)[64 * j] : (f32x4){0.f, 0.f, 0.f, 0.f};
            float s = 0.f;
#pragma unroll
            for (int j = 0; j < 4; ++j) s += (v[j].x * v[j].x + v[j].y * v[j].y) + (v[j].z * v[j].z + v[j].w * v[j].w);
            const float r = rsqrtf(wave_sum(s) * (1.f / DM) + EPS);
            GAS unsigned long long* o8 = (GAS unsigned long long*)(F.XN + (size_t)m * DM) + lane;
#pragma unroll
            for (int j = 0; j < 4; ++j) { const f32x4 y = (v[j] * r) * gv[j]; o8[64 * j] = (unsigned long long)pk2(y.x, y.y) | ((unsigned long long)pk2(y.z, y.w) << 32); }
#pragma unroll
            for (int j = 0; j < 4; ++j) v[j] = nx[j];
        }
    }
    const int pspread = NGW >= 2048 ? 4 : 1, pw_ = (gw % pspread == (pspread > 1 ? 1 : 0)) ? gw / pspread : -1;
    if (pw_ >= 0 && pw_ < 512 && (pspread > 1 || gw >= NGW - 512)) {
        const int idx = (pspread > 1 ? pw_ : gw - (NGW - 512)) * 64 + lane, gp = idx >> 4, c = idx & 15, g = gp >> 6;
        const float dt = expf(F.in[I_LDT][g]);
        const float ar = F.in[I_ARE][gp], ai = F.in[I_AIM][gp];
        const float mag = expf(ar * dt), abr = mag * cosf(ai * dt), abi = mag * sinf(ai * dt);
        const float den = ar * ar + ai * ai, nr = abr - 1.0f, ni = abi;
        const float gr = (nr * ar + ni * ai) / den, gi = (ni * ar - nr * ai) / den;
        if (c == 0) { F.PAR[PA_ABR + gp] = abr; F.PAR[PA_ABI + gp] = abi; }
        const float br = F.in[I_BRE][gp * 16 + c], bi = F.in[I_BIM][gp * 16 + c];
        F.PAR[PA_BBR + gp * 16 + c] = gr * br - gi * bi; F.PAR[PA_BBI + gp * 16 + c] = gr * bi + gi * br;
    }
    {
        bf16* EH = (bf16*)(F.ws + WS_EH);
        const float* cw = F.in[I_CW]; const float* hist = F.in[I_SCONV];
        for (int e = gw * 64 + lane; e < DB * (FF / 4); e += NGW * 64) {
            const int db = e / (FF / 4), c = (e - db * (FF / 4)) * 4;
            const f32x4 h0 = *(const f32x4*)(hist + (size_t)db * 2 * FF + c), h1 = *(const f32x4*)(hist + (size_t)db * 2 * FF + FF + c);
            const f32x4 w0 = *(const f32x4*)(cw + c), w1 = *(const f32x4*)(cw + FF + c);
            const f32x4 e0 = w0 * h0 + w1 * h1, e1 = w0 * h1;
            v2u a; a.x = pk2(e0[0], e0[1]); a.y = pk2(e0[2], e0[3]); *(v2u*)(EH + (size_t)db * 2 * FF + c) = a;
            v2u b; b.x = pk2(e1[0], e1[1]); b.y = pk2(e1[2], e1[3]); *(v2u*)(EH + (size_t)db * 2 * FF + FF + c) = b;
        }
    }
    if (gw == 0) {
        const float s0 = wave_sum(F.in[I_LQ][lane] * F.in[I_LK][lane]), s1 = wave_sum(F.in[I_LQ][64 + lane] * F.in[I_LK][64 + lane]);
        if (lane == 0) F.PAR[PA_LAM] = expf(s0) - expf(s1) + LAM_INIT;
    }
}

constexpr int WCV_I2 = (SW / 64) * (SW / 64), WCV_I3 = (DM / 64) * (DM / 64), WCV_I4 = (DM / 64) * (FF / 64), WCV_I6 = (FF / 64) * (DM / 64);
constexpr int WCV_ITEMS = WCV_I2 + WCV_I3 + 2 * WCV_I4 + WCV_I6, WCV_UNITS = (WCV_ITEMS + 7) / 8;
__device__ __forceinline__ void wcv_item(Frame& F, int r) {
    int lane_ = F.lane; asm volatile("" : "+v"(lane_));
    const int lane = lane_;
    LAS float* scr = (LAS float*)(F.lds + F.wave * 16384);
    if (r < WCV_I2) { p0_tr_item(F.in[I_WGLU], SW, SW, F.WGLU_t, scr, r, lane, nullptr, 0); return; } r -= WCV_I2;
    if (r < WCV_I3) { p0_tr_item(F.in[I_WOUT], DM, DM, F.WOUT_t, scr, r, lane, nullptr, 0); return; } r -= WCV_I3;
    if (r < WCV_I4) { p0_tr_item(F.in[I_WGATE], DM, FF, F.WGATE_t, scr, r, lane, F.in[I_N2], 2); return; } r -= WCV_I4;
    if (r < WCV_I4) { p0_tr_item(F.in[I_WUP], DM, FF, F.WGATE_t, scr, r, lane, F.in[I_N2], 3); return; } r -= WCV_I4;
    p0_tr_item(F.in[I_WDOWN], FF, DM, F.WDOWN_t, scr, r, lane, nullptr, 0);
}

using pg8::Unit; using pg8::HALF; using pg8::BM;

constexpr int PT_KSPL = 4, PT_PK = 4, PT_NPART = 24 * PT_KSPL;
struct ProjOrder {
    pg8::StaticOrder so; int c;
    __device__ void init(int G, int c_) { so.init(64 * 256, PWID, G, c_); c = c_; }
    __device__ bool next(int i, Unit& u) const {
        int j = i;
        if (c < PT_NPART) {
            if (j == 0) { const int q = c / PT_KSPL, ks = c - q * PT_KSPL, tt = q >> 3; u.pm = 64 + tt; u.pn = q & 7; u.arow = tt == 0 ? 0 : MP + 256 * (tt - 1); u.kt0 = PT_PK * ks; u.nkt = PT_PK; return true; }
            --j; }
        if (!so.next(j, u)) return false;
        u.arow = LP * (u.pm >> 3) + NMETA + 256 * (u.pm & 7);
        return true;
    }
    __device__ __forceinline__ void a_ready(const Unit&) const {}
    __device__ __forceinline__ void done(const Unit&) const {}
};
struct EpiProj {
    static constexpr bool PERM = true, AFTER_DRAIN = false;
    bf16 *qb, *kb, *vb, *ub; float* out; const float *qn, *kn; float* slab;
    __device__ __forceinline__ void operator()(const f32x4 (&acc)[2][2][4][2], const Unit& u, int wr, int wc, int fr_, int fq_) const {
        int fr = fr_, fq = fq_; asm volatile("" : "+v"(fr), "+v"(fq));
        if (u.nkt > 0) {
            float* sl = slab + (size_t)((((u.pm - 64) * 8 + u.pn) * PT_KSPL) + u.kt0 / PT_PK) * 65536;
            const int lrow0 = wr * 64 + fr, lcol0 = wc * 32 + 8 * fq;
#pragma unroll
            for (int ai = 0; ai < 2; ++ai)
#pragma unroll
                for (int m = 0; m < 4; ++m)
#pragma unroll
                    for (int bj = 0; bj < 2; ++bj)
#pragma unroll
                        for (int n = 0; n < 2; ++n) *(f32x4*)(sl + (size_t)(lrow0 + ai * HALF + m * 16) * 256 + lcol0 + bj * HALF + n * 4) = acc[ai][bj][m][n];
            return;
        }
        const int tt = u.pn >> 1, half = u.pn & 1;
        const int row0 = u.arow + wr * 64 + fr;
        if (tt < 2) {
            const float* gsrc = (tt == 0 ? qn : kn) + (wc & 1) * 64 + 8 * fq;
            const float sc = (tt == 0) ? QSCALE : 1.0f;
            f32x4 gv[2][2];
#pragma unroll
            for (int bj = 0; bj < 2; ++bj)
#pragma unroll
                for (int n = 0; n < 2; ++n) gv[bj][n] = *(const f32x4*)(gsrc + 32 * bj + 4 * n) * sc;
            bf16* dstb = (tt == 0) ? qb : kb;
            const int colL = 256 * half + 64 * wc + 8 * fq;
#pragma unroll
            for (int ai = 0; ai < 2; ++ai)
#pragma unroll
                for (int m = 0; m < 4; ++m) {
                    float ss = 0.f;
#pragma unroll
                    for (int bj = 0; bj < 2; ++bj)
#pragma unroll
                        for (int n = 0; n < 2; ++n) { const f32x4 x = acc[ai][bj][m][n]; ss += (x[0] * x[0] + x[1] * x[1]) + (x[2] * x[2] + x[3] * x[3]); }
                    ss += __shfl_xor(ss, 16); ss += __shfl_xor(ss, 32);
                    const float r = rsqrtf(ss * (1.0f / 64.0f) + EPS);
                    const int row = row0 + ai * HALF + m * 16;
                    float* fo = (tt == 1) ? out + O_KP + (size_t)row * 512 : nullptr;
#pragma unroll
                    for (int bj = 0; bj < 2; ++bj) { const int col = colL + 32 * bj;
                        const f32x4 v0 = (acc[ai][bj][m][0] * r) * gv[bj][0], v1 = (acc[ai][bj][m][1] * r) * gv[bj][1];
                        *(v4u*)(dstb + (size_t)row * 512 + col) = (v4u){ pk2(v0[0], v0[1]), pk2(v0[2], v0[3]), pk2(v1[0], v1[1]), pk2(v1[2], v1[3]) };
                        if (fo) { *(f32x4*)(fo + col) = v0; *(f32x4*)(fo + col + 4) = v1; } }
                }
        } else {
            bf16* dstb = (tt == 2) ? vb : ub;
            const int col0 = 256 * half + 32 * wc + 8 * fq;
#pragma unroll
            for (int ai = 0; ai < 2; ++ai)
#pragma unroll
                for (int m = 0; m < 4; ++m) {
                    const int row = row0 + ai * HALF + m * 16;
                    float* fo = (tt == 2) ? out + O_VP + (size_t)row * 512 : nullptr;
#pragma unroll
                    for (int bj = 0; bj < 2; ++bj) { const int col = col0 + 128 * bj;
                        const f32x4 v0 = acc[ai][bj][m][0], v1 = acc[ai][bj][m][1];
                        *(v4u*)(dstb + (size_t)row * 512 + col) = (v4u){ pk2(v0[0], v0[1]), pk2(v0[2], v0[3]), pk2(v1[0], v1[1]), pk2(v1[2], v1[3]) };
                        if (fo) { *(f32x4*)(fo + col) = v0; *(f32x4*)(fo + col + 4) = v1; } }
                }
        }
    }
};
__device__ __forceinline__ void proj_tail_reduce(Frame& F, const float* slab) {
    int lane_ = F.lane; asm volatile("" : "+v"(lane_));
    const int lane = lane_;
    const int gw = (int)blockIdx.x * 8 + F.wave, NGW = F.G * 8;
    constexpr int NIT = (NMETA + MS) * 8;
    f32x4 vq[3][PT_KSPL];
#pragma unroll
    for (int q = 0; q < 3; ++q) {
        const int it = gw + q * NGW;
        if (it < NIT) {
            const int rr = it >> 3, pn = it & 7, tt = pn >> 1;
            const bool meta = rr < NMETA;
            const int tl = meta ? 0 : 1 + ((rr - NMETA) >> 8), lr = meta ? rr : ((rr - NMETA) & 255);
            const int L = 4 * lane;
            const int phys = (tt < 2) ? 128 * ((L >> 5) & 1) + 32 * (L >> 6) + (L & 31) : L;
            const float* sl = slab + (size_t)((tl * 8 + pn) * PT_KSPL) * 65536 + (size_t)lr * 256 + phys;
#pragma unroll
            for (int k = 0; k < PT_KSPL; ++k) vq[q][k] = *(const f32x4*)(sl + (size_t)k * 65536);
        }
    }
#pragma unroll
    for (int q = 0; q < 3; ++q) {
        const int it = gw + q * NGW;
        if (it >= NIT) break;
        const int rr = it >> 3, pn = it & 7, tt = pn >> 1, half = pn & 1;
        const bool meta = rr < NMETA;
        const int L = 4 * lane;
        f32x4 v = (vq[q][0] + vq[q][1]) + (vq[q][2] + vq[q][3]);
        if (tt < 2) {
            float ss = (v[0] * v[0] + v[1] * v[1]) + (v[2] * v[2] + v[3] * v[3]);
            ss += __shfl_xor(ss, 1); ss += __shfl_xor(ss, 2); ss += __shfl_xor(ss, 4); ss += __shfl_xor(ss, 8);
            const float r = rsqrtf(ss * (1.0f / 64.0f) + EPS);
            const f32x4 g = *(const f32x4*)((tt == 0 ? F.in[I_QN] : F.in[I_KN]) + (L & 127));
            v = (v * r) * g; if (tt == 0) v = v * QSCALE;
        }
        const int col = 256 * half + L;
        bf16* dstb = tt == 0 ? F.QB : tt == 1 ? F.KB : tt == 2 ? F.VB : F.UB;
        v2u w; w.x = pk2(v[0], v[1]); w.y = pk2(v[2], v[3]);
        const int nrep = meta ? NB : 1;
        for (int b = 0; b < nrep; ++b) {
            const int row = meta ? b * LP + rr : MP + (rr - NMETA);
            *(v2u*)(dstb + (size_t)row * 512 + col) = w;
            if (tt == 1 || tt == 2) { float* fo = meta ? F.out + (tt == 1 ? O_KP : O_VP) + (size_t)row * 512 : F.out + (tt == 1 ? O_KS : O_VS) + (size_t)(rr - NMETA) * 512; *(f32x4*)(fo + col) = v; }
        }
    }
}

struct EpiGlu {
    static constexpr bool PERM = true, AFTER_DRAIN = false;
    const bf16* gb; bf16* mix; const float* bias;
    __device__ __forceinline__ void operator()(const f32x4 (&acc)[2][2][4][2], const Unit& u, int wr, int wc, int fr, int fq) const {
        const int row0 = u.pm * BM + wr * 64 + fr, col0 = u.pn * BM + wc * 32 + 8 * fq;
        f32x4 bv[2][2];
#pragma unroll
        for (int bj = 0; bj < 2; ++bj)
#pragma unroll
            for (int n = 0; n < 2; ++n) bv[bj][n] = *(const f32x4*)(bias + col0 + bj * HALF + n * 4);
#pragma unroll
        for (int ai = 0; ai < 2; ++ai)
#pragma unroll
            for (int m = 0; m < 4; ++m) { const int row = row0 + ai * HALF + m * 16;
#pragma unroll
                for (int bj = 0; bj < 2; ++bj) { const int col = col0 + bj * HALF;
                    const v4u gw = *(const v4u*)(gb + (size_t)row * 512 + col);
                    const unsigned gws[4] = { gw.x, gw.y, gw.z, gw.w }; unsigned ow[4];
#pragma unroll
                    for (int n = 0; n < 2; ++n) { const f32x4 z = acc[ai][bj][m][n] + bv[bj][n];
                        const float gg[4] = { __builtin_bit_cast(float, gws[2 * n] << 16), __builtin_bit_cast(float, gws[2 * n] & 0xffff0000u), __builtin_bit_cast(float, gws[2 * n + 1] << 16), __builtin_bit_cast(float, gws[2 * n + 1] & 0xffff0000u) };
                        float o[4];
#pragma unroll
                        for (int e = 0; e < 4; ++e) o[e] = gg[e] * __builtin_amdgcn_rcpf(1.0f + __builtin_amdgcn_exp2f(-1.4426950408889634f * z[e]));
                        ow[2 * n] = pk2(o[0], o[1]); ow[2 * n + 1] = pk2(o[2], o[3]); }
                    *(v4u*)(mix + (size_t)row * DM + 512 + col) = (v4u){ ow[0], ow[1], ow[2], ow[3] }; }
            }
    }
};

constexpr int OT_KSPL = 4, OT_PK = 4, OT_NPART = 12 * OT_KSPL;
struct OutOrder {
    pg8::StaticOrder so; int c;
    __device__ void init(int G, int c_) { so.init(64 * 256, DM, G, c_); c = c_; }
    __device__ bool next(int i, Unit& u) const {
        int j = i;
        if (c < OT_NPART) {
            if (j == 0) { const int q = c / OT_KSPL, ks = c - q * OT_KSPL, tt = q >> 2; u.pm = 64 + tt; u.pn = q & 3; u.arow = tt == 0 ? 0 : MP + 256 * (tt - 1); u.kt0 = OT_PK * ks; u.nkt = OT_PK; return true; }
            --j; }
        if (!so.next(j, u)) return false;
        u.arow = LP * (u.pm >> 3) + NMETA + 256 * (u.pm & 7);
        return true;
    }
    __device__ __forceinline__ void a_ready(const Unit&) const {}
    __device__ __forceinline__ void done(const Unit&) const {}
};
struct EpiOut {
    static constexpr bool PERM = true, AFTER_DRAIN = false;
    const float* xp; bf16* x1b; float* rowss; float* slab;
    __device__ __forceinline__ void operator()(const f32x4 (&acc)[2][2][4][2], const Unit& u, int wr, int wc, int fr_, int fq_) const {
        int fr = fr_, fq = fq_; asm volatile("" : "+v"(fr), "+v"(fq));
        const int lrow0 = wr * 64 + fr, lcol0 = wc * 32 + 8 * fq;
        if (u.nkt > 0) {
            float* sl = slab + (size_t)((((u.pm - 64) * 4 + u.pn) * OT_KSPL) + u.kt0 / OT_PK) * 65536;
#pragma unroll
            for (int ai = 0; ai < 2; ++ai)
#pragma unroll
                for (int m = 0; m < 4; ++m)
#pragma unroll
                    for (int bj = 0; bj < 2; ++bj)
#pragma unroll
                        for (int n = 0; n < 2; ++n) *(f32x4*)(sl + (size_t)(lrow0 + ai * HALF + m * 16) * 256 + lcol0 + bj * HALF + n * 4) = acc[ai][bj][m][n];
            return;
        }
        const int col0 = u.pn * BM + lcol0;
        const float* xs_ = xp + ((size_t)(u.pm >> 3) * SEQ + 256 * (u.pm & 7)) * DM;
#pragma unroll
        for (int ai = 0; ai < 2; ++ai)
#pragma unroll
            for (int m = 0; m < 4; ++m) { const int lr = lrow0 + ai * HALF + m * 16, row = u.arow + lr;
                float ss = 0.f;
#pragma unroll
                for (int bj = 0; bj < 2; ++bj) { const int col = col0 + bj * HALF;
                    const f32x4 v0 = acc[ai][bj][m][0] + *(const f32x4*)(xs_ + (size_t)lr * DM + col), v1 = acc[ai][bj][m][1] + *(const f32x4*)(xs_ + (size_t)lr * DM + col + 4);
                    ss += ((v0[0] * v0[0] + v0[1] * v0[1]) + (v0[2] * v0[2] + v0[3] * v0[3])) + ((v1[0] * v1[0] + v1[1] * v1[1]) + (v1[2] * v1[2] + v1[3] * v1[3]));
                    *(v4u*)(x1b + (size_t)row * DM + col) = (v4u){ pk2(v0[0], v0[1]), pk2(v0[2], v0[3]), pk2(v1[0], v1[1]), pk2(v1[2], v1[3]) }; }
                ss += __shfl_xor(ss, 16); ss += __shfl_xor(ss, 32);
                if (fq == 0) atomicAdd(rowss + row, ss);
            }
    }
};
__device__ __forceinline__ void out_tail_reduce(Frame& F, const float* slab) {
    int lane_ = F.lane; asm volatile("" : "+v"(lane_));
    const int lane = lane_;
    const int gw = (int)blockIdx.x * 8 + F.wave, NGW = F.G * 8;
    for (int rr = gw; rr < NMETA + MS; rr += NGW) {
        const bool meta = rr < NMETA;
        const int tt = meta ? 0 : 1 + ((rr - NMETA) >> 8), lr = meta ? rr : ((rr - NMETA) & 255);
        const float* xsrc = meta ? F.in[I_META] + (size_t)rr * DM : F.in[I_XS] + (size_t)(rr - NMETA) * DM;
        f32x4 v[4]; float ss = 0.f;
#pragma unroll
        for (int j = 0; j < 4; ++j) { const int c = 256 * j + 4 * lane;
            f32x4 s = *(const f32x4*)(xsrc + c);
            const float* sl = slab + (size_t)((tt * 4 + j) * OT_KSPL) * 65536 + (size_t)lr * 256 + 4 * lane;
#pragma unroll
            for (int k = 0; k < OT_KSPL; ++k) s += *(const f32x4*)(sl + (size_t)k * 65536);
            v[j] = s; ss += (s[0] * s[0] + s[1] * s[1]) + (s[2] * s[2] + s[3] * s[3]); }
        ss = wave_sum(ss);
        const int nrep = meta ? NB : 1;
        for (int b = 0; b < nrep; ++b) { const int row = meta ? b * LP + rr : MP + (rr - NMETA);
#pragma unroll
            for (int j = 0; j < 4; ++j) { v2u w; w.x = pk2(v[j][0], v[j][1]); w.y = pk2(v[j][2], v[j][3]); *(v2u*)(F.XN + (size_t)row * DM + 256 * j + 4 * lane) = w; }
            if (lane == 0) F.ROWSS[row] = ss; }
    }
}

__device__ __forceinline__ float dpp_ror1(float v) { return __builtin_bit_cast(float, __builtin_amdgcn_mov_dpp(__builtin_bit_cast(int, v), 0x121, 0xf, 0xf, false)); }
__device__ __forceinline__ float dpp_ror2(float v) { return __builtin_bit_cast(float, __builtin_amdgcn_mov_dpp(__builtin_bit_cast(int, v), 0x122, 0xf, 0xf, false)); }
__device__ __forceinline__ f32x2 gelu_mul_pk(f32x2 x, f32x2 c) {
    const f32x2 x2 = x * x, t = x2 * 0.044715f + 1.0f, z = (x * t) * (-2.0f * 0.7978845608028654f * 1.4426950408889634f);
    f32x2 e; e.x = __builtin_amdgcn_exp2f(z.x); e.y = __builtin_amdgcn_exp2f(z.y);
    const f32x2 d = e + 1.0f; f32x2 r; r.x = __builtin_amdgcn_rcpf(d.x); r.y = __builtin_amdgcn_rcpf(d.y);
    return (x * r) * c;
}
constexpr int MT2 = 68, MSTEP2 = 254;
struct EpiGateUp {
    static constexpr bool PERM = true, AFTER_DRAIN = false;
    const float* rowss; bf16* hb; float* out; const float *cw, *cb; const bf16* ehist; LAS float* xch;
    __device__ __forceinline__ void operator()(const f32x4 (&acc)[2][2][4][2], const Unit& u, int wr, int wc, int fr, int fq) const {
#ifdef PROBE_EPI
        LAS unsigned long long* pst = (LAS unsigned long long*)(xch + 2048); int pcnt = (int)pst[15];
        if (blockIdx.x == 0 && wr == 0 && wc == 0 && fr == 0 && fq == 0 && pcnt < 6) { pst[pcnt] = __builtin_amdgcn_s_memrealtime(); pst[15] = pcnt + 1; }
#endif
        const int trow0 = wr * 64 + fr;
        const int grow0 = u.pm * MSTEP2 - 2 + trow0;
        const int colw = wc * 32 + 8 * fq;
        const int col0 = u.pn * 128 + colw;
#pragma unroll
        for (int ai = 0; ai < 2; ++ai) { int R = grow0 + ai * HALF + 48; R = R < 0 ? 0 : (R >= MPAD ? MPAD - 1 : R);
            const float rs = rsqrtf(rowss[R] * (1.0f / DM) + EPS);
            if (fr >= 14) {
#pragma unroll
                for (int n = 0; n < 2; ++n) *(LAS f32x4*)(xch + ((ai * 2 + wr) * 2 + (fr - 14)) * 128 + colw + 4 * n) = acc[ai][0][3][n] * rs; } }
        asm volatile("s_waitcnt lgkmcnt(0)" ::: "memory"); __builtin_amdgcn_s_barrier(); asm volatile("" ::: "memory");
        f32x4 w0[2], w1[2], w2[2], bb[2];
#pragma unroll
        for (int n = 0; n < 2; ++n) { w0[n] = *(const f32x4*)(cw + col0 + 4 * n); w1[n] = *(const f32x4*)(cw + FF + col0 + 4 * n); w2[n] = *(const f32x4*)(cw + 2 * FF + col0 + 4 * n); bb[n] = *(const f32x4*)(cb + col0 + 4 * n); }
#pragma unroll
        for (int ai = 0; ai < 2; ++ai) {
            v2u eh[4][2];
#pragma unroll
            for (int m = 0; m < 4; ++m) { const int R = grow0 + ai * HALF + m * 16; const bool smp = (R >= MP) && (R < MV) && (((R - MP) & 3) < 2);
                const bf16* ep = ehist + ((size_t)(smp ? (R - MP) >> 2 : 0) * 2 + (smp ? (R - MP) & 1 : 0)) * FF + col0;
#pragma unroll
                for (int n = 0; n < 2; ++n) eh[m][n] = smp ? *(const v2u*)(ep + 4 * n) : (v2u){0u, 0u}; }
            f32x4 pr1[2], pr2[2];
            {   const bool hasprev = !(ai == 0 && wr == 0);
                const int pg = (wr == 1) ? (ai * 2) : ((ai - 1) * 2 + 1);
#pragma unroll
                for (int n = 0; n < 2; ++n) { f32x4 x62 = (f32x4){0.f, 0.f, 0.f, 0.f}, x63 = x62;
                    if (hasprev) { x62 = *(const LAS f32x4*)(xch + (pg * 2 + 0) * 128 + colw + 4 * n); x63 = *(const LAS f32x4*)(xch + (pg * 2 + 1) * 128 + colw + 4 * n); }
                    pr1[n] = x63; pr2[n] = (fr == 0) ? x62 : x63; } }
#pragma unroll
            for (int m = 0; m < 4; ++m) {
                const int trow = trow0 + ai * HALF + m * 16, R = grow0 + ai * HALF + m * 16;
                const int Rc = R < 0 ? 0 : (R >= MPAD ? MPAD - 1 : R);
                const float rs = rsqrtf(rowss[Rc] * (1.0f / DM) + EPS);
                int t = 2; float* fo = nullptr;
                if (Rc < MP) { const int b = Rc / LP; t = Rc - b * LP; if (t >= LP - 2) fo = out + O_CP + (size_t)(b * 2 + (t - (LP - 2))) * FF; }
                else if (Rc < MV) { const int db = (Rc - MP) >> 2; t = (Rc - MP) & 3; if (t >= 2) fo = out + O_CS + (size_t)(db * 2 + (t - 2)) * FF; }
                const bool store = (trow >= 2) && (R < MPAD);
                const float k1 = (t == 0) ? 0.f : 1.f, k2 = (t < 2) ? 0.f : 1.f;
                bf16* hrow = hb + (size_t)(store ? R : 0) * FF + col0;
                unsigned hw[4];
#pragma unroll
                for (int n = 0; n < 2; ++n) {
                    const f32x4 a0 = acc[ai][0][m][n] * rs, c = acc[ai][1][m][n] * rs;
                    f32x4 r1, r2;
#pragma unroll
                    for (int e = 0; e < 4; ++e) { r1[e] = dpp_ror1(a0[e]); r2[e] = dpp_ror2(a0[e]); }
                    f32x4 a1, a2;
#pragma unroll
                    for (int e = 0; e < 4; ++e) { a1[e] = (fr >= 1) ? r1[e] : pr1[n][e]; a2[e] = (fr >= 2) ? r2[e] : pr2[n][e]; }
                    pr1[n] = r1; pr2[n] = r2;
                    const v2u ew = eh[m][n];
                    const f32x2 w0a = (f32x2){w0[n][0], w0[n][1]} * k2, w0b = (f32x2){w0[n][2], w0[n][3]} * k2, w1a = (f32x2){w1[n][0], w1[n][1]} * k1, w1b = (f32x2){w1[n][2], w1[n][3]} * k1;
                    f32x2 cva = (f32x2){bb[n][0], bb[n][1]} + (f32x2){ __builtin_bit_cast(float, ew.x << 16), __builtin_bit_cast(float, ew.x & 0xffff0000u) };
                    f32x2 cvb = (f32x2){bb[n][2], bb[n][3]} + (f32x2){ __builtin_bit_cast(float, ew.y << 16), __builtin_bit_cast(float, ew.y & 0xffff0000u) };
                    cva = w0a * (f32x2){a2[0], a2[1]} + cva; cvb = w0b * (f32x2){a2[2], a2[3]} + cvb;
                    cva = w1a * (f32x2){a1[0], a1[1]} + cva; cvb = w1b * (f32x2){a1[2], a1[3]} + cvb;
                    cva = (f32x2){w2[n][0], w2[n][1]} * (f32x2){a0[0], a0[1]} + cva; cvb = (f32x2){w2[n][2], w2[n][3]} * (f32x2){a0[2], a0[3]} + cvb;
                    const f32x2 oa = gelu_mul_pk(cva, (f32x2){c[0], c[1]}), ob = gelu_mul_pk(cvb, (f32x2){c[2], c[3]});
                    hw[2 * n] = pk2(oa.x, oa.y); hw[2 * n + 1] = pk2(ob.x, ob.y);
                    if (store && fo) *(f32x4*)(fo + col0 + 4 * n) = a0;
                }
                if (store) *(v4u*)hrow = (v4u){hw[0], hw[1], hw[2], hw[3]};
            }
        }
#ifdef PROBE_EPI
        { int pcnt2 = (int)pst[15]; if (blockIdx.x == 0 && wr == 0 && wc == 0 && fr == 0 && fq == 0 && pcnt2 < 6) { asm volatile("s_waitcnt vmcnt(0) lgkmcnt(0)" ::: "memory"); pst[pcnt2] = __builtin_amdgcn_s_memrealtime(); pst[15] = pcnt2 + 1; } }
#endif
    }
};

constexpr int DT_KSPL = 11, DT_PK = 4, DT_NPART = 8 * DT_KSPL;
struct DownOrder {
    pg8::StaticOrder so; int c;
    __device__ void init(int G, int c_) { so.init(64 * 256, DM, G, c_); c = c_; }
    __device__ bool next(int i, Unit& u) const {
        int j = i;
        if (c < DT_NPART) {
            if (j == 0) { const int q = c / DT_KSPL, ks = c - q * DT_KSPL; u.pm = 64 + (q >> 2); u.pn = q & 3; u.arow = MP + 256 * (q >> 2); u.kt0 = DT_PK * ks; u.nkt = DT_PK; return true; }
            --j; }
        if (!so.next(j, u)) return false;
        u.arow = LP * (u.pm >> 3) + NMETA + 256 * (u.pm & 7);
        return true;
    }
    __device__ __forceinline__ void a_ready(const Unit&) const {}
    __device__ __forceinline__ void done(const Unit&) const {}
};
struct EpiDown {
    static constexpr bool PERM = true, AFTER_DRAIN = false;
    const bf16* x1b; float* out; float* slab;
    __device__ __forceinline__ void operator()(const f32x4 (&acc)[2][2][4][2], const Unit& u, int wr, int wc, int fr_, int fq_) const {
        int fr = fr_, fq = fq_; asm volatile("" : "+v"(fr), "+v"(fq));
        const int lrow0 = wr * 64 + fr, lcol0 = wc * 32 + 8 * fq;
        if (u.nkt > 0) {
            float* sl = slab + (size_t)((((u.pm - 64) * 4 + u.pn) * DT_KSPL) + u.kt0 / DT_PK) * 65536;
#pragma unroll
            for (int ai = 0; ai < 2; ++ai)
#pragma unroll
                for (int m = 0; m < 4; ++m)
#pragma unroll
                    for (int bj = 0; bj < 2; ++bj)
#pragma unroll
                        for (int n = 0; n < 2; ++n) *(f32x4*)(sl + (size_t)(lrow0 + ai * HALF + m * 16) * 256 + lcol0 + bj * HALF + n * 4) = acc[ai][bj][m][n];
            return;
        }
        const int col0 = u.pn * BM + lcol0;
        float* yo = out + O_YP + ((size_t)(u.pm >> 3) * SEQ + 256 * (u.pm & 7)) * DM;
#pragma unroll
        for (int ai = 0; ai < 2; ++ai)
#pragma unroll
            for (int m = 0; m < 4; ++m) { const int lr = lrow0 + ai * HALF + m * 16;
#pragma unroll
                for (int bj = 0; bj < 2; ++bj)
#pragma unroll
                    for (int n = 0; n < 2; ++n) { const int col = col0 + bj * HALF + n * 4;
                        *(f32x4*)(yo + (size_t)lr * DM + col) = acc[ai][bj][m][n] + ld_bf4(x1b + (size_t)(u.arow + lr) * DM + col); }
            }
    }
};
__device__ __forceinline__ void down_tail_reduce(Frame& F, const float* slab) {
    const int gt = (int)blockIdx.x * 512 + F.tid, NT = F.G * 512;
    for (int e = gt; e < MS * DM / 4; e += NT) {
        const int r = e >> 8, c = (e & 255) * 4;
        const float* sl = slab + (size_t)(((r >> 8) * 4 + (c >> 8)) * DT_KSPL) * 65536 + (size_t)(r & 255) * 256 + (c & 255);
        f32x4 s = ld_bf4(F.XN + (size_t)(MP + r) * DM + c);
#pragma unroll
        for (int k = 0; k < DT_KSPL; ++k) s += *(const f32x4*)(sl + (size_t)k * 65536);
        *(f32x4*)(F.out + O_YS + (size_t)r * DM + c) = s;
    }
}

typedef LAS const char* lds_cptr;
__device__ __forceinline__ unsigned off_b(unsigned row, unsigned ch) { return 256u * row + 16u * (ch ^ (((row & 3u) << 2) | ((row >> 2) & 3u))); }
__device__ __forceinline__ s16x4 vtr(lds_cptr p) { return __builtin_bit_cast(s16x4, __builtin_amdgcn_ds_read_tr16_b64_v4i16((LAS s16x4*)p)); }
__device__ __forceinline__ void glds16(const void* gsrc, unsigned lds_dst) { unsigned keep;
    asm volatile("s_mov_b32 %0, m0\n\ts_mov_b32 m0, %2\n\ts_nop 0\n\tglobal_load_lds_dwordx4 %1, off\n\ts_mov_b32 m0, %0" : "=&s"(keep) : "v"(gsrc), "s"(lds_dst) : "memory"); }
__device__ __forceinline__ int crow(int r, int hi) { return (r & 3) + 8 * (r >> 2) + 4 * hi; }
#define MFMA32(a, b, c) __builtin_amdgcn_mfma_f32_32x32x16_bf16((a), (b), (c), 0, 0, 0)
#define MFMA16(a, b, c) __builtin_amdgcn_mfma_f32_16x16x32_bf16((a), (b), (c), 0, 0, 0)

constexpr int ATT_K = 0, ATT_V = 32768, ATT_WS = 65536, ATT_Q = 67584;
__device__ __forceinline__ void attn_unit(Frame& F, int b, int h, int qi) {
    int lane_ = F.lane; asm volatile("" : "+v"(lane_));
    const int lane = lane_, w = F.wave, r32 = lane & 31, hi = lane >> 5;
    const int rowb = b * LP;
    const int Q0 = NMETA + 256 * qi + 32 * w;
    const int NT = 4 * qi + 5;
    LAS unsigned char* lds = F.lds;
    { LAS unsigned char* Qw = lds + ATT_Q + 8192 * w + 16 * lane; const bf16* qp = F.QB + ((long)(rowb + Q0 + r32)) * 512 + h * 128 + hi * 8;
#pragma unroll
      for (int ks = 0; ks < 8; ++ks) *(LAS v4u*)(Qw + 1024 * ks) = *(const v4u*)(qp + ks * 16); }
    f32x16 o0[4], o1[4];
#pragma unroll
    for (int c = 0; c < 4; ++c) { o0[c] = (f32x16){}; o1[c] = (f32x16){}; }
    float l0 = 0.f, l1 = 0.f;
    const unsigned ldsb = (unsigned)(uintptr_t)lds;
    const char* kg = (const char*)(F.KB + (size_t)rowb * 512 + h * 128);
    const char* vg = (const char*)(F.VB + (size_t)rowb * 512 + h * 128);
#define ATT_STAGE(j, buf) do { const char* kt_ = kg + (size_t)(64 * (j)) * 1024; const char* vt_ = vg + (size_t)(64 * (j)) * 1024; unsigned ln_ = lane; asm volatile("" : "+v"(ln_)); \
        _Pragma("unroll") for (int i_ = 0; i_ < 2; ++i_) { const unsigned row_ = 4u * (w + 8 * i_) + (ln_ >> 4), ch_ = (ln_ & 15) ^ (((row_ & 3u) << 2) | ((row_ >> 2) & 3u)); \
        const unsigned vr_ = (row_ & ~12u) | ((row_ & 4u) << 1) | ((row_ & 8u) >> 1); \
        glds16(kt_ + (row_ * 1024u + ch_ * 16u), (unsigned)__builtin_amdgcn_readfirstlane(ldsb + ATT_K + (buf) * 16384 + (w + 8 * i_) * 1024)); \
        glds16(vt_ + (vr_ * 1024u + ch_ * 16u), (unsigned)__builtin_amdgcn_readfirstlane(ldsb + ATT_V + (buf) * 16384 + (w + 8 * i_) * 1024)); } } while (0)
    ATT_STAGE(0, 0); VM_WAIT(); __syncthreads();
    for (int j = 0; j < NT; ++j) {
        const int buf = j & 1;
        if (j + 1 < NT) ATT_STAGE(j + 1, buf ^ 1);
        if (64 * j <= Q0 + 31) {
            const LAS unsigned char* Kb = lds + ATT_K + buf * 16384; const LAS unsigned char* Vb = lds + ATT_V + buf * 16384;
            const bool needmask = (64 * j + 63 > Q0);
            unsigned ln = lane; asm volatile("" : "+v"(ln));
            const unsigned r32v = ln & 31u, hiv = ln >> 5, blk = (ln >> 4) & 1u, qq = (ln & 15u) >> 2, pp = ln & 3u;
            const unsigned kra = off_b(r32v, hiv);
            const unsigned vba = off_b(8 * hiv + qq, 2 * blk + (pp >> 1)) + 8 * (pp & 1), vbb = off_b(8 * hiv + 4 + qq, 2 * blk + (pp >> 1)) + 8 * (pp & 1);
            const LAS unsigned char* Qw = lds + ATT_Q + 8192 * w + 16 * ln;
            const int qpos = Q0 + (int)r32v;
            bf16x8 pk0[4], pk1[4];
#define PK8(X, B) __builtin_bit_cast(bf16x8, (v4u){ cvtpk(X[B], X[B + 1]), cvtpk(X[B + 2], X[B + 3]), cvtpk(X[B + 4], X[B + 5]), cvtpk(X[B + 6], X[B + 7]) })
#define ATT_QK(KS0, HALF_, PK, LACC) do { f32x16 sa; \
                if (needmask) { _Pragma("unroll") for (int r = 0; r < 16; ++r) sa[r] = (64 * j + 32 * (HALF_) + crow(r, (int)hiv) > qpos) ? -1.0e30f : 0.f; } else sa = (f32x16){}; \
                _Pragma("unroll") for (int ks = (KS0); ks < (KS0) + 4; ++ks) { const bf16x8 qv = *(const LAS bf16x8*)(Qw + 1024 * ks); \
                    const bf16x8 a0 = *(const LAS bf16x8*)(Kb + 8192 * (HALF_) + (kra ^ (32u * ks))); \
                    sa = MFMA32(a0, qv, sa); } \
                __builtin_amdgcn_sched_group_barrier(0x100, 4, 0); __builtin_amdgcn_sched_group_barrier(0x008, 1, 0); __builtin_amdgcn_sched_group_barrier(0x100, 2, 0); \
                __builtin_amdgcn_sched_group_barrier(0x008, 1, 0); __builtin_amdgcn_sched_group_barrier(0x100, 2, 0); __builtin_amdgcn_sched_group_barrier(0x008, 2, 0); \
                float ls_ = 0.f; \
                _Pragma("unroll") for (int r = 0; r < 16; ++r) { sa[r] = __builtin_amdgcn_exp2f(sa[r]); ls_ += sa[r]; } \
                LACC += ls_; PK[2 * (HALF_)] = PK8(sa, 0); PK[2 * (HALF_) + 1] = PK8(sa, 8); } while (0)
            ATT_QK(0, 0, pk0, l0); __builtin_amdgcn_sched_barrier(0);
            ATT_QK(0, 1, pk0, l0); __builtin_amdgcn_sched_barrier(0);
            ATT_QK(4, 0, pk1, l1); __builtin_amdgcn_sched_barrier(0);
            ATT_QK(4, 1, pk1, l1); __builtin_amdgcn_sched_barrier(0);
#undef ATT_QK
#undef PK8
#pragma unroll
            for (int c = 0; c < 4; ++c)
#pragma unroll
                for (int ks = 0; ks < 4; ++ks) {
                    const s16x4 lo = vtr((lds_cptr)(Vb + (vba ^ (64u * c)) + 4096 * ks)), hh = vtr((lds_cptr)(Vb + (vbb ^ (64u * c)) + 4096 * ks));
                    const bf16x8 vf = (bf16x8){ lo[0], lo[1], lo[2], lo[3], hh[0], hh[1], hh[2], hh[3] };
                    o0[c] = MFMA32(pk0[ks], vf, o0[c]); o1[c] = MFMA32(pk1[ks], vf, o1[c]);
                }
            __builtin_amdgcn_sched_group_barrier(0x100, 4, 0);
#pragma unroll
            for (int i = 0; i < 14; ++i) { __builtin_amdgcn_sched_group_barrier(0x008, 2, 0); __builtin_amdgcn_sched_group_barrier(0x100, 2, 0); }
            __builtin_amdgcn_sched_group_barrier(0x008, 4, 0);
            __builtin_amdgcn_sched_barrier(0);
        }
        VM_WAIT(); __syncthreads();
    }
#undef ATT_STAGE
    const float lam = F.PAR[PA_LAM];
    l0 += __shfl_xor(l0, 32); l1 += __shfl_xor(l1, 32);
    LAS float* wsf = (LAS float*)(lds + ATT_WS) + w * 64;
    if (hi == 0) { wsf[r32] = l0; wsf[32 + r32] = l1; }
    LDS_WAIT(); asm volatile("" ::: "memory");
    const float* subn = F.in[I_SUBN];
    float sn[4];
#pragma unroll
    for (int c = 0; c < 4; ++c) sn[c] = subn[32 * c + r32] * (1.0f - LAM_INIT);
#pragma unroll
    for (int r = 0; r < 16; ++r) {
        const int qr = crow(r, hi);
        const float i0 = 1.0f / wsf[qr], i1 = lam / wsf[32 + qr];
        float v[4]; float ss = 0.f;
#pragma unroll
        for (int c = 0; c < 4; ++c) { v[c] = o0[c][r] * i0 - o1[c][r] * i1; ss += v[c] * v[c]; }
        ss += __shfl_xor(ss, 1); ss += __shfl_xor(ss, 2); ss += __shfl_xor(ss, 4); ss += __shfl_xor(ss, 8); ss += __shfl_xor(ss, 16);
        const float rn = rsqrtf(ss * (1.0f / 128.0f) + EPS);
        const int pos = Q0 + qr;
        if (pos >= 0) { bf16* dst = F.MIX + (size_t)(rowb + pos) * DM + h * 128 + r32;
#pragma unroll
            for (int c = 0; c < 4; ++c) dst[32 * c] = (bf16)f2bf(v[c] * rn * sn[c]); }
    }
    LDS_WAIT();
}

#ifndef NSL_
#define NSL_ 4
#endif
constexpr int NSL = NSL_, PPG = NPG / NSL;
constexpr int DEC_RED = 0, DEC_P = 0, DEC_Q = 16384;
__device__ __forceinline__ bf16x8 cvt8(const f32x4 a, const f32x4 b) { return __builtin_bit_cast(bf16x8, (v4u){ cvtpk(a[0], a[1]), cvtpk(a[2], a[3]), cvtpk(b[0], b[1]), cvtpk(b[2], b[3]) }); }
__device__ __forceinline__ f32x4 ldnt4(const float* p) { return __builtin_nontemporal_load((const f32x4*)p); }
__device__ __forceinline__ void decode_unit(Frame& F, int db, int pg) {
    int lane_ = F.lane; asm volatile("" : "+v"(lane_));
    const int lane = lane_, w = F.wave, col = lane & 15, kg = lane >> 4;
    LAS unsigned char* lds = F.lds;
    if (w < 4) {
        const int h = w;
#pragma unroll
        for (int kb = 0; kb < 4; ++kb) { v4u q = (v4u){0u, 0u, 0u, 0u};
            if (col < 8 && (col >> 2) == (kb >> 1)) q = *(const v4u*)(F.QB + (size_t)(MP + db * 4 + (col & 3)) * 512 + h * 128 + kb * 32 + kg * 8);
            *(LAS v4u*)(lds + DEC_Q + ((h * 4 + kb) * 64 + lane) * 16) = q; }
    }
    __syncthreads();
    const int hb = (w >> 2) * 2, hl = lane >> 5;
    f32x4 O[8];
#pragma unroll
    for (int c = 0; c < 8; ++c) O[c] = (f32x4){0.f, 0.f, 0.f, 0.f};
    float lsum[2] = {0.f, 0.f};
    const int* pt = (const int*)F.in[I_PT] + db * NPG + pg * PPG;
    LAS float* Pw = (LAS float*)(lds + DEC_P + 1024 * w);
    const LAS unsigned char* Qf = lds + DEC_Q + (hb * 4 * 64 + lane) * 16;
    LAS unsigned char* Kt = lds + 32768 + 8448 * w;
    const size_t koff = (size_t)(32 * (w & 3)) * 512 + hb * 128 + 4 * lane;
    const size_t voff = (size_t)(32 * (w & 3)) * 512 + hb * 128 + 4 * lane;
    f32x4 bA[16], bB[16];
#define LD_K(KP) do { _Pragma("unroll") for (int i = 0; i < 16; ++i) bA[i] = ldnt4((KP) + koff + (size_t)i * 512); } while (0)
#define LD_V(VP) do { _Pragma("unroll") for (int i = 0; i < 16; ++i) bB[i] = ldnt4((VP) + voff + (size_t)i * 512); } while (0)
    int pgid[PPG];
#pragma unroll
    for (int i = 0; i < PPG; ++i) pgid[i] = __builtin_amdgcn_readfirstlane(pt[i]);
    const int page = pgid[0];
    LD_K(F.in[I_CK] + (size_t)page * PAGE * 512);
    LD_V(F.in[I_CV] + (size_t)page * PAGE * 512);
#define DEC_BODY(GI, LOADNEXT) do { \
        const int gn = (GI) + 1; \
        const int npage = pgid[(LOADNEXT) ? (gn >> 1) : 0]; \
        const float* nkp = F.in[I_CK] + ((size_t)npage * PAGE + 16 * (gn & 1)) * 512; \
        const float* nvp = F.in[I_CV] + ((size_t)npage * PAGE + 16 * (gn & 1)) * 512; \
        f32x4 acc[2]; \
          \
        _Pragma("unroll") for (int s_ = 0; s_ < 16; ++s_) { const f32x4 kv = bA[s_]; \
            if (LOADNEXT) bA[s_] = ldnt4(nkp + koff + (size_t)s_ * 512); \
            *(LAS v2u*)(Kt + s_ * 528 + 8 * lane) = (v2u){ cvtpk(kv[0], kv[1]), cvtpk(kv[2], kv[3]) }; } \
        LDS_WAIT(); asm volatile("" ::: "memory"); \
        _Pragma("unroll") for (int hh = 0; hh < 2; ++hh) { f32x4 ac = (f32x4){0.f, 0.f, 0.f, 0.f}; \
            _Pragma("unroll") for (int kb = 0; kb < 4; ++kb) { const int i_ = hh * 4 + kb; \
                const bf16x8 a = *(const LAS bf16x8*)(Kt + col * 528 + (hh * 128 + kb * 32 + kg * 8) * 2); \
                const bf16x8 bq = *(const LAS bf16x8*)(Qf + i_ * 1024); ac = MFMA16(a, bq, ac); } \
            acc[hh] = ac; } \
        __builtin_amdgcn_sched_barrier(0); \
        if (col < 8) { \
            _Pragma("unroll") for (int hh = 0; hh < 2; ++hh) \
                _Pragma("unroll") for (int e = 0; e < 4; ++e) { const float p = __builtin_amdgcn_exp2f(acc[hh][e]); lsum[hh] += p; Pw[((4 * kg + e) * 2 + hh) * 8 + col] = p; } \
        } \
        LDS_WAIT(); asm volatile("" ::: "memory"); \
        __builtin_amdgcn_sched_barrier(0); \
        _Pragma("unroll") for (int s_ = 0; s_ < 16; ++s_) { \
            const f32x4 pa = *(const LAS f32x4*)(Pw + (s_ * 2 + hl) * 8), pb = *(const LAS f32x4*)(Pw + (s_ * 2 + hl) * 8 + 4); \
            const f32x4 vv = bB[s_]; \
            if (LOADNEXT) bB[s_] = ldnt4(nvp + voff + (size_t)s_ * 512); \
            _Pragma("unroll") for (int c = 0; c < 4; ++c) { O[c] += vv * pa[c]; O[4 + c] += vv * pb[c]; } \
        } \
        LDS_WAIT(); asm volatile("" ::: "memory"); \
        __builtin_amdgcn_sched_barrier(0); \
    } while (0)
    int ngi = 2 * PPG - 1; asm volatile("" : "+s"(ngi));
#pragma unroll 1
    for (int gi = 0; gi < ngi; ++gi) DEC_BODY(gi, true);
    DEC_BODY(2 * PPG - 1, false);
#undef DEC_BODY
#undef LD_K
#undef LD_V
    __syncthreads();
#pragma unroll
    for (int c = 0; c < 8; ++c) *(LAS f32x4*)(lds + DEC_RED + ((w * 8 + c) * 64 + lane) * 16) = O[c];
#pragma unroll
    for (int hh = 0; hh < 2; ++hh) { float l = lsum[hh]; l += __shfl_xor(l, 16); l += __shfl_xor(l, 32); if (lane < 8) ((LAS float*)(lds + 131072))[(w * 2 + hh) * 8 + lane] = l; }
    __syncthreads();
    float* slab = F.SLO + ((size_t)(db * NSL + pg)) * 4096;
#pragma unroll
    for (int k = 0; k < 2; ++k) { const int sc = 2 * w + k, set = sc >> 3, cc = sc & 7;
        f32x4 s = (f32x4){0.f, 0.f, 0.f, 0.f};
#pragma unroll
        for (int ww = 0; ww < 4; ++ww) s += *(const LAS f32x4*)(lds + DEC_RED + (((4 * set + ww) * 8 + cc) * 64 + lane) * 16);
        const int h = 2 * set + hl;
        *(f32x4*)(slab + (h * 8 + cc) * 128 + 4 * (lane & 31)) = s; }
    if (w == 0 && lane < 32) { const int h = lane >> 3, cc = lane & 7; float s = 0.f;
#pragma unroll
        for (int ww = 0; ww < 4; ++ww) s += ((const LAS float*)(lds + 131072))[((4 * (h >> 1) + ww) * 2 + (h & 1)) * 8 + cc];
        F.SLL[(size_t)(db * NSL + pg) * 32 + lane] = s; }
    __syncthreads();
}

__device__ __forceinline__ void decode_final(Frame& F, int db, int h, int tq) {
    int lane_ = F.lane; asm volatile("" : "+v"(lane_));
    const int lane = lane_;
    const float lam = F.PAR[PA_LAM];
    const int rbase = MP + db * 4;
    f32x2 sl[2][NSL]; float ll[2][NSL];
#pragma unroll
    for (int c = 0; c < 2; ++c)
#pragma unroll
        for (int pg = 0; pg < NSL; ++pg) { const int cc = 4 * c + tq;
            sl[c][pg] = *(const f32x2*)(F.SLO + ((size_t)(db * NSL + pg) * 32 + h * 8 + cc) * 128 + 2 * lane); ll[c][pg] = F.SLL[(size_t)(db * NSL + pg) * 32 + h * 8 + cc]; }
    float qv[2], kv[2][4], vn0[4], vn1[4];
#pragma unroll
    for (int c = 0; c < 2; ++c) { qv[c] = bf2f(F.QB[(size_t)(rbase + tq) * 512 + h * 128 + c * 64 + lane]);
#pragma unroll
        for (int j = 0; j < 4; ++j) kv[c][j] = bf2f(F.KB[(size_t)(rbase + (j <= tq ? j : tq)) * 512 + h * 128 + c * 64 + lane]); }
#pragma unroll
    for (int j = 0; j < 4; ++j) { const unsigned vw = *(const unsigned*)(F.VB + (size_t)(rbase + (j <= tq ? j : tq)) * 512 + h * 128 + 2 * lane); vn0[j] = bf2f((unsigned short)(vw & 0xffffu)); vn1[j] = bf2f((unsigned short)(vw >> 16)); }
    const float sn0 = F.in[I_SUBN][2 * lane] * (1.0f - LAM_INIT), sn1 = F.in[I_SUBN][2 * lane + 1] * (1.0f - LAM_INIT);
    float o[2][2], l[2];
#pragma unroll
    for (int c = 0; c < 2; ++c) { float a0 = 0.f, a1 = 0.f, ls = 0.f;
#pragma unroll
        for (int pg = 0; pg < NSL; ++pg) { a0 += sl[c][pg].x; a1 += sl[c][pg].y; ls += ll[c][pg]; }
#pragma unroll
        for (int j = 0; j < 4; ++j) { const float p = (j <= tq) ? __builtin_amdgcn_exp2f(wave_sum(qv[c] * kv[c][j])) : 0.f;
            ls += p; a0 += p * vn0[j]; a1 += p * vn1[j]; }
        o[c][0] = a0; o[c][1] = a1; l[c] = ls; }
    const float i0 = 1.0f / l[0], i1 = lam / l[1];
    const float y0 = o[0][0] * i0 - o[1][0] * i1, y1 = o[0][1] * i0 - o[1][1] * i1;
    const float rn = rsqrtf(wave_sum(y0 * y0 + y1 * y1) * (1.0f / 128.0f) + EPS);
    *(unsigned*)(F.MIX + (size_t)(rbase + tq) * DM + h * 128 + 2 * lane) = pk2(y0 * rn * sn0, y1 * rn * sn1);
}

__device__ __forceinline__ void ssm_sample_unit(Frame& F, int db, int g);
constexpr int SSM_LE = 131072, SSM_CF = 139264, SSM_HP = 136;
__device__ __forceinline__ void ssm_unit(Frame& F, int b, int g) {
    int lane_ = F.lane; asm volatile("" : "+v"(lane_));
    const int lane = lane_, w = F.wave, r32 = lane & 31, hi = lane >> 5;
    LAS unsigned char* lds = F.lds;
    LAS float* X = (LAS float*)(lds + 16384 * w);
    LAS unsigned short* Hb = (LAS unsigned short*)(lds + 16384 * w);
    LAS float* LE = (LAS float*)(lds + SSM_LE);
    const int rowb = b * LP;
    const float ar = F.PAR[PA_ABR + g * 64 + lane], ai = F.PAR[PA_ABI + g * 64 + lane];
    float a32r = ar, a32i = ai;
#pragma unroll
    for (int i = 0; i < 5; ++i) { const float nr = a32r * a32r - a32i * a32i, ni = 2.0f * a32r * a32i; a32r = nr; a32i = ni; }
    bf16x8 Bf[2][2];
#pragma unroll
    for (int ri = 0; ri < 2; ++ri)
#pragma unroll
        for (int nb = 0; nb < 2; ++nb) { const float* s = F.PAR + (ri ? PA_BBI : PA_BBR) + ((g * 64 + 32 * nb + r32) * 16 + 8 * hi);
            Bf[ri][nb] = cvt8(*(const f32x4*)s, *(const f32x4*)(s + 4)); }
    const int cfl = (r32 & 15) | (hi << 4);
    if (w == 0 && r32 < 16) {
#pragma unroll
        for (int s = 0; s < 8; ++s) { const float* src = (s < 4 ? F.in[I_CRE] : F.in[I_CIM]) + ((size_t)(g * 16 + r32) * 64 + 16 * (s & 3) + 8 * hi);
            f32x4 x0 = *(const f32x4*)src, x1 = *(const f32x4*)(src + 4); if (s >= 4) { x0 = -x0; x1 = -x1; }
            *(LAS bf16x8*)(lds + SSM_CF + (s * 32 + cfl) * 16) = cvt8(x0, x1); }
    }
    __syncthreads();
    const float dsk = (r32 < 16) ? F.in[I_DSK][g * 16 + r32] : 0.f;
    float cr = 0.f, ci = 0.f;
    const bf16* ubase = F.UB + (size_t)(rowb + r32) * 512 + 16 * g + 8 * hi;
    bf16x8 Anext = *(const bf16x8*)(ubase + (size_t)(32 * w) * 512);
    LAS unsigned short* Ut = (LAS unsigned short*)(lds + 16384 * w + 9216);
    LAS unsigned short* Gt = (LAS unsigned short*)(lds + 16384 * w + 10240);
    for (int it = 0; it < 9; ++it) {
        const int ck = 8 * it + w, t0 = 32 * ck;
        const bool active = ck < 65;
        const bf16x8 A = Anext;
        { int ckn = ck + 8; ckn = ckn > 64 ? 64 : ckn; Anext = *(const bf16x8*)(ubase + (size_t)(32 * ckn) * 512); }
        float hlr[32], hli[32];
        float er = 0.f, ei = 0.f;
        if (active) {
            const f32x16 z = (f32x16){};
            const f32x16 xr0 = MFMA32(A, Bf[0][0], z), xr1 = MFMA32(A, Bf[0][1], z), xi0 = MFMA32(A, Bf[1][0], z), xi1 = MFMA32(A, Bf[1][1], z);
#pragma unroll
            for (int r = 0; r < 16; ++r) { const int t = crow(r, hi);
                X[t * 64 + r32] = xr0[r]; X[t * 64 + 32 + r32] = xr1[r]; X[2048 + t * 64 + r32] = xi0[r]; X[2048 + t * 64 + 32 + r32] = xi1[r]; }
            LDS_WAIT(); asm volatile("" ::: "memory");
#pragma unroll
            for (int t = 0; t < 32; ++t) { const float xr = X[t * 64 + lane], xi = X[2048 + t * 64 + lane];
                const float nr = ar * er - ai * ei + xr, ni = ar * ei + ai * er + xi; er = nr; ei = ni; hlr[t] = nr; hli[t] = ni; }
        }
        LE[((it & 1) * 8 + w) * 128 + lane] = er; LE[((it & 1) * 8 + w) * 128 + 64 + lane] = ei;
        LDS_WAIT(); __builtin_amdgcn_s_barrier(); asm volatile("" ::: "memory");
        float cinr = 0.f, cini = 0.f;
#pragma unroll
        for (int j = 0; j < 8; ++j) {
            if (j == w) { cinr = cr; cini = ci; }
            const float lr = LE[((it & 1) * 8 + j) * 128 + lane], li = LE[((it & 1) * 8 + j) * 128 + 64 + lane];
            const float nr = a32r * cr - a32i * ci + lr, ni = a32r * ci + a32i * cr + li; cr = nr; ci = ni;
        }
        if (active) {
            float pr = ar, pi = ai;
#pragma unroll
            for (int t = 0; t < 32; ++t) {
                const float hr = hlr[t] + pr * cinr - pi * cini, hq = hli[t] + pr * cini + pi * cinr;
                Hb[t * SSM_HP + lane] = (unsigned short)f2bf(hr); Hb[t * SSM_HP + 64 + lane] = (unsigned short)f2bf(hq);
                if (ck == 64 && t == 15) { F.out[O_SRP + (size_t)(b * NG + g) * 64 + lane] = hr; F.out[O_SIP + (size_t)(b * NG + g) * 64 + lane] = hq; }
                const float npr = pr * ar - pi * ai, npi = pr * ai + pi * ar; pr = npr; pi = npi;
            }
            *(LAS bf16x8*)((LAS unsigned char*)Ut + r32 * 32 + hi * 16) = A;
            LDS_WAIT(); asm volatile("" ::: "memory");
            f32x16 y = (f32x16){};
#pragma unroll
            for (int s = 0; s < 8; ++s) { const bf16x8 Af = *(const LAS bf16x8*)((LAS unsigned char*)Hb + r32 * (SSM_HP * 2) + (16 * s + 8 * hi) * 2);
                bf16x8 cf = *(const LAS bf16x8*)(lds + SSM_CF + (s * 32 + cfl) * 16); if (r32 >= 16) cf = (bf16x8){0, 0, 0, 0, 0, 0, 0, 0};
                y = MFMA32(Af, cf, y); }
            if (r32 < 16) {
#pragma unroll
                for (int r = 0; r < 16; ++r) { const int t = crow(r, hi);
                    Gt[t * 16 + r32] = (unsigned short)f2bf(gelu_tanh(y[r] + dsk * bf2f(Ut[t * 16 + r32]))); }
            }
            LDS_WAIT(); asm volatile("" ::: "memory");
            { const int t = lane >> 1, hf = lane & 1, pos = t0 + t;
              if (pos < LP) *(v4u*)(F.GB + (size_t)(rowb + pos) * 512 + 16 * g + 8 * hf) = *(const LAS v4u*)((LAS unsigned char*)Gt + t * 32 + hf * 16); }
            LDS_WAIT(); asm volatile("" ::: "memory");
        }
    }
    __syncthreads();
#ifdef SSMS_IN_SSM
#pragma unroll 1
    for (int i = 0; i < 2; ++i) ssm_sample_unit(F, 16 * b + 2 * w + i, g);
#endif
}

__device__ __forceinline__ void ssm_sample_unit(Frame& F, int db, int g) {
    int lane_ = F.lane; asm volatile("" : "+v"(lane_));
    const int lane = lane_, w = F.wave;
    LAS float* S = (LAS float*)(F.lds + 4096 * w);
    const int gp = g * 64 + lane;
    const float ar = F.PAR[PA_ABR + gp], ai = F.PAR[PA_ABI + gp];
    float hr = F.in[I_SRE][(size_t)(db * NG + g) * 64 + lane], hq = F.in[I_SIM][(size_t)(db * NG + g) * 64 + lane];
    float br[16], bi[16];
#pragma unroll
    for (int c = 0; c < 16; ++c) { br[c] = F.PAR[PA_BBR + gp * 16 + c]; bi[c] = F.PAR[PA_BBI + gp * 16 + c]; }
    const int rbase = MP + db * 4;
#pragma unroll
    for (int t = 0; t < 4; ++t) {
        const v4u u0 = *(const v4u*)(F.UB + (size_t)(rbase + t) * 512 + 16 * g), u1 = *(const v4u*)(F.UB + (size_t)(rbase + t) * 512 + 16 * g + 8);
        const unsigned uw[8] = { u0.x, u0.y, u0.z, u0.w, u1.x, u1.y, u1.z, u1.w };
        float xr = 0.f, xi = 0.f;
#pragma unroll
        for (int c = 0; c < 16; ++c) { const float uu = bf2f((unsigned short)((c & 1) ? (uw[c >> 1] >> 16) : (uw[c >> 1] & 0xffffu))); xr += br[c] * uu; xi += bi[c] * uu; }
        const float nr = ar * hr - ai * hq + xr, ni = ar * hq + ai * hr + xi; hr = nr; hq = ni;
        S[t * 128 + lane] = hr; S[t * 128 + 64 + lane] = hq;
    }
    F.out[O_SRS + (size_t)(db * NG + g) * 64 + lane] = hr; F.out[O_SIS + (size_t)(db * NG + g) * 64 + lane] = hq;
    LDS_WAIT(); asm volatile("" ::: "memory");
    const int t = lane >> 4, ch = lane & 15;
    const float* cre = F.in[I_CRE] + (size_t)(g * 16 + ch) * 64; const float* cim = F.in[I_CIM] + (size_t)(g * 16 + ch) * 64;
    float y = 0.f;
#pragma unroll 4
    for (int p = 0; p < 64; p += 4) { const f32x4 a = *(const f32x4*)(cre + p), c = *(const f32x4*)(cim + p);
        const f32x4 sr = *(const LAS f32x4*)(S + t * 128 + p), si = *(const LAS f32x4*)(S + t * 128 + 64 + p);
        y += (a[0] * sr[0] - c[0] * si[0]) + (a[1] * sr[1] - c[1] * si[1]) + (a[2] * sr[2] - c[2] * si[2]) + (a[3] * sr[3] - c[3] * si[3]); }
    const float uu = bf2f(F.UB[(size_t)(rbase + t) * 512 + 16 * g + ch]);
    F.GB[(size_t)(rbase + t) * 512 + 16 * g + ch] = (bf16)f2bf(gelu_tanh(y + F.in[I_DSK][g * 16 + ch] * uu));
    LDS_WAIT(); asm volatile("" ::: "memory");
}
__device__ __forceinline__ void ssm_sample_unit2(Frame& F, int dbp, int g) {
    int lane_ = F.lane; asm volatile("" : "+v"(lane_));
    const int lane = lane_, w = F.wave;
    LAS float* Cl = (LAS float*)(F.lds + 16384 * w);
    LAS float* S = Cl + 2176;
    const int gp = g * 64 + lane;
    const int t = lane >> 4, ch = lane & 15;
    f32x4 cv[2][4];
#pragma unroll
    for (int ri = 0; ri < 2; ++ri)
#pragma unroll
        for (int j = 0; j < 4; ++j) cv[ri][j] = *(const f32x4*)((ri ? F.in[I_CIM] : F.in[I_CRE]) + (size_t)g * 1024 + 256 * j + 4 * lane);
    const float ar = F.PAR[PA_ABR + gp], ai = F.PAR[PA_ABI + gp];
    f32x4 bq[2][4];
#pragma unroll
    for (int ri = 0; ri < 2; ++ri)
#pragma unroll
        for (int j = 0; j < 4; ++j) bq[ri][j] = *(const f32x4*)(F.PAR + (ri ? PA_BBI : PA_BBR) + gp * 16 + 4 * j);
    float hr[2], hq[2], uy[2]; v4u uu[2][4][2];
#pragma unroll
    for (int d = 0; d < 2; ++d) { const int db = 2 * dbp + d, rbase = MP + db * 4;
        hr[d] = F.in[I_SRE][(size_t)(db * NG + g) * 64 + lane]; hq[d] = F.in[I_SIM][(size_t)(db * NG + g) * 64 + lane];
#pragma unroll
        for (int tt = 0; tt < 4; ++tt) { uu[d][tt][0] = *(const v4u*)(F.UB + (size_t)(rbase + tt) * 512 + 16 * g); uu[d][tt][1] = *(const v4u*)(F.UB + (size_t)(rbase + tt) * 512 + 16 * g + 8); }
        uy[d] = bf2f(F.UB[(size_t)(rbase + t) * 512 + 16 * g + ch]); }
    const float dsk = F.in[I_DSK][g * 16 + ch];
#pragma unroll
    for (int ri = 0; ri < 2; ++ri)
#pragma unroll
        for (int j = 0; j < 4; ++j) *(LAS f32x4*)(Cl + ri * 1088 + (4 * j + (lane >> 4)) * 68 + 4 * (lane & 15)) = cv[ri][j];
#pragma unroll
    for (int d = 0; d < 2; ++d) { const int db = 2 * dbp + d;
        float h0 = hr[d], h1 = hq[d];
#pragma unroll
        for (int tt = 0; tt < 4; ++tt) {
            const unsigned uw[8] = { uu[d][tt][0].x, uu[d][tt][0].y, uu[d][tt][0].z, uu[d][tt][0].w, uu[d][tt][1].x, uu[d][tt][1].y, uu[d][tt][1].z, uu[d][tt][1].w };
            float xr = 0.f, xi = 0.f;
#pragma unroll
            for (int c = 0; c < 16; ++c) { const float u_ = bf2f((unsigned short)((c & 1) ? (uw[c >> 1] >> 16) : (uw[c >> 1] & 0xffffu))); xr += bq[0][c >> 2][c & 3] * u_; xi += bq[1][c >> 2][c & 3] * u_; }
            const float nr = ar * h0 - ai * h1 + xr, ni = ar * h1 + ai * h0 + xi; h0 = nr; h1 = ni;
            S[(d * 4 + tt) * 128 + lane] = h0; S[(d * 4 + tt) * 128 + 64 + lane] = h1;
        }
        F.out[O_SRS + (size_t)(db * NG + g) * 64 + lane] = h0; F.out[O_SIS + (size_t)(db * NG + g) * 64 + lane] = h1;
    }
    LDS_WAIT(); asm volatile("" ::: "memory");
#pragma unroll
    for (int d = 0; d < 2; ++d) { const int rbase = MP + (2 * dbp + d) * 4;
        float y = 0.f;
#pragma unroll
        for (int p = 0; p < 64; p += 4) { const f32x4 a = *(const LAS f32x4*)(Cl + ch * 68 + p), c = *(const LAS f32x4*)(Cl + 1088 + ch * 68 + p);
            const f32x4 sr = *(const LAS f32x4*)(S + (d * 4 + t) * 128 + p), si = *(const LAS f32x4*)(S + (d * 4 + t) * 128 + 64 + p);
            y += (a[0] * sr[0] - c[0] * si[0]) + (a[1] * sr[1] - c[1] * si[1]) + (a[2] * sr[2] - c[2] * si[2]) + (a[3] * sr[3] - c[3] * si[3]); }
        F.GB[(size_t)(rbase + t) * 512 + 16 * g + ch] = (bf16)f2bf(gelu_tanh(y + dsk * uy[d]));
    }
    LDS_WAIT(); asm volatile("" ::: "memory");
}

struct Args { const void* in[N_IN]; float* out; unsigned char* ws; };
constexpr int NQ_MAIN = 4 * 288, NQ_SS = 64, NQ = NQ_MAIN + NQ_SS;

__global__ void __launch_bounds__(512, 2) hymba_fwd(Args args) {
    extern __shared__ __attribute__((aligned(16))) unsigned char lds_raw[];
    Frame F;
    F.lds = (LAS unsigned char*)lds_raw;
    F.MISC = (volatile LAS unsigned*)(F.lds + MISC_OFF);
    F.tid = threadIdx.x; F.lane = F.tid & 63; F.wave = __builtin_amdgcn_readfirstlane(F.tid >> 6);
    F.G = gridDim.x; { const int bx = blockIdx.x; F.vcu = (F.G % 8 == 0) ? (bx % 8) * (F.G / 8) + bx / 8 : bx; }
    unsigned char* ws = args.ws;
    F.ws = ws; F.out = args.out;
#pragma unroll
    for (int i = 0; i < N_IN; ++i) F.in[i] = (const float*)args.in[i];
    F.ctl = (gu32*)(ws + WS_CTL);
    F.WIN_t = (bf16*)(ws + WS_WIN); F.WGLU_t = (bf16*)(ws + WS_WGLU); F.WOUT_t = (bf16*)(ws + WS_WOUT); F.WGATE_t = (bf16*)(ws + WS_WGATE); F.WUP_t = (bf16*)(ws + WS_WUP); F.WDOWN_t = (bf16*)(ws + WS_WDOWN);
    F.XN = (bf16*)(ws + WS_XN); F.QB = (bf16*)(ws + WS_QB); F.KB = (bf16*)(ws + WS_KB); F.VB = (bf16*)(ws + WS_VB); F.UB = (bf16*)(ws + WS_UB);
    F.MIX = (bf16*)(ws + WS_MIX); F.GB = (bf16*)(ws + WS_G); F.AB = (bf16*)(ws + WS_A); F.HB = (bf16*)(ws + WS_H);
    F.X1 = (float*)(ws + WS_X1); F.PAR = (float*)(ws + WS_PAR); F.ROWSS = (float*)(ws + WS_CTL) + CW_ROWSS; F.SLO = (float*)(ws + WS_SLO); F.SLL = (float*)(ws + WS_SLL);
    for (int u = F.tid; u < (LDS_BYTES - MISC_OFF) / 4; u += 512) ((LAS unsigned*)(F.lds + MISC_OFF))[u] = 0u;
    __syncthreads();
#if defined(REP_BAR) && REP_BAR > 1
#define xcd_barrier(b) do { xcd_barrier(b); xcd_barrier(b); } while (0)
#endif
    XcdBarrier bar = xcd_barrier_post((unsigned*)(F.ctl + CW_BAR), F.MISC + 8);

#ifdef PROBE_PH
    unsigned long long ts_a = 0, ts_b = 0; int ts_n = 0;
#define STAMP() do { const unsigned long long t_ = __builtin_amdgcn_s_memrealtime(); if (ts_n == PROBE_PH) ts_a = t_; if (ts_n == PROBE_PH + 1) ts_b = t_; ++ts_n; } while (0)
#else
#define STAMP() do {} while (0)
#endif
#ifdef PROBE_X
    unsigned long long tx_a = 0, tx_b = 0;
#define STAMPX(i) do { if ((i) == PROBE_X) tx_a = __builtin_amdgcn_s_memrealtime(); if ((i) == PROBE_X + 1) tx_b = __builtin_amdgcn_s_memrealtime(); } while (0)
#else
#define STAMPX(i) do {} while (0)
#endif
    STAMP();
    STAMPX(10);
    p0_prologue(F);
    STAMPX(11);
#if defined(REP_P0) && REP_P0 > 1
    __syncthreads(); p0_prologue(F);
#endif
    xcd_barrier(bar); STAMP();

    int qpar = 0;
#define P2_QUEUE(QI, NUNITS, ...) do { for (;;) { \
        if (F.tid == 0) F.MISC[qpar] = __hip_atomic_fetch_add((unsigned*)(F.ctl + CW_QUEUE + 64 * (QI)), 1u, RLX_AGENT); \
        __syncthreads(); const int n = (int)F.MISC[qpar]; qpar ^= 1; \
        if (n >= (NUNITS)) break; __VA_ARGS__; } } while (0)
    {
        pg8::Gemm g{F.XN, F.WIN_t, MPAD, PWID, DM, DM, 256}; ProjOrder S; S.init(F.G, (int)blockIdx.x);
        EpiProj E{F.QB, F.KB, F.VB, F.UB, F.out, F.in[I_QN], F.in[I_KN], (float*)(F.ws + WS_A)};
        pg8::gemm_phase<EpiProj, ProjOrder, true, true>(F.lds, g, S, E);
#ifndef NO_IDLE_WCV
        __syncthreads();
        if ((int)blockIdx.x >= PT_NPART || F.G < 2 * PT_NPART)
        P2_QUEUE(6, (WCV_I2 + WCV_I4) / 8, { const int j_ = n * 8 + F.wave; wcv_item(F, j_ < WCV_I2 ? j_ : WCV_I3 + j_); });
#endif
    }
    xcd_barrier(bar); STAMP();
    proj_tail_reduce(F, (const float*)(F.ws + WS_A));
    xcd_barrier(bar); STAMP();

    STAMPX(0);
#define P2_QUEUE_PF(QI, NUNITS, ...) do { unsigned nx_ = 0u; if (F.tid == 0) nx_ = __hip_atomic_fetch_add((unsigned*)(F.ctl + CW_QUEUE + 64 * (QI)), 1u, RLX_AGENT); \
        for (;;) { if (F.tid == 0) F.MISC[qpar] = nx_; \
            __syncthreads(); const int n = (int)F.MISC[qpar]; qpar ^= 1; \
            if (n >= (NUNITS)) break; \
            if (F.tid == 0) nx_ = __hip_atomic_fetch_add((unsigned*)(F.ctl + CW_QUEUE + 64 * (QI)), 1u, RLX_AGENT); \
            __VA_ARGS__; } } while (0)
#define Q_SSM_PF() P2_QUEUE_PF(0, 256, ssm_unit(F, n >> 5, n & 31))
#define Q_ATT_PF() P2_QUEUE_PF(1, 288, { const int qi = 7 - n / 32, bh = n % 32; attn_unit(F, bh >> 2, bh & 3, qi); })
#define Q_DEC_PF() P2_QUEUE_PF(2, DB * NSL, decode_unit(F, n / NSL, n % NSL))
#define Q_SSM() P2_QUEUE(0, 256, ssm_unit(F, n >> 5, n & 31))
#define Q_ATT() P2_QUEUE(1, 288, { const int qi = 7 - n / 32, bh = n % 32; attn_unit(F, bh >> 2, bh & 3, qi); })
#define Q_DEC() P2_QUEUE(2, DB * NSL, decode_unit(F, n / NSL, n % NSL))
#ifndef NO_IDLE_WCV
#define Q_WCV() do {} while (0)
#else
#define Q_WCV() P2_QUEUE(4, WCV_I2 / 8, wcv_item(F, n * 8 + F.wave))
#endif
#define Q_SSMS() P2_QUEUE(3, DB * NG / 16, ssm_sample_unit2(F, (n * 8 + F.wave) >> 5, (n * 8 + F.wave) & 31))
#ifndef P2_MODE
#define P2_MODE 1
#endif
#if P2_MODE == 0
    Q_SSM(); Q_ATT(); Q_DEC(); Q_WCV(); Q_SSMS();
#elif P2_MODE == 2
    Q_ATT(); Q_SSM(); Q_DEC(); Q_WCV(); Q_SSMS();
#else
#ifndef DEC_FIRST_16
#define DEC_FIRST_16 8
#endif
#ifdef DEC_INTERLEAVE
    const bool decfirst = (F.vcu & 1) == 0;
#else
    const bool decfirst = (F.vcu & 15) < DEC_FIRST_16;
#endif
#ifdef QPREFETCH
    if (decfirst) { Q_DEC_PF(); STAMPX(1); Q_SSM_PF(); STAMPX(2); Q_ATT(); }
    else { Q_ATT_PF(); STAMPX(1); Q_SSM_PF(); STAMPX(2); Q_DEC(); }
#else
    if (decfirst) { Q_DEC(); STAMPX(1); Q_SSM(); STAMPX(2); Q_ATT(); }
#ifndef CF_ATT_FIRST
    else { Q_SSM(); STAMPX(1); Q_ATT(); STAMPX(2); Q_DEC(); }
#else
    else { Q_ATT(); STAMPX(1); Q_SSM(); STAMPX(2); Q_DEC(); }
#endif
#endif
    STAMPX(3);
#ifdef SSMS_IN_SSM
    Q_WCV();
#else
    Q_WCV(); Q_SSMS();
#endif
#endif
    STAMPX(4);
#undef Q_SSM
#undef Q_ATT
#undef Q_DEC
#undef Q_WCV
#undef Q_SSMS
#undef Q_SSM_PF
#undef Q_ATT_PF
#undef Q_DEC_PF
#undef P2_QUEUE_PF
    xcd_barrier(bar); STAMP();

    {
        STAMPX(30);
        pg8::Gemm g{F.GB, F.WGLU_t, MPAD, SW, SW, SW, 256}; pg8::StaticOrder S; S.init(MPAD, SW, F.G, (int)blockIdx.x);
        EpiGlu E{F.GB, F.MIX, F.in[I_BGLU]};
        pg8::gemm_phase<EpiGlu, pg8::StaticOrder, true, true>(F.lds, g, S, E);
#if defined(REP_P3) && REP_P3 > 1
        __syncthreads();
        pg8::gemm_phase<EpiGlu, pg8::StaticOrder, true, true>(F.lds, g, S, E);
#endif
        { const int nglu = (MPAD / 256) * (SW / 256);
          const int nidle = F.G > nglu ? F.G - nglu : F.G, ib = F.G > nglu ? (int)blockIdx.x - nglu : (int)blockIdx.x;
          if (ib >= 0)
#pragma unroll 1
            for (int uidx = ib * 8 + F.wave; uidx < DB * NH * TS; uidx += nidle * 8) decode_final(F, uidx >> 4, (uidx >> 2) & 3, uidx & 3); }
        __syncthreads();
#ifndef NO_IDLE_WCV
        if ((int)blockIdx.x >= (MPAD / 256) * (SW / 256) || F.G < 2 * (MPAD / 256) * (SW / 256))
        P2_QUEUE(5, (WCV_I3 + WCV_I4) / 8, { const int j_ = n * 8 + F.wave; wcv_item(F, j_ < WCV_I3 ? WCV_I2 + j_ : WCV_I2 + WCV_I4 + j_); });
#else
        P2_QUEUE(5, (WCV_ITEMS - WCV_I2 + 7) / 8, { const int r_ = WCV_I2 + n * 8 + F.wave; if (r_ < WCV_ITEMS) wcv_item(F, r_); });
#endif
        STAMPX(31);
    }
    xcd_barrier(bar); STAMP();

    {
        pg8::Gemm g{F.MIX, F.WOUT_t, MPAD, DM, DM, DM, 256}; OutOrder S; S.init(F.G, (int)blockIdx.x);
        EpiOut E{F.in[I_XP], F.XN, F.ROWSS, (float*)(F.ws + WS_A)};
        pg8::gemm_phase<EpiOut, OutOrder, true, true>(F.lds, g, S, E);
#ifndef NO_IDLE_WCV
        __syncthreads();
        if ((int)blockIdx.x >= OT_NPART || F.G < 2 * OT_NPART)
        P2_QUEUE(7, WCV_I6 / 8, wcv_item(F, WCV_I2 + WCV_I3 + 2 * WCV_I4 + n * 8 + F.wave));
#endif
    }
#undef P2_QUEUE
    xcd_barrier(bar); STAMP();
    out_tail_reduce(F, (const float*)(F.ws + WS_A));
    xcd_barrier(bar); STAMP();

    {
#ifdef PROBE_EPI
        if (F.tid < 32) ((LAS unsigned long long*)((LAS float*)(F.lds + RING_BYTES) + 2048))[F.tid] = 0ull;
        __syncthreads();
#endif
        pg8::Gemm g{F.XN - 2 * DM, F.WGATE_t, MT2 * 256, 2 * FF, DM, DM, MSTEP2}; pg8::StaticOrder S; S.init(MT2 * 256, 2 * FF, F.G, (int)blockIdx.x);
        EpiGateUp E{F.ROWSS, F.HB, F.out, F.in[I_CW], F.in[I_CB], (const bf16*)(F.ws + WS_EH), (LAS float*)(F.lds + RING_BYTES)};
        STAMPX(20);
        pg8::gemm_phase<EpiGateUp, pg8::StaticOrder, true, true>(F.lds, g, S, E);
        STAMPX(21);
#if defined(REP_P5) && REP_P5 > 1
        __syncthreads();
        pg8::gemm_phase<EpiGateUp, pg8::StaticOrder, true, true>(F.lds, g, S, E);
#endif
    }
    xcd_barrier(bar); STAMP();

    {
        pg8::Gemm g{F.HB, F.WDOWN_t, MPAD, DM, FF, FF, 256}; DownOrder S; S.init(F.G, (int)blockIdx.x);
        EpiDown E{F.XN, F.out, (float*)(F.ws + WS_A)};
        pg8::gemm_phase<EpiDown, DownOrder, true, true>(F.lds, g, S, E);
    }
    xcd_barrier(bar); STAMP();
    down_tail_reduce(F, (const float*)(F.ws + WS_A));
#ifdef PROBE_EPI
    if (blockIdx.x == 0 && F.tid == 0) { const LAS unsigned long long* pst = (const LAS unsigned long long*)((LAS float*)(F.lds + RING_BYTES) + 2048); const unsigned long long t0 = __builtin_amdgcn_s_memrealtime(), want = (pst[PROBE_EPI + 1] - pst[PROBE_EPI]) * PROBE_AMP; while (__builtin_amdgcn_s_memrealtime() - t0 < want) __builtin_amdgcn_s_sleep(8); }
#endif
#ifdef PROBE_X
    if (blockIdx.x == PROBE_BLK && F.tid == 0) { const unsigned long long t0 = __builtin_amdgcn_s_memrealtime(), want = (tx_b - tx_a) * PROBE_AMP; while (__builtin_amdgcn_s_memrealtime() - t0 < want) __builtin_amdgcn_s_sleep(8); }
#endif
#ifdef PROBE_PH
    xcd_barrier(bar); STAMP(); STAMP();
    if (blockIdx.x == 0 && F.tid == 0) { const unsigned long long t0 = __builtin_amdgcn_s_memrealtime(), want = (ts_b - ts_a) * PROBE_AMP; while (__builtin_amdgcn_s_memrealtime() - t0 < want) __builtin_amdgcn_s_sleep(8); }
#endif
}

extern "C" void kernel_launch(void* const* d_in, const int* in_sizes, int n_in, void* d_out, int out_size, void* d_ws, size_t ws_size, hipStream_t stream) {
    static int grid = 0;
    if (grid == 0) {
        if (n_in != N_IN || (size_t)out_size != O_END || ws_size < WS_END) { fprintf(stderr, "kernel_launch: unexpected shapes (n_in %d, out %d, ws %zu); nothing launched\n", n_in, out_size, ws_size); grid = -1; return; }
        int dev = 0, cus = 0, per_cu = 0;
        if (hipGetDevice(&dev) != hipSuccess || hipDeviceGetAttribute(&cus, hipDeviceAttributeMultiprocessorCount, dev) != hipSuccess) { grid = -1; return; }
        if (hipFuncSetAttribute((const void*)hymba_fwd, hipFuncAttributeMaxDynamicSharedMemorySize, LDS_BYTES) != hipSuccess) { fprintf(stderr, "kernel_launch: hipFuncSetAttribute failed\n"); grid = -1; return; }
        if (hipOccupancyMaxActiveBlocksPerMultiprocessor(&per_cu, (const void*)hymba_fwd, 512, LDS_BYTES) != hipSuccess || per_cu < 1)
            fprintf(stderr, "kernel_launch: note: occupancy query reports %d workgroups per CU\n", per_cu);
        (void)hipGetLastError();
        grid = cus;
    }
    if (grid < 0) return;
    if (hipMemsetAsync((char*)d_ws + WS_CTL, 0, CTL_ZERO_BYTES, stream) != hipSuccess) return;
    Args a{};
    for (int i = 0; i < N_IN; ++i) a.in[i] = d_in[i];
    a.out = (float*)d_out; a.ws = (unsigned char*)d_ws;
    hipLaunchKernelGGL(hymba_fwd, dim3(grid), dim3(512), LDS_BYTES, stream, a);
}
```
